# Optimizing an MI355X kernel written in HIP

```python
import math
import jax, jax.numpy as jnp
from jax import lax
import numpy as np

D_MODEL = 1024
BATCH = 2
SEQ = 8192
DEPTH = 2

HEAD_DIM = 64
SWEEP_BLOCK = 128
RMS_EPS = 1e-6
NEG_INF = -1e30

MLA_HEADS = 8
MLA_Q_RANK = 256
MLA_KV_RANK = 128
MLA_NOPE = 64
MLA_ROPE = 32
MLA_V = 64
ROPE_THETA = 10000.0

SWA_HEADS = 8
SWA_KV_HEADS = 2
SWA_WINDOW = 128

MOBA_HEADS = 8
MOBA_BLOCK = 256
MOBA_TOPK = 3

SB_HEADS = 8

REL_BUCKETS = 32
REL_MAX_DIST = 2048
REL_HEADS = 8

N_GROUPS = 4
EXPERTS_PER_GROUP = 8
N_EXPERTS = N_GROUPS * EXPERTS_PER_GROUP
EXPERT_TOPK = 2
D_EXPERT = 256
MOE_CHUNK = 128

N_EVEN = (DEPTH + 1) // 2
N_ODD = DEPTH // 2

SWA_Q_W = SWA_HEADS * HEAD_DIM
SWA_KV_W = SWA_KV_HEADS * HEAD_DIM
IN_EVEN = MLA_Q_RANK + MLA_KV_RANK + MLA_ROPE + SWA_Q_W + 2 * SWA_KV_W
SPLIT_EVEN = (MLA_Q_RANK, MLA_Q_RANK + MLA_KV_RANK, MLA_Q_RANK + MLA_KV_RANK + MLA_ROPE,
              MLA_Q_RANK + MLA_KV_RANK + MLA_ROPE + SWA_Q_W,
              MLA_Q_RANK + MLA_KV_RANK + MLA_ROPE + SWA_Q_W + SWA_KV_W)
MIX_EVEN = MLA_HEADS * MLA_V + SWA_HEADS * HEAD_DIM
IN_ODD = 3 * (MOBA_HEADS + SB_HEADS) * HEAD_DIM
MIX_ODD = (MOBA_HEADS + SB_HEADS) * HEAD_DIM

kernel_name = "hybrid_mla_swa_moba_stickbreak_hmoe"


def rms_norm(x, g):
    xf = x.astype(jnp.float32)
    y = xf * lax.rsqrt(jnp.mean(xf * xf, axis=-1, keepdims=True) + RMS_EPS)
    return (y * g.astype(jnp.float32)).astype(x.dtype)


def rope(x):
    T, R = x.shape[1], x.shape[-1]
    freqs = ROPE_THETA ** (-jnp.arange(0, R, 2, dtype=jnp.float32) / R)
    ang = jnp.arange(T, dtype=jnp.float32)[:, None] * freqs[None, :]
    shape = (T,) + (1,) * (x.ndim - 3) + (R // 2,)
    cos, sin = jnp.cos(ang).reshape(shape), jnp.sin(ang).reshape(shape)
    xf = x.astype(jnp.float32)
    x1, x2 = xf[..., : R // 2], xf[..., R // 2:]
    return jnp.concatenate([x1 * cos - x2 * sin, x2 * cos + x1 * sin], axis=-1).astype(x.dtype)


def t5_bucket(dist):
    n = jnp.maximum(dist, 0)
    max_exact = REL_BUCKETS // 2
    nf = jnp.maximum(n, 1).astype(jnp.float32)
    large = max_exact + (jnp.log(nf / max_exact) / math.log(REL_MAX_DIST / max_exact)
                         * (REL_BUCKETS - max_exact)).astype(jnp.int32)
    large = jnp.minimum(large, REL_BUCKETS - 1)
    return jnp.where(n < max_exact, n, large)


def rel_bias(dist, table):
    return jnp.moveaxis(table[t5_bucket(dist)].astype(jnp.float32), -1, 0)


def mla_attention(q_nope, q_rope, k_nope, k_rope, v):
    B_, T, H, _ = q_nope.shape
    scale = (MLA_NOPE + MLA_ROPE) ** -0.5
    kpos = jnp.arange(T)

    def block(i):
        start = i * SWEEP_BLOCK
        qn = lax.dynamic_slice_in_dim(q_nope, start, SWEEP_BLOCK, axis=1)
        qr = lax.dynamic_slice_in_dim(q_rope, start, SWEEP_BLOCK, axis=1)
        s = (jnp.einsum('bqhd,bkhd->bhqk', qn, k_nope)
             + jnp.einsum('bqhr,bkr->bhqk', qr, k_rope)).astype(jnp.float32) * scale
        qpos = start + jnp.arange(SWEEP_BLOCK)
        s = jnp.where(kpos[None, :] <= qpos[:, None], s, NEG_INF)
        p = jax.nn.softmax(s, axis=-1).astype(v.dtype)
        return jnp.einsum('bhqk,bkhd->bqhd', p, v)

    out = lax.map(block, jnp.arange(T // SWEEP_BLOCK))
    return out.transpose(1, 0, 2, 3, 4).reshape(B_, T, H, -1)


def swa_attention(q, k, v, sinks, rel_table):
    B_, T, Hq, D = q.shape
    Hkv = k.shape[2]
    G = Hq // Hkv
    nb = T // SWEEP_BLOCK
    Q = SWEEP_BLOCK
    qb = q.reshape(B_, nb, Q, Hkv, G, D)
    pad = ((0, 0), (Q, 0), (0, 0), (0, 0))
    kb = jnp.pad(k, pad).reshape(B_, nb + 1, Q, Hkv, D)
    vb = jnp.pad(v, pad).reshape(B_, nb + 1, Q, Hkv, D)
    kw = jnp.concatenate([kb[:, :-1], kb[:, 1:]], axis=2)
    vw = jnp.concatenate([vb[:, :-1], vb[:, 1:]], axis=2)
    s = jnp.einsum('bnqhgd,bnkhd->bhgnqk', qb, kw).astype(jnp.float32) * D ** -0.5
    qpos = jnp.arange(nb)[:, None] * Q + jnp.arange(Q)[None, :]
    kpos = (jnp.arange(nb)[:, None] - 1) * Q + jnp.arange(2 * Q)[None, :]
    dist = qpos[:, :, None] - kpos[:, None, :]
    valid = (dist >= 0) & (dist < SWA_WINDOW) & (kpos[:, None, :] >= 0)
    s = s + rel_bias(dist, rel_table).reshape(Hkv, G, nb, Q, 2 * Q)
    s = jnp.where(valid, s, NEG_INF)
    sink = jnp.broadcast_to(sinks.astype(jnp.float32).reshape(1, Hkv, G, 1, 1, 1), s.shape[:-1] + (1,))
    p = jax.nn.softmax(jnp.concatenate([s, sink], axis=-1), axis=-1)[..., :-1]
    out = jnp.einsum('bhgnqk,bnkhd->bnqhgd', p.astype(v.dtype), vw)
    return out.reshape(B_, T, Hq, D)


def moba_attention(q, k, v, rel_table):
    B_, T, H, D = q.shape
    L = MOBA_BLOCK
    nkb = -(-T // L)
    Tp = nkb * L
    topk = min(MOBA_TOPK, nkb)
    scale = D ** -0.5
    qh = q.transpose(0, 2, 1, 3)
    kp = jnp.pad(k.transpose(0, 2, 1, 3), ((0, 0), (0, 0), (0, Tp - T), (0, 0)))
    vp = jnp.pad(v.transpose(0, 2, 1, 3), ((0, 0), (0, 0), (0, Tp - T), (0, 0)))
    kblk = kp.reshape(B_, H, nkb, L, D)
    vblk = vp.reshape(B_, H, nkb, L, D)
    kmean = jnp.mean(kblk.astype(jnp.float32), axis=3)
    table_h = rel_table.T
    bi = jnp.arange(B_)[:, None, None, None]
    hi = jnp.arange(H)[None, :, None, None]
    Q = SWEEP_BLOCK

    def block(i):
        start = i * Q
        own = start // L
        qc = lax.dynamic_slice_in_dim(qh, start, Q, axis=2)
        qpos = start + jnp.arange(Q)
        gsc = jnp.einsum('bhqd,bhnd->bhqn', qc.astype(jnp.float32), kmean)
        gsc = jnp.where(jnp.arange(nkb) < own, gsc, NEG_INF)
        _, sel = lax.top_k(gsc, topk)
        sel_valid = sel < own
        ks = kblk[bi, hi, sel]
        vs = vblk[bi, hi, sel]
        s_sel = jnp.einsum('bhqd,bhqkld->bhqkl', qc, ks).astype(jnp.float32) * scale
        kpos_sel = sel[..., None] * L + jnp.arange(L)
        dist_sel = qpos[:, None, None] - kpos_sel
        s_sel = s_sel + table_h[hi[..., None], t5_bucket(dist_sel)].astype(jnp.float32)
        s_sel = jnp.where(sel_valid[..., None], s_sel, NEG_INF).reshape(B_, H, Q, topk * L)
        kown = lax.dynamic_slice_in_dim(kp, own * L, L, axis=2)
        vown = lax.dynamic_slice_in_dim(vp, own * L, L, axis=2)
        s_own = jnp.einsum('bhqd,bhld->bhql', qc, kown).astype(jnp.float32) * scale
        dist_own = qpos[:, None] - (own * L + jnp.arange(L))[None, :]
        s_own = s_own + rel_bias(dist_own, rel_table)[None]
        s_own = jnp.where(dist_own >= 0, s_own, NEG_INF)
        p = jax.nn.softmax(jnp.concatenate([s_sel, s_own], axis=-1), axis=-1)
        p_sel = p[..., : topk * L].reshape(B_, H, Q, topk, L).astype(v.dtype)
        p_own = p[..., topk * L:].astype(v.dtype)
        return (jnp.einsum('bhqkl,bhqkld->bhqd', p_sel, vs)
                + jnp.einsum('bhql,bhld->bhqd', p_own, vown))

    out = lax.map(block, jnp.arange(T // Q))
    return out.transpose(1, 0, 3, 2, 4).reshape(B_, T, H, D)


def stick_breaking_attention(q, k, v):
    B_, T, H, D = q.shape
    scale = D ** -0.5
    kpos = jnp.arange(T)

    def block(i):
        start = i * SWEEP_BLOCK
        qc = lax.dynamic_slice_in_dim(q, start, SWEEP_BLOCK, axis=1)
        z = jnp.einsum('bqhd,bkhd->bhqk', qc, k).astype(jnp.float32) * scale
        qpos = start + jnp.arange(SWEEP_BLOCK)
        past = kpos[None, :] < qpos[:, None]
        log_1m = jnp.where(past, jax.nn.log_sigmoid(-z), 0.0)
        after = lax.cumsum(log_1m, axis=3, reverse=True) - log_1m
        w = jnp.where(past, jnp.exp(jax.nn.log_sigmoid(z) + after), 0.0)
        return jnp.einsum('bhqk,bkhd->bqhd', w.astype(v.dtype), v)

    out = lax.map(block, jnp.arange(T // SWEEP_BLOCK))
    return out.transpose(1, 0, 2, 3, 4).reshape(B_, T, H, D)


def even_mixer(u, w_in, g_q, g_kv, w_qb, w_kvb, sinks, w_out, rel_table):
    B_, T, _ = u.shape
    cq, ckv, kr, qs, ks, vs = jnp.split(u @ w_in, SPLIT_EVEN, axis=-1)
    q = (rms_norm(cq, g_q) @ w_qb).reshape(B_, T, MLA_HEADS, MLA_NOPE + MLA_ROPE)
    kv = (rms_norm(ckv, g_kv) @ w_kvb).reshape(B_, T, MLA_HEADS, MLA_NOPE + MLA_V)
    o_a = mla_attention(q[..., :MLA_NOPE], rope(q[..., MLA_NOPE:]),
                        kv[..., :MLA_NOPE], rope(kr), kv[..., MLA_NOPE:]).reshape(B_, T, -1)
    o_b = swa_attention(qs.reshape(B_, T, SWA_HEADS, HEAD_DIM),
                        ks.reshape(B_, T, SWA_KV_HEADS, HEAD_DIM),
                        vs.reshape(B_, T, SWA_KV_HEADS, HEAD_DIM), sinks, rel_table).reshape(B_, T, -1)
    return jnp.concatenate([o_a, o_b], axis=-1) @ w_out


def odd_mixer(u, w_in, w_out, rel_table):
    B_, T, _ = u.shape
    parts = [p.reshape(B_, T, -1, HEAD_DIM) for p in jnp.split(u @ w_in, 6, axis=-1)]
    qc, kc, vc, qd, kd, vd = parts
    o_c = moba_attention(qc, kc, vc, rel_table).reshape(B_, T, -1)
    o_d = stick_breaking_attention(qd, kd, vd).reshape(B_, T, -1)
    return jnp.concatenate([o_c, o_d], axis=-1) @ w_out


def hier_moe(u, w_group, b_group, w_router, b_router, w_gate, w_up, w_down):
    B_, T, D = u.shape
    uf = u.reshape(-1, D)
    N = uf.shape[0]
    glog = (uf @ w_group).astype(jnp.float32) + b_group.astype(jnp.float32)
    gprob = jax.nn.softmax(glog, axis=-1)
    g_sel = jnp.argmax(glog, axis=-1)
    g_gate = jnp.take_along_axis(gprob, g_sel[:, None], axis=-1)
    elog = ((uf @ w_router).astype(jnp.float32) + b_router.astype(jnp.float32)).reshape(N, N_GROUPS, EXPERTS_PER_GROUP)
    elog_g = jnp.take_along_axis(elog, g_sel[:, None, None], axis=1)[:, 0]
    top_p, top_i = lax.top_k(jax.nn.softmax(elog_g, axis=-1), EXPERT_TOPK)
    top_p = top_p / jnp.sum(top_p, axis=-1, keepdims=True)
    expert_id = g_sel[:, None] * EXPERTS_PER_GROUP + top_i
    combine = jnp.sum(jax.nn.one_hot(expert_id, N_EXPERTS, dtype=jnp.float32)
                      * (g_gate * top_p)[..., None], axis=1)

    def chunk(args):
        xc, cc = args
        h = jax.nn.silu(jnp.einsum('nd,edf->nef', xc, w_gate)) * jnp.einsum('nd,edf->nef', xc, w_up)
        h = h * cc[..., None].astype(h.dtype)
        return jnp.einsum('nef,efd->nd', h, w_down)

    y = lax.map(chunk, (uf.reshape(-1, MOE_CHUNK, D), combine.reshape(-1, MOE_CHUNK, N_EXPERTS)))
    return y.reshape(B_, T, D)


def setup_inputs(seed: int = 0) -> dict:
    key = jax.random.key(seed)
    k = jax.random.split(key, 21)
    f32 = jnp.float32
    nrm = lambda kk, shape, fan_in: jax.random.normal(kk, shape, f32) * fan_in ** -0.5
    gain = lambda kk, shape: 1.0 + 0.05 * jax.random.normal(kk, shape, f32)
    return {
        "x": jax.random.normal(k[0], (BATCH, SEQ, D_MODEL), f32),
        "norm_mix": gain(k[1], (DEPTH, D_MODEL)),
        "norm_ffn": gain(k[2], (DEPTH, D_MODEL)),
        "norm_final": gain(k[3], (D_MODEL,)),
        "rel_bias_table": 0.3 * jax.random.normal(k[4], (REL_BUCKETS, REL_HEADS), f32),
        "w_in_even": nrm(k[5], (N_EVEN, D_MODEL, IN_EVEN), D_MODEL),
        "g_mla_q": gain(k[6], (N_EVEN, MLA_Q_RANK)),
        "g_mla_kv": gain(k[7], (N_EVEN, MLA_KV_RANK)),
        "w_mla_qb": nrm(k[8], (N_EVEN, MLA_Q_RANK, MLA_HEADS * (MLA_NOPE + MLA_ROPE)), MLA_Q_RANK),
        "w_mla_kvb": nrm(k[9], (N_EVEN, MLA_KV_RANK, MLA_HEADS * (MLA_NOPE + MLA_V)), MLA_KV_RANK),
        "swa_sinks": 0.5 * jax.random.normal(k[10], (N_EVEN, SWA_HEADS), f32),
        "w_out_even": nrm(k[11], (N_EVEN, MIX_EVEN, D_MODEL), MIX_EVEN),
        "w_in_odd": nrm(k[12], (N_ODD, D_MODEL, IN_ODD), D_MODEL),
        "w_out_odd": nrm(k[13], (N_ODD, MIX_ODD, D_MODEL), MIX_ODD),
        "moe_w_group": nrm(k[14], (DEPTH, D_MODEL, N_GROUPS), D_MODEL),
        "moe_b_group": 0.01 * jax.random.normal(k[15], (DEPTH, N_GROUPS), f32),
        "moe_w_router": nrm(k[16], (DEPTH, D_MODEL, N_EXPERTS), D_MODEL),
        "moe_b_router": 0.01 * jax.random.normal(k[17], (DEPTH, N_EXPERTS), f32),
        "moe_w_gate": nrm(k[18], (DEPTH, N_EXPERTS, D_MODEL, D_EXPERT), D_MODEL),
        "moe_w_up": nrm(k[19], (DEPTH, N_EXPERTS, D_MODEL, D_EXPERT), D_MODEL),
        "moe_w_down": nrm(k[20], (DEPTH, N_EXPERTS, D_EXPERT, D_MODEL), D_EXPERT),
    }


def reference(x, norm_mix, norm_ffn, norm_final, rel_bias_table, w_in_even, g_mla_q, g_mla_kv,
              w_mla_qb, w_mla_kvb, swa_sinks, w_out_even, w_in_odd, w_out_odd, moe_w_group,
              moe_b_group, moe_w_router, moe_b_router, moe_w_gate, moe_w_up, moe_w_down):
    h = x
    for layer in range(DEPTH):
        j = layer // 2
        u = rms_norm(h, norm_mix[layer])
        if layer % 2 == 0:
            h = h + even_mixer(u, w_in_even[j], g_mla_q[j], g_mla_kv[j], w_mla_qb[j], w_mla_kvb[j],
                               swa_sinks[j], w_out_even[j], rel_bias_table)
        else:
            h = h + odd_mixer(u, w_in_odd[j], w_out_odd[j], rel_bias_table)
        u = rms_norm(h, norm_ffn[layer])
        h = h + hier_moe(u, moe_w_group[layer], moe_b_group[layer], moe_w_router[layer], moe_b_router[layer],
                         moe_w_gate[layer], moe_w_up[layer], moe_w_down[layer])
    return rms_norm(h, norm_final)
```

```cpp
#include <hip/hip_runtime.h>
#include <stdint.h>
#include <math.h>
#include <cstdio>

constexpr int NB = 2, T_ = 8192, DM = 1024, NTOK = NB * T_;
constexpr float RMS_EPS = 1e-6f;
#define GAS __attribute__((address_space(1)))
#define LAS __attribute__((address_space(3)))
namespace pg8 {
#define PG8_LAS __attribute__((address_space(3)))
typedef unsigned short bf16_t;
typedef short bf16x8 __attribute__((ext_vector_type(8)));
typedef float f32x4 __attribute__((ext_vector_type(4)));
typedef unsigned u32x4 __attribute__((ext_vector_type(4)));
constexpr int BM = 256, BK = 64, HALF = 128, HTB = HALF * BK * 2  , STAGE_BYTES = 8 * HTB, NXCD = 8, WGM = 8;

__host__ __device__ __forceinline__ int lds_byte(int r, int c) { const int st = (r >> 4) * 2 + (c >> 5), rr = r & 15, cc = c & 31, ob = rr * 64 + cc * 2; return st * 1024 + (ob ^ (((ob >> 9) & 1) << 5)); }
__host__ __device__ __forceinline__ void stage_rc(int b, int& R, int& C) { const int st = b / 1024, sb = b % 1024, swz = sb ^ (((sb >> 9) & 1) << 5); R = (st >> 1) * 16 + swz / 64; C = (st & 1) * 32 + (swz % 64) / 2; }
__host__ __device__ __forceinline__ int perm32(int rho) { const int n = rho >> 4, i = rho & 15; return 8 * (i >> 2) + 4 * n + (i & 3); }

struct Unit { int pm, pn; };
struct Gemm { const bf16_t* A; const bf16_t* Bt; int M, N, K; };

struct StaticOrder {
    int nM, nN, nwg, G, c;
    __host__ __device__ void init(int M, int N, int G_, int c_) { nM = M / BM; nN = N / BM; nwg = nM * nN; G = G_; c = c_; }
    __host__ __device__ bool next(int i, Unit& u) const {
        const long L = (long)i * G + c; if (L >= nwg) return false;
        int wgid = (int)L; { const int q = nwg / NXCD, r = nwg % NXCD, xcd = wgid % NXCD, off = wgid / NXCD; wgid = (xcd < r ? xcd * (q + 1) : r * (q + 1) + (xcd - r) * q) + off; }
        const int nig = WGM * nN, gid = wgid / nig, fm = gid * WGM, gsz = (nM - fm) < WGM ? (nM - fm) : WGM;
        u.pm = fm + ((wgid % nig) % gsz); u.pn = (wgid % nig) / gsz; return true;
    }
    __device__ __forceinline__ void a_ready(const Unit&) const {}
    __device__ __forceinline__ void done(const Unit&) const {}
};

__device__ __forceinline__ unsigned cvt_pk_bf16(float lo, float hi) { unsigned r; asm volatile("v_cvt_pk_bf16_f32 %0, %1, %2" : "=v"(r) : "v"(lo), "v"(hi)); return r; }
template <class Epi, class Sched, bool ALIGN_EPI = false, bool SP2 = false>
__device__ __forceinline__ void gemm_phase(PG8_LAS unsigned char* lds, const Gemm g, const Sched& S, const Epi& E) {
    const int tid = threadIdx.x, wid = __builtin_amdgcn_readfirstlane(tid >> 6), lane = tid & 63, wr = wid >> 2, wc = wid & 3, fr = lane & 15, fq = lane >> 4;
    const int K = g.K, nt = K / BK;
    unsigned voffA[2], voffB[2];
#pragma unroll
    for (int i = 0; i < 2; ++i) { int R, C; stage_rc(tid * 16 + i * 8192, R, C); const int Rb = Epi::PERM ? ((R & ~31) + perm32(R & 31)) : R;
        voffA[i] = (unsigned)(R * K + C) * 2u; voffB[i] = (unsigned)(Rb * K + C) * 2u; }
    const size_t kstep = (size_t)(BK * 2);
    const size_t hstep = (size_t)HALF * K * 2;
    const size_t tstep = 2 * hstep;
    const unsigned ldsw = (unsigned)wid * 1024u;
    const int aoff = lds_byte(wr * 64 + fr, fq * 8), boff = lds_byte(wc * 32 + fr, fq * 8);
#define PG8_SA(b, h) (((b) * 2 + (h)) * HTB)
#define PG8_SB(b, h) ((4 + (b) * 2 + (h)) * HTB)
#define PG8_STAGE(bufoff, gbase, voff) do { _Pragma("unroll") for (int _i = 0; _i < 2; ++_i) \
        __builtin_amdgcn_global_load_lds((const unsigned*)((const char*)(gbase) + (voff)[_i]), (PG8_LAS unsigned*)(lds + (bufoff) + ldsw + _i * 8192), 16, 0, 0); } while (0)
#define PG8_LDA(dst, b, h) do { _Pragma("unroll") for (int m = 0; m < 4; ++m) _Pragma("unroll") for (int k = 0; k < 2; ++k) dst[m][k] = *(const PG8_LAS bf16x8*)(lds + PG8_SA(b, h) + aoff + m * 2048 + k * 1024); } while (0)
#define PG8_LDB(dst, b, h) do { _Pragma("unroll") for (int n = 0; n < 2; ++n) _Pragma("unroll") for (int k = 0; k < 2; ++k) dst[n][k] = *(const PG8_LAS bf16x8*)(lds + PG8_SB(b, h) + boff + n * 2048 + k * 1024); } while (0)
#define PG8_MMA(ai, bj, At, Bt) do { __builtin_amdgcn_s_setprio(1); _Pragma("unroll") for (int m = 0; m < 4; ++m) _Pragma("unroll") for (int n = 0; n < 2; ++n) _Pragma("unroll") for (int k = 0; k < 2; ++k) \
        acc[ai][bj][m][n] = __builtin_amdgcn_mfma_f32_16x16x32_bf16(Bt[n][k], At[m][k], acc[ai][bj][m][n], 0, 0, 0); __builtin_amdgcn_s_setprio(0); } while (0)
#define PG8_WAIT_V(n) asm volatile("s_waitcnt vmcnt(" #n ")" ::: "memory")
#define PG8_WAIT_L(n) asm volatile("s_waitcnt lgkmcnt(" #n ")" ::: "memory")
#define PG8_BAR __builtin_amdgcn_s_barrier()
#define PG8_SCHED __builtin_amdgcn_sched_barrier(0)
    Unit cur, nxt; int ui = 0;
    if (!S.next(0, cur)) return;
    f32x4 acc[2][2][4][2];
#pragma unroll
    for (int a = 0; a < 2; ++a)
#pragma unroll
        for (int b = 0; b < 2; ++b)
#pragma unroll
            for (int m = 0; m < 4; ++m)
#pragma unroll
                for (int n = 0; n < 2; ++n) acc[a][b][m][n] = (f32x4){0.f, 0.f, 0.f, 0.f};
    bf16x8 At[4][2], B0[2][2], B1[2][2];
    const char* cA = (const char*)g.A + (size_t)cur.pm * tstep; const char* cB = (const char*)g.Bt + (size_t)cur.pn * tstep;
    S.a_ready(cur);
    if constexpr (SP2) {
        PG8_STAGE(PG8_SB(0, 0), cB, voffB); PG8_STAGE(PG8_SB(0, 1), cB + hstep, voffB); PG8_STAGE(PG8_SA(0, 0), cA, voffA); PG8_STAGE(PG8_SA(0, 1), cA + hstep, voffA);
        if (wr == 1) PG8_BAR;
        PG8_WAIT_V(2); PG8_BAR;
        PG8_STAGE(PG8_SB(1, 0), cB + kstep, voffB); PG8_STAGE(PG8_SA(1, 0), cA + kstep, voffA); PG8_STAGE(PG8_SB(1, 1), cB + hstep + kstep, voffB);
        PG8_WAIT_V(6); PG8_BAR;
    } else {
        PG8_STAGE(PG8_SB(0, 0), cB, voffB); PG8_STAGE(PG8_SA(0, 0), cA, voffA); PG8_STAGE(PG8_SB(0, 1), cB + hstep, voffB); PG8_STAGE(PG8_SA(0, 1), cA + hstep, voffA);
        if (wr == 1) PG8_BAR;
        PG8_WAIT_V(4); PG8_BAR;
        PG8_STAGE(PG8_SB(1, 0), cB + kstep, voffB); PG8_STAGE(PG8_SA(1, 0), cA + kstep, voffA); PG8_STAGE(PG8_SB(1, 1), cB + hstep + kstep, voffB);
        PG8_WAIT_V(6); PG8_BAR;
    }
    for (;;) {
        const bool has_next = S.next(ui + 1, nxt);
        const char* nA = has_next ? (const char*)g.A + (size_t)nxt.pm * tstep : cA; const char* nB = has_next ? (const char*)g.Bt + (size_t)nxt.pn * tstep : cB;
        for (int t = 0; t < nt; t += 2) {
            const bool last = (t == nt - 2);
            const char* a1 = cA + (size_t)(t + 1) * kstep;
            const char* a2 = last ? nA : cA + (size_t)(t + 2) * kstep; const char* b2 = last ? nB : cB + (size_t)(t + 2) * kstep;
            const char* a3 = a2 + kstep; const char* b3 = b2 + kstep;
            if (last && has_next) S.a_ready(nxt);
            if constexpr (SP2) {
            PG8_LDB(B0, 0, 0); PG8_LDB(B1, 0, 1); PG8_SCHED; PG8_LDA(At, 0, 0); PG8_STAGE(PG8_SA(1, 1), a1 + hstep, voffA);
            PG8_WAIT_V(8); PG8_WAIT_L(0); PG8_BAR; PG8_MMA(0, 0, At, B0); PG8_MMA(0, 1, At, B1); PG8_BAR; PG8_SCHED;
            PG8_LDA(At, 0, 1); PG8_STAGE(PG8_SB(0, 0), b2, voffB); PG8_STAGE(PG8_SB(0, 1), b2 + hstep, voffB); PG8_STAGE(PG8_SA(0, 0), a2, voffA);
            PG8_WAIT_V(8); PG8_WAIT_L(0); PG8_BAR; PG8_MMA(1, 0, At, B0); PG8_MMA(1, 1, At, B1); PG8_BAR; PG8_SCHED;
            PG8_LDB(B0, 1, 0); PG8_LDB(B1, 1, 1); PG8_SCHED; PG8_LDA(At, 1, 0); PG8_STAGE(PG8_SA(0, 1), a2 + hstep, voffA);
            PG8_WAIT_V(8); PG8_WAIT_L(0); PG8_BAR; PG8_MMA(0, 0, At, B0); PG8_MMA(0, 1, At, B1); PG8_BAR; PG8_SCHED;
            PG8_LDA(At, 1, 1); PG8_STAGE(PG8_SB(1, 0), b3, voffB); PG8_STAGE(PG8_SB(1, 1), b3 + hstep, voffB); PG8_STAGE(PG8_SA(1, 0), a3, voffA);
            PG8_WAIT_V(8); PG8_WAIT_L(0); PG8_BAR; PG8_MMA(1, 0, At, B0); PG8_MMA(1, 1, At, B1); PG8_BAR; PG8_SCHED;
            } else {
            PG8_LDB(B0, 0, 0); PG8_SCHED; PG8_LDA(At, 0, 0); PG8_STAGE(PG8_SA(1, 1), a1 + hstep, voffA);
            PG8_WAIT_L(8); PG8_BAR; PG8_WAIT_L(0); PG8_MMA(0, 0, At, B0); PG8_BAR; PG8_SCHED;
            PG8_LDB(B1, 0, 1); PG8_STAGE(PG8_SB(0, 0), b2, voffB);
            PG8_BAR; PG8_WAIT_L(0); PG8_MMA(0, 1, At, B1); PG8_BAR;
            PG8_LDA(At, 0, 1); PG8_STAGE(PG8_SA(0, 0), a2, voffA);
            PG8_BAR; PG8_WAIT_L(0); PG8_MMA(1, 0, At, B0); PG8_BAR; PG8_SCHED;
            PG8_STAGE(PG8_SB(0, 1), b2 + hstep, voffB);
            PG8_WAIT_V(6); PG8_BAR; PG8_MMA(1, 1, At, B1); PG8_BAR;
            PG8_LDB(B0, 1, 0); PG8_SCHED; PG8_LDA(At, 1, 0); PG8_STAGE(PG8_SA(0, 1), a2 + hstep, voffA);
            PG8_WAIT_L(8); PG8_BAR; PG8_WAIT_L(0); PG8_MMA(0, 0, At, B0); PG8_BAR; PG8_SCHED;
            PG8_LDB(B1, 1, 1); PG8_STAGE(PG8_SB(1, 0), b3, voffB);
            PG8_BAR; PG8_WAIT_L(0); PG8_MMA(0, 1, At, B1); PG8_BAR;
            PG8_LDA(At, 1, 1); PG8_STAGE(PG8_SA(1, 0), a3, voffA);
            PG8_BAR; PG8_WAIT_L(0); PG8_MMA(1, 0, At, B0); PG8_BAR; PG8_SCHED;
            PG8_STAGE(PG8_SB(1, 1), b3 + hstep, voffB);
            PG8_WAIT_V(6); PG8_BAR; PG8_MMA(1, 1, At, B1); PG8_BAR;
            }
        }
        if constexpr (ALIGN_EPI) { if (wr == 0) PG8_BAR; }
        if constexpr (!Epi::AFTER_DRAIN) { E(acc, cur, wr, wc, fr, fq); S.done(cur); }
        if (!has_next) break;
#pragma unroll
        for (int a = 0; a < 2; ++a)
#pragma unroll
            for (int b = 0; b < 2; ++b)
#pragma unroll
                for (int m = 0; m < 4; ++m)
#pragma unroll
                    for (int n = 0; n < 2; ++n) acc[a][b][m][n] = (f32x4){0.f, 0.f, 0.f, 0.f};
        cur = nxt; cA = nA; cB = nB; ++ui;
        if constexpr (ALIGN_EPI) { if (wr == 1) PG8_BAR; }
    }
    PG8_WAIT_V(0);
    if constexpr (!ALIGN_EPI) { if (wr == 0) PG8_BAR; }
    PG8_BAR;
    if constexpr (Epi::AFTER_DRAIN) { E.fused(acc, cur, wr, wc, fr, fq, lds, wid, lane); S.done(cur); }
#undef PG8_SA
#undef PG8_SB
#undef PG8_STAGE
#undef PG8_LDA
#undef PG8_LDB
#undef PG8_MMA
#undef PG8_WAIT_V
#undef PG8_WAIT_L
#undef PG8_BAR
#undef PG8_SCHED
}

template <class Epi, class Sched, bool ALIGN_EPI = false, bool SP2 = false>
__device__ __forceinline__ void gemm_phase_g(PG8_LAS unsigned char* lds, const Gemm g, const Sched& S, const Epi& E) {
    const int tid = threadIdx.x, wid = __builtin_amdgcn_readfirstlane(tid >> 6), lane = tid & 63, wr = wid >> 2, wc = wid & 3, fr = lane & 15, fq = lane >> 4;
    const int K = g.K, nt = K / BK;
    unsigned voffA[2], voffB[2]; int RA[2], CA[2]; (void)voffA;
#pragma unroll
    for (int i = 0; i < 2; ++i) { int R, C; stage_rc(tid * 16 + i * 8192, R, C); const int Rb = Epi::PERM ? ((R & ~31) + perm32(R & 31)) : R;
        voffA[i] = (unsigned)(R * K + C) * 2u; voffB[i] = (unsigned)(Rb * K + C) * 2u; RA[i] = R; CA[i] = C; }
    const size_t kstep = (size_t)(BK * 2);
    const size_t hstep = (size_t)HALF * K * 2;
    const size_t tstep = 2 * hstep;
    const unsigned ldsw = (unsigned)wid * 1024u;
    const int aoff = lds_byte(wr * 64 + fr, fq * 8), boff = lds_byte(wc * 32 + fr, fq * 8);
#define PG8_SA(b, h) (((b) * 2 + (h)) * HTB)
#define PG8_SB(b, h) ((4 + (b) * 2 + (h)) * HTB)
#define PG8_STAGE(bufoff, gbase, voff) do { _Pragma("unroll") for (int _i = 0; _i < 2; ++_i) \
        __builtin_amdgcn_global_load_lds((const unsigned*)((const char*)(gbase) + (voff)[_i]), (PG8_LAS unsigned*)(lds + (bufoff) + ldsw + _i * 8192), 16, 0, 0); } while (0)
#define PG8_LDA(dst, b, h) do { _Pragma("unroll") for (int m = 0; m < 4; ++m) _Pragma("unroll") for (int k = 0; k < 2; ++k) dst[m][k] = *(const PG8_LAS bf16x8*)(lds + PG8_SA(b, h) + aoff + m * 2048 + k * 1024); } while (0)
#define PG8_LDB(dst, b, h) do { _Pragma("unroll") for (int n = 0; n < 2; ++n) _Pragma("unroll") for (int k = 0; k < 2; ++k) dst[n][k] = *(const PG8_LAS bf16x8*)(lds + PG8_SB(b, h) + boff + n * 2048 + k * 1024); } while (0)
#define PG8_MMA(ai, bj, At, Bt) do { __builtin_amdgcn_s_setprio(1); _Pragma("unroll") for (int m = 0; m < 4; ++m) _Pragma("unroll") for (int n = 0; n < 2; ++n) _Pragma("unroll") for (int k = 0; k < 2; ++k) \
        acc[ai][bj][m][n] = __builtin_amdgcn_mfma_f32_16x16x32_bf16(Bt[n][k], At[m][k], acc[ai][bj][m][n], 0, 0, 0); __builtin_amdgcn_s_setprio(0); } while (0)
#define PG8_WAIT_V(n) asm volatile("s_waitcnt vmcnt(" #n ")" ::: "memory")
#define PG8_WAIT_L(n) asm volatile("s_waitcnt lgkmcnt(" #n ")" ::: "memory")
#define PG8_BAR __builtin_amdgcn_s_barrier()
#define PG8_SCHED __builtin_amdgcn_sched_barrier(0)
    Unit cur, nxt; int ui = 0;
    if (!S.next(0, cur)) return;
    f32x4 acc[2][2][4][2];
#pragma unroll
    for (int a = 0; a < 2; ++a)
#pragma unroll
        for (int b = 0; b < 2; ++b)
#pragma unroll
            for (int m = 0; m < 4; ++m)
#pragma unroll
                for (int n = 0; n < 2; ++n) acc[a][b][m][n] = (f32x4){0.f, 0.f, 0.f, 0.f};
    bf16x8 At[4][2], B0[2][2], B1[2][2];
    const char* cA = (const char*)g.A; const char* cB = (const char*)g.Bt + (size_t)cur.pn * tstep;
    unsigned gC[2][2], gN[2][2];
#pragma unroll
    for (int h = 0; h < 2; ++h)
#pragma unroll
        for (int i = 0; i < 2; ++i) gC[h][i] = S.goff(cur, h, RA[i], CA[i]);
    S.a_ready(cur);
    if constexpr (SP2) {
        PG8_STAGE(PG8_SB(0, 0), cB, voffB); PG8_STAGE(PG8_SB(0, 1), cB + hstep, voffB); PG8_STAGE(PG8_SA(0, 0), cA, gC[0]); PG8_STAGE(PG8_SA(0, 1), cA, gC[1]);
        if (wr == 1) PG8_BAR;
        PG8_WAIT_V(2); PG8_BAR;
        PG8_STAGE(PG8_SB(1, 0), cB + kstep, voffB); PG8_STAGE(PG8_SA(1, 0), cA + kstep, gC[0]); PG8_STAGE(PG8_SB(1, 1), cB + hstep + kstep, voffB);
        PG8_WAIT_V(6); PG8_BAR;
    } else {
        PG8_STAGE(PG8_SB(0, 0), cB, voffB); PG8_STAGE(PG8_SA(0, 0), cA, gC[0]); PG8_STAGE(PG8_SB(0, 1), cB + hstep, voffB); PG8_STAGE(PG8_SA(0, 1), cA, gC[1]);
        if (wr == 1) PG8_BAR;
        PG8_WAIT_V(4); PG8_BAR;
        PG8_STAGE(PG8_SB(1, 0), cB + kstep, voffB); PG8_STAGE(PG8_SA(1, 0), cA + kstep, gC[0]); PG8_STAGE(PG8_SB(1, 1), cB + hstep + kstep, voffB);
        PG8_WAIT_V(6); PG8_BAR;
    }
    for (;;) {
        const bool has_next = S.next(ui + 1, nxt);
        const char* nA = cA; const char* nB = has_next ? (const char*)g.Bt + (size_t)nxt.pn * tstep : cB;
#pragma unroll
        for (int h = 0; h < 2; ++h)
#pragma unroll
            for (int i = 0; i < 2; ++i) gN[h][i] = has_next ? S.goff(nxt, h, RA[i], CA[i]) : gC[h][i];
        for (int t = 0; t < nt; t += 2) {
            const bool last = (t == nt - 2);
            const char* a1 = cA + (size_t)(t + 1) * kstep;
            const char* a2 = last ? nA : cA + (size_t)(t + 2) * kstep; const char* b2 = last ? nB : cB + (size_t)(t + 2) * kstep;
            const char* a3 = a2 + kstep; const char* b3 = b2 + kstep;
            unsigned g0[2], g1[2]; g0[0] = last ? gN[0][0] : gC[0][0]; g0[1] = last ? gN[0][1] : gC[0][1]; g1[0] = last ? gN[1][0] : gC[1][0]; g1[1] = last ? gN[1][1] : gC[1][1];
            if (last && has_next) S.a_ready(nxt);
            if constexpr (SP2) {
            PG8_LDB(B0, 0, 0); PG8_LDB(B1, 0, 1); PG8_SCHED; PG8_LDA(At, 0, 0); PG8_STAGE(PG8_SA(1, 1), a1, gC[1]);
            PG8_WAIT_V(8); PG8_WAIT_L(0); PG8_BAR; PG8_MMA(0, 0, At, B0); PG8_MMA(0, 1, At, B1); PG8_BAR; PG8_SCHED;
            PG8_LDA(At, 0, 1); PG8_STAGE(PG8_SB(0, 0), b2, voffB); PG8_STAGE(PG8_SB(0, 1), b2 + hstep, voffB); PG8_STAGE(PG8_SA(0, 0), a2, g0);
            PG8_WAIT_V(8); PG8_WAIT_L(0); PG8_BAR; PG8_MMA(1, 0, At, B0); PG8_MMA(1, 1, At, B1); PG8_BAR; PG8_SCHED;
            PG8_LDB(B0, 1, 0); PG8_LDB(B1, 1, 1); PG8_SCHED; PG8_LDA(At, 1, 0); PG8_STAGE(PG8_SA(0, 1), a2, g1);
            PG8_WAIT_V(8); PG8_WAIT_L(0); PG8_BAR; PG8_MMA(0, 0, At, B0); PG8_MMA(0, 1, At, B1); PG8_BAR; PG8_SCHED;
            PG8_LDA(At, 1, 1); PG8_STAGE(PG8_SB(1, 0), b3, voffB); PG8_STAGE(PG8_SB(1, 1), b3 + hstep, voffB); PG8_STAGE(PG8_SA(1, 0), a3, g0);
            PG8_WAIT_V(8); PG8_WAIT_L(0); PG8_BAR; PG8_MMA(1, 0, At, B0); PG8_MMA(1, 1, At, B1); PG8_BAR; PG8_SCHED;
            } else {
            PG8_LDB(B0, 0, 0); PG8_SCHED; PG8_LDA(At, 0, 0); PG8_STAGE(PG8_SA(1, 1), a1, gC[1]);
            PG8_WAIT_L(8); PG8_BAR; PG8_WAIT_L(0); PG8_MMA(0, 0, At, B0); PG8_BAR; PG8_SCHED;
            PG8_LDB(B1, 0, 1); PG8_STAGE(PG8_SB(0, 0), b2, voffB);
            PG8_BAR; PG8_WAIT_L(0); PG8_MMA(0, 1, At, B1); PG8_BAR;
            PG8_LDA(At, 0, 1); PG8_STAGE(PG8_SA(0, 0), a2, g0);
            PG8_BAR; PG8_WAIT_L(0); PG8_MMA(1, 0, At, B0); PG8_BAR; PG8_SCHED;
            PG8_STAGE(PG8_SB(0, 1), b2 + hstep, voffB);
            PG8_WAIT_V(6); PG8_BAR; PG8_MMA(1, 1, At, B1); PG8_BAR;
            PG8_LDB(B0, 1, 0); PG8_SCHED; PG8_LDA(At, 1, 0); PG8_STAGE(PG8_SA(0, 1), a2, g1);
            PG8_WAIT_L(8); PG8_BAR; PG8_WAIT_L(0); PG8_MMA(0, 0, At, B0); PG8_BAR; PG8_SCHED;
            PG8_LDB(B1, 1, 1); PG8_STAGE(PG8_SB(1, 0), b3, voffB);
            PG8_BAR; PG8_WAIT_L(0); PG8_MMA(0, 1, At, B1); PG8_BAR;
            PG8_LDA(At, 1, 1); PG8_STAGE(PG8_SA(1, 0), a3, g0);
            PG8_BAR; PG8_WAIT_L(0); PG8_MMA(1, 0, At, B0); PG8_BAR; PG8_SCHED;
            PG8_STAGE(PG8_SB(1, 1), b3 + hstep, voffB);
            PG8_WAIT_V(6); PG8_BAR; PG8_MMA(1, 1, At, B1); PG8_BAR;
            }
        }
        if constexpr (ALIGN_EPI) { if (wr == 0) PG8_BAR; }
        if constexpr (!Epi::AFTER_DRAIN) { E(acc, cur, wr, wc, fr, fq); S.done(cur); }
        if (!has_next) break;
#pragma unroll
        for (int a = 0; a < 2; ++a)
#pragma unroll
            for (int b = 0; b < 2; ++b)
#pragma unroll
                for (int m = 0; m < 4; ++m)
#pragma unroll
                    for (int n = 0; n < 2; ++n) acc[a][b][m][n] = (f32x4){0.f, 0.f, 0.f, 0.f};
        cur = nxt; cA = nA; cB = nB; ++ui;
#pragma unroll
        for (int h = 0; h < 2; ++h)
#pragma unroll
            for (int i = 0; i < 2; ++i) gC[h][i] = gN[h][i];
        if constexpr (ALIGN_EPI) { if (wr == 1) PG8_BAR; }
    }
    PG8_WAIT_V(0);
    if constexpr (!ALIGN_EPI) { if (wr == 0) PG8_BAR; }
    PG8_BAR;
    if constexpr (Epi::AFTER_DRAIN) { E.fused(acc, cur, wr, wc, fr, fq, lds, wid, lane); S.done(cur); }
#undef PG8_SA
#undef PG8_SB
#undef PG8_STAGE
#undef PG8_LDA
#undef PG8_LDB
#undef PG8_MMA
#undef PG8_WAIT_V
#undef PG8_WAIT_L
#undef PG8_BAR
#undef PG8_SCHED
}
}
#define XB_TMO      128
#define XB_XCNT(j)  (256  + 64 * (j))
#define XB_XSUB(j)  (1280 + 64 * (j))
#define XB_XGEN(j)  (2304 + 64 * (j))
#define XB_TOP      3328
#define XB_TOPGEN   3392
#define XCD_BAR_WORDS 3456
#define XB_SPIN_CAP (1u << 18)

__device__ __forceinline__ unsigned xb_ld(unsigned* p)              { return __hip_atomic_load(p, __ATOMIC_RELAXED, __HIP_MEMORY_SCOPE_AGENT); }
__device__ __forceinline__ unsigned xb_add(unsigned* p, unsigned v) { return __hip_atomic_fetch_add(p, v, __ATOMIC_RELAXED, __HIP_MEMORY_SCOPE_AGENT); }
__device__ __forceinline__ unsigned xb_xcc_id() { return (unsigned)__builtin_amdgcn_s_getreg((3 << 11) | 20) & 0xFu; }
#define XB_SPIN(cond, bar) do { unsigned _sp = 0; while (cond) { __builtin_amdgcn_s_sleep(1); \
    if ((++_sp & 255u) == 0u) { if (xb_ld(&(bar)[XB_TMO])) break; if (_sp > XB_SPIN_CAP) { atomicAdd(&(bar)[XB_TMO], 1u); break; } } } } while (0)

struct XcdBarrier {
    unsigned* bar; unsigned x;
    volatile LAS unsigned* st;
};

__device__ __forceinline__ XcdBarrier xcd_barrier_post(unsigned* bar, volatile LAS unsigned* st) {
    XcdBarrier b; b.bar = bar; b.x = xb_xcc_id(); b.st = st;
    if (threadIdx.x == 0) (void)xb_add(&bar[XB_XCNT(b.x)], 1u);
    return b;
}
__device__ __forceinline__ void xcd_barrier_complete(unsigned* bar, unsigned x, unsigned& nloc, unsigned& nx) {
    const unsigned G = gridDim.x * gridDim.y * gridDim.z;
    unsigned sum, cnt, mine, sp = 0u;
    for (;;) {
        sum = 0u; cnt = 0u; mine = 0u;
#pragma unroll
        for (unsigned j = 0; j < 16; ++j) { const unsigned c = xb_ld(&bar[XB_XCNT(j)]); sum += c; cnt += (c > 0u) ? 1u : 0u; mine = (j == x) ? c : mine; }
        if (sum == G) break;
        __builtin_amdgcn_s_sleep(1);
        if ((++sp & 255u) == 0u) { if (xb_ld(&bar[XB_TMO])) break; if (sp > XB_SPIN_CAP) { atomicAdd(&bar[XB_TMO], 1u); break; } }
    }
    nloc = mine > 0u ? mine : 1u; nx = cnt > 0u ? cnt : 1u;
}

__device__ __forceinline__ void xcd_barrier(const XcdBarrier& b) {
    asm volatile("s_waitcnt vmcnt(0)" ::: "memory");
    __syncthreads();
    if (threadIdx.x == 0) {
        unsigned* bar = b.bar;
        __builtin_amdgcn_s_waitcnt(0);
        unsigned nloc = b.st[0], nx = b.st[1];
        if (nloc == 0u) { xcd_barrier_complete(bar, b.x, nloc, nx); b.st[0] = nloc; b.st[1] = nx; }
        const unsigned old = xb_add(&bar[XB_XSUB(b.x)], 1u);
        const unsigned gen = old / nloc;
        if (old + 1u == (gen + 1u) * nloc) {
            __builtin_amdgcn_fence(__ATOMIC_RELEASE, "agent");
            asm volatile("s_waitcnt vmcnt(0)" ::: "memory");
            const unsigned og = xb_add(&bar[XB_TOP], 1u);
            const unsigned tg = og / nx;
            if (og + 1u == (tg + 1u) * nx) xb_add(&bar[XB_TOPGEN], 1u);
            else XB_SPIN(xb_ld(&bar[XB_TOPGEN]) == tg, bar);
            __builtin_amdgcn_fence(__ATOMIC_ACQUIRE, "agent");
            xb_add(&bar[XB_XGEN(b.x)], 1u);
            asm volatile("s_waitcnt vmcnt(0)" ::: "memory");
        } else {
            XB_SPIN(xb_ld(&bar[XB_XGEN(b.x)]) == gen, bar);
            __builtin_amdgcn_fence(__ATOMIC_ACQUIRE, "agent");
            asm volatile("s_waitcnt vmcnt(0)" ::: "memory");
        }
    }
    __syncthreads();
}

typedef unsigned short bf16;
typedef unsigned v4u __attribute__((ext_vector_type(4)));
typedef unsigned v2u __attribute__((ext_vector_type(2)));
typedef float f32x4 __attribute__((ext_vector_type(4)));
typedef float f32x2 __attribute__((ext_vector_type(2)));
typedef float f32x16 __attribute__((ext_vector_type(16)));
typedef short bf16x8 __attribute__((ext_vector_type(8)));
typedef short s16x4 __attribute__((ext_vector_type(4)));
#define LDS_WAIT() asm volatile("s_waitcnt lgkmcnt(0)" ::: "memory")
#define VM_WAIT() asm volatile("s_waitcnt vmcnt(0)" ::: "memory")
__device__ __forceinline__ unsigned f2bf(float f) { unsigned u = __builtin_bit_cast(unsigned, f); return (u + 0x7fffu + ((u >> 16) & 1u)) >> 16; }
__device__ __forceinline__ unsigned pk2(float lo, float hi) { return f2bf(lo) | (f2bf(hi) << 16); }
__device__ __forceinline__ float bf2f(unsigned short b) { return __builtin_bit_cast(float, (unsigned)b << 16); }
__device__ __forceinline__ float bflo(unsigned w) { return __builtin_bit_cast(float, w << 16); }
__device__ __forceinline__ float bfhi(unsigned w) { return __builtin_bit_cast(float, w & 0xffff0000u); }

constexpr int NWAVES = 8;
constexpr float LOG2E = 1.4426950408889634f;
constexpr size_t MiB = 1u << 20;
constexpr size_t WS_CTL = 0, CTL_ZERO_BYTES = 1 * MiB;
constexpr size_t WS_BIAS = 1 * MiB;
constexpr size_t WS_KMEAN = 1 * MiB + 256 * 1024;
constexpr size_t WS_ROPE = 1 * MiB + 512 * 1024;
constexpr size_t WS_TOKINFO = 2 * MiB + 512 * 1024;
constexpr size_t WS_ROWW = 2 * MiB + 768 * 1024;
constexpr size_t WS_WRT = 3 * MiB;
constexpr size_t WS_WINE = 4 * MiB;
constexpr size_t WS_WQB = 6 * MiB + 512 * 1024;
constexpr size_t WS_WKVB = 7 * MiB;
constexpr size_t WS_WOE = 8 * MiB;
constexpr size_t WS_WINO = 10 * MiB;
constexpr size_t WS_WOO = 16 * MiB;
constexpr size_t WS_MOEW = 18 * MiB;
constexpr size_t WS_U = 114 * MiB;
constexpr size_t WS_PROJ0 = 146 * MiB;
constexpr size_t WS_CQN = 186 * MiB;
constexpr size_t WS_CKVN = 194 * MiB;
constexpr size_t WS_KR = 198 * MiB;
constexpr size_t WS_Q = 200 * MiB;
constexpr size_t WS_KVB = 224 * MiB;
constexpr size_t WS_XG = 146 * MiB;
constexpr size_t WS_HH = 226 * MiB;
constexpr size_t WS_PROJ1 = 146 * MiB;
constexpr size_t WS_MBLIST = 256 * MiB;
constexpr size_t WS_PARTO = 18 * MiB;
constexpr size_t WS_PARTML = 242 * MiB;
constexpr size_t WS_EL = 246 * MiB;
constexpr size_t WS_EW = 250 * MiB;
constexpr size_t WS_END = 272 * MiB;
constexpr int CW_BAR = 4096;
constexpr int CW_ECNT = 65536;
constexpr int CW_MBCNT = 131072;
constexpr int CW_HCNT = 147456;
constexpr int CW_TICK = 200000;
constexpr int CW_TMO = 16;
constexpr int RING_OFF = 0, RING_BYTES = 131072;
constexpr int MISC_OFF = RING_BYTES + 320;
constexpr int LDS_BYTES = 147456;

struct Params { const float* in[21]; float* out; unsigned char* ws; int ph_lo, ph_hi, li, pad; };

__device__ __forceinline__ void transpose_item(const float* W, int ldw, int k0, int n0, bf16* WTrow0, int ldk, LAS float* scr, int lane) {
#pragma unroll 8
    for (int i = 0; i < 32; ++i) { const int kk = 2 * i + (lane >> 5); scr[kk * 33 + (lane & 31)] = W[(size_t)(k0 + kk) * ldw + n0 + (lane & 31)]; }
    LDS_WAIT(); asm volatile("" ::: "memory");
    const int c = lane & 7;
#pragma unroll
    for (int j = 0; j < 4; ++j) { const int n = (lane >> 3) + 8 * j; const LAS float* s = scr + (8 * c) * 33 + n;
        v4u o; o.x = pk2(s[0 * 33], s[1 * 33]); o.y = pk2(s[2 * 33], s[3 * 33]); o.z = pk2(s[4 * 33], s[5 * 33]); o.w = pk2(s[6 * 33], s[7 * 33]);
        *(v4u*)(WTrow0 + (size_t)n * ldk + k0 + 8 * c) = o; }
    LDS_WAIT(); asm volatile("" ::: "memory");
}
__device__ __forceinline__ float wsum(float v) {
#pragma unroll
    for (int o = 1; o < 64; o <<= 1) v += __shfl_xor(v, o);
    return v;
}
__device__ __forceinline__ void rms_row_to_bf16(const float* xrow, const float* gain, bf16* orow, int lane) {
    const f32x4* xr = (const f32x4*)xrow + lane; const f32x4* gr = (const f32x4*)gain + lane;
    f32x4 v[4]; float s = 0.f;
#pragma unroll
    for (int j = 0; j < 4; ++j) { v[j] = xr[64 * j]; s += (v[j].x * v[j].x + v[j].y * v[j].y) + (v[j].z * v[j].z + v[j].w * v[j].w); }
    const float r = 1.0f / sqrtf(wsum(s) * (1.f / 1024.f) + RMS_EPS);
    unsigned long long* o8 = (unsigned long long*)orow + lane;
#pragma unroll
    for (int j = 0; j < 4; ++j) { const f32x4 g = gr[64 * j];
        o8[64 * j] = (unsigned long long)pk2(v[j].x * r * g.x, v[j].y * r * g.y) | ((unsigned long long)pk2(v[j].z * r * g.z, v[j].w * r * g.w) << 32); }
}

__device__ __forceinline__ void rms_rows2_to_bf16(const float* x0, const float* x1, const float* gain, bf16* o0, bf16* o1, int lane) {
    const f32x4* xa = (const f32x4*)x0 + lane; const f32x4* xb = (const f32x4*)x1 + lane; const f32x4* gr = (const f32x4*)gain + lane;
    f32x4 va[4], vb[4]; float sa = 0.f, sb = 0.f;
#pragma unroll
    for (int j = 0; j < 4; ++j) { va[j] = xa[64 * j]; vb[j] = xb[64 * j]; }
#pragma unroll
    for (int j = 0; j < 4; ++j) { sa += (va[j].x * va[j].x + va[j].y * va[j].y) + (va[j].z * va[j].z + va[j].w * va[j].w); sb += (vb[j].x * vb[j].x + vb[j].y * vb[j].y) + (vb[j].z * vb[j].z + vb[j].w * vb[j].w); }
#pragma unroll
    for (int o = 1; o < 64; o <<= 1) { sa += __shfl_xor(sa, o); sb += __shfl_xor(sb, o); }
    const float ra = 1.0f / sqrtf(sa * (1.f / 1024.f) + RMS_EPS), rb = 1.0f / sqrtf(sb * (1.f / 1024.f) + RMS_EPS);
    unsigned long long* pa = (unsigned long long*)o0 + lane; unsigned long long* pb = (unsigned long long*)o1 + lane;
#pragma unroll
    for (int j = 0; j < 4; ++j) { const f32x4 g = gr[64 * j];
        pa[64 * j] = (unsigned long long)pk2(va[j].x * ra * g.x, va[j].y * ra * g.y) | ((unsigned long long)pk2(va[j].z * ra * g.z, va[j].w * ra * g.w) << 32);
        pb[64 * j] = (unsigned long long)pk2(vb[j].x * rb * g.x, vb[j].y * rb * g.y) | ((unsigned long long)pk2(vb[j].z * rb * g.z, vb[j].w * rb * g.w) << 32); }
}
struct EpiStore {
    static constexpr bool PERM = true, AFTER_DRAIN = false;
    bf16* O; int ldc; int pnmask;
    __device__ __forceinline__ void operator()(const pg8::f32x4 (&acc)[2][2][4][2], const pg8::Unit& u, int wr, int wc, int fr, int fq) const {
        const int row0 = u.pm * 256 + wr * 64 + fr, col0 = (u.pn & pnmask) * 256 + wc * 32 + 8 * fq;
#pragma unroll
        for (int ai = 0; ai < 2; ++ai)
#pragma unroll
            for (int m = 0; m < 4; ++m) { bf16* rowp = O + (size_t)(row0 + ai * 128 + m * 16) * ldc + col0;
#pragma unroll
                for (int bj = 0; bj < 2; ++bj) { const pg8::f32x4 v0 = acc[ai][bj][m][0], v1 = acc[ai][bj][m][1];
                    v4u w; w.x = pg8::cvt_pk_bf16(v0[0], v0[1]); w.y = pg8::cvt_pk_bf16(v0[2], v0[3]); w.z = pg8::cvt_pk_bf16(v1[0], v1[1]); w.w = pg8::cvt_pk_bf16(v1[2], v1[3]);
                    *(v4u*)(rowp + bj * 128) = w; } }
    }
};

struct EpiQRope {
    static constexpr bool PERM = false, AFTER_DRAIN = false;
    bf16* O; const f32x2* rope;
    __device__ __forceinline__ void operator()(const pg8::f32x4 (&acc)[2][2][4][2], const pg8::Unit& u, int wr, int wc, int fr, int fq) const {
        const int row0 = u.pm * 256 + wr * 64 + fr;
#pragma unroll
        for (int ai = 0; ai < 2; ++ai)
#pragma unroll
            for (int m = 0; m < 4; ++m) { const int row = row0 + ai * 128 + m * 16, t = row & 8191; asm volatile("" ::: "memory");
#pragma unroll
                for (int bj = 0; bj < 2; ++bj) { const int colg = u.pn * 256 + bj * 128 + wc * 32;
                    pg8::f32x4 v0 = acc[ai][bj][m][0], v1 = acc[ai][bj][m][1];
                    if (((colg >> 5) % 3) == 2) {
                        const f32x4* rp = (const f32x4*)(rope + (size_t)t * 16 + 4 * fq); const f32x4 a = rp[0], b = rp[1];
                        const pg8::f32x4 x1 = v0, x2 = v1;
                        v0[0] = x1[0] * a.x - x2[0] * a.y; v1[0] = x2[0] * a.x + x1[0] * a.y;
                        v0[1] = x1[1] * a.z - x2[1] * a.w; v1[1] = x2[1] * a.z + x1[1] * a.w;
                        v0[2] = x1[2] * b.x - x2[2] * b.y; v1[2] = x2[2] * b.x + x1[2] * b.y;
                        v0[3] = x1[3] * b.z - x2[3] * b.w; v1[3] = x2[3] * b.z + x1[3] * b.w;
                    }
                    bf16* op = O + (size_t)row * 768 + colg + 4 * fq;
                    v2u w0, w1; w0.x = pg8::cvt_pk_bf16(v0[0], v0[1]); w0.y = pg8::cvt_pk_bf16(v0[2], v0[3]); w1.x = pg8::cvt_pk_bf16(v1[0], v1[1]); w1.y = pg8::cvt_pk_bf16(v1[2], v1[3]);
                    *(v2u*)op = w0; *(v2u*)(op + 16) = w1; } }
    }
};
struct EpiResid {
    static constexpr bool PERM = true, AFTER_DRAIN = false;
    const float* X; float* OUT;
    __device__ __forceinline__ void operator()(const pg8::f32x4 (&acc)[2][2][4][2], const pg8::Unit& u, int wr, int wc, int fr, int fq) const {
        const int row0 = u.pm * 256 + wr * 64 + fr, col0 = u.pn * 256 + wc * 32 + 8 * fq;
#pragma unroll
        for (int ai = 0; ai < 2; ++ai)
#pragma unroll
            for (int m = 0; m < 4; ++m) { const size_t off = (size_t)(row0 + ai * 128 + m * 16) * 1024 + col0;
#pragma unroll
                for (int bj = 0; bj < 2; ++bj) { const f32x4* xp = (const f32x4*)(X + off + bj * 128); f32x4* op = (f32x4*)(OUT + off + bj * 128);
                    const f32x4 x0 = xp[0], x1 = xp[1]; const pg8::f32x4 v0 = acc[ai][bj][m][0], v1 = acc[ai][bj][m][1];
                    op[0] = (f32x4){x0.x + v0[0], x0.y + v0[1], x0.z + v0[2], x0.w + v0[3]};
                    op[1] = (f32x4){x1.x + v1[0], x1.y + v1[1], x1.z + v1[2], x1.w + v1[3]}; } }
    }
};

struct EpiSwiGLU {
    static constexpr bool PERM = true, AFTER_DRAIN = false;
    bf16* HH; const f32x2* EW; const LAS unsigned char* t2e; const LAS int* seg;
    __device__ __forceinline__ void operator()(const pg8::f32x4 (&acc)[2][2][4][2], const pg8::Unit& u, int wr, int wc, int fr, int fq) const {
        const int row0 = u.pm * 256 + wr * 64 + fr, j = u.pn & 1, col0 = j * 128 + wc * 32 + 8 * fq;
        const int e_ = __builtin_amdgcn_readfirstlane((int)t2e[u.pm]); const f32x2* roww = EW + (size_t)e_ * 16384 - __builtin_amdgcn_readfirstlane(seg[e_]);
#pragma unroll
        for (int ai = 0; ai < 2; ++ai)
#pragma unroll
            for (int m = 0; m < 4; ++m) { const int row = row0 + ai * 128 + m * 16; const f32x2 wr2 = roww[row]; const float w = wr2.x, rr = wr2.y;
                float hv[8];
#pragma unroll
                for (int n = 0; n < 2; ++n)
#pragma unroll
                    for (int k = 0; k < 4; ++k) { const float g = acc[ai][0][m][n][k] * rr, up = acc[ai][1][m][n][k] * rr;
                        hv[4 * n + k] = g * __builtin_amdgcn_rcpf(1.0f + __builtin_amdgcn_exp2f(-g * LOG2E)) * up * w; }
                v4u o; o.x = pg8::cvt_pk_bf16(hv[0], hv[1]); o.y = pg8::cvt_pk_bf16(hv[2], hv[3]); o.z = pg8::cvt_pk_bf16(hv[4], hv[5]); o.w = pg8::cvt_pk_bf16(hv[6], hv[7]);
                { bf16* hp = HH + (size_t)row * 256 + col0; asm volatile("global_store_dwordx4 %0, %1, off sc1" :: "v"(hp), "v"(o) : "memory"); } }
    }
};
template <int ntn> struct MoeOrder {
    int total, G, c; const LAS unsigned char* t2e;
    __device__ __forceinline__ bool next(int i, pg8::Unit& u) const {
        const int Lx = i * G + c; if (Lx >= total) return false;
        const int pm = Lx / ntn, j = Lx - pm * ntn; u.pm = pm; u.pn = __builtin_amdgcn_readfirstlane((int)t2e[pm]) * ntn + j; return true;
    }
    __device__ __forceinline__ void a_ready(const pg8::Unit&) const {}
    __device__ __forceinline__ void done(const pg8::Unit&) const {}
};

template <int ntn> struct MoeOrderG {
    int total, G, c; const LAS unsigned char* t2e; const LAS int* seg; const LAS int* cntL; const int* EL;
    __device__ __forceinline__ bool next(int i, pg8::Unit& u) const {
        const int Lx = i * G + c; if (Lx >= total) return false;
        const int pi = Lx / ntn, j = Lx - pi * ntn, pm = __builtin_amdgcn_readfirstlane((int)ord[pi]); u.pm = pm; u.pn = __builtin_amdgcn_readfirstlane((int)t2e[pm]) * ntn + j; return true;
    }
    __device__ __forceinline__ unsigned goff(const pg8::Unit& u, int h, int R, int C) const {
        const int e = __builtin_amdgcn_readfirstlane((int)t2e[u.pm]); const int cn = __builtin_amdgcn_readfirstlane(cntL[e]);
        int li = u.pm * 256 - __builtin_amdgcn_readfirstlane(seg[e]) + h * 128 + R; li = li < cn ? li : cn - 1;
        return (unsigned)EL[(size_t)e * 16384 + li] * 2048u + (unsigned)C * 2u;
    }
    __device__ __forceinline__ void a_ready(const pg8::Unit&) const {}
    unsigned* hcnt;
    const LAS unsigned char* ord;
    __device__ __forceinline__ void done(const pg8::Unit& u) const {
        asm volatile("s_waitcnt vmcnt(0)" ::: "memory");
        if ((threadIdx.x & 63) == 0) (void)__hip_atomic_fetch_add(hcnt + u.pm * 16, 6u, __ATOMIC_RELAXED, __HIP_MEMORY_SCOPE_AGENT);
    }
};
template <int ntn> struct MoeOrderD {
    int total; const LAS unsigned char* t2e; const LAS unsigned char* ord; const unsigned* hcnt; unsigned* tick; LAS unsigned* slot;
    __device__ __forceinline__ bool next(int i, pg8::Unit& u) const {
        (void)i;
        if (__builtin_amdgcn_readfirstlane((int)(threadIdx.x >> 6)) == 0) {
            unsigned tk = 0;
            if ((threadIdx.x & 63) == 0) tk = __hip_atomic_fetch_add(tick, 1u, __ATOMIC_RELAXED, __HIP_MEMORY_SCOPE_AGENT);
            tk = (unsigned)__builtin_amdgcn_readfirstlane((int)tk);
            if (tk < (unsigned)total) {
                const unsigned* w = hcnt + 16 * (int)ord[tk / ntn];
                for (unsigned polls = 0; polls < (1u << 20); ++polls) {
                    if ((unsigned)__builtin_amdgcn_readfirstlane((int)__hip_atomic_load(w, __ATOMIC_RELAXED, __HIP_MEMORY_SCOPE_AGENT)) >= 96u) break;
                    __builtin_amdgcn_s_sleep(2); }
                __builtin_amdgcn_fence(__ATOMIC_ACQUIRE, "agent");
            }
            if ((threadIdx.x & 63) == 0) *slot = tk;
            asm volatile("s_waitcnt vmcnt(0) lgkmcnt(0)" ::: "memory");
        }
        asm volatile("" ::: "memory"); __builtin_amdgcn_s_barrier(); asm volatile("" ::: "memory");
        const unsigned tk = (unsigned)__builtin_amdgcn_readfirstlane((int)*slot);
        if (tk >= (unsigned)total) return false;
        const int pm = __builtin_amdgcn_readfirstlane((int)ord[tk / ntn]), j = (int)(tk % ntn); u.pm = pm; u.pn = __builtin_amdgcn_readfirstlane((int)t2e[pm]) * ntn + j;
        return true;
    }
    __device__ __forceinline__ void a_ready(const pg8::Unit&) const {}
    __device__ __forceinline__ void done(const pg8::Unit&) const {}
};
constexpr int AM_MLA = 0, AM_SWA = 1, AM_MOBAC = 2, AM_SB = 3, AM_MOBAO = 4;
constexpr int AK_OFF = 0, AK_BUF = 13312;
constexpr int AV_OFF = 26624, AV_BUF = 8192;
constexpr int AW_OFF = 43008;
constexpr int AFLAG_OFF = 51200;
constexpr int ABIAS_OFF = 51456;
constexpr int UT_OFF = RING_BYTES + 1024;
constexpr int ATT_LDS_END = ABIAS_OFF + 256 + 32768;
static_assert(ATT_LDS_END <= RING_BYTES, "attention LDS");
constexpr float NEGBIG = -1.0e30f;
constexpr float ATT_THR = 8.0f;

__device__ __forceinline__ int crow(int r, int hi) { return (r & 3) + 8 * (r >> 2) + 4 * hi; }
typedef short v4i16_t __attribute__((ext_vector_type(4)));
__device__ __forceinline__ s16x4 vtr(const LAS unsigned char* p) { return __builtin_bit_cast(s16x4, __builtin_amdgcn_ds_read_tr16_b64_v4i16((LAS v4i16_t*)p)); }


template <int ND0, int RSK>
__device__ __forceinline__ void att_qk(const LAS unsigned char* Kc, int krd, const bf16x8 (&qf)[ND0], f32x16& p0, f32x16& p1, const f32x16& cinit) {
    p0 = cinit; p1 = cinit;
#pragma unroll
    for (int d0 = 0; d0 < ND0; ++d0) {
        const bf16x8 ka = *(const LAS bf16x8*)(Kc + krd + d0 * 32);
        const bf16x8 kb = *(const LAS bf16x8*)(Kc + krd + 32 * RSK + d0 * 32);
        p0 = __builtin_amdgcn_mfma_f32_32x32x16_bf16(ka, qf[d0], p0, 0, 0, 0);
        p1 = __builtin_amdgcn_mfma_f32_32x32x16_bf16(kb, qf[d0], p1, 0, 0, 0);
    }
}
template <int MODE>
__device__ __forceinline__ void att_smpv(f32x16& p0, f32x16& p1, f32x16 (&o)[2], float& mref, float& lsum, float& carry, const LAS unsigned char* Vc, int vrd,
                                         LAS float* wsf, const LAS float* btab, int qpos, int q0w, int t, int hi, int ql, float cscale, f32x16& negm, bool& first) {
    const int k0 = t * 64;
    const int dbase = qpos - k0 - 4 * hi;
    if constexpr (MODE != AM_SB) {
        if constexpr (MODE == AM_MLA) {
            if (k0 + 63 > q0w) {
#pragma unroll
                for (int r = 0; r < 16; ++r) { const int c0 = (r & 3) + 8 * (r >> 2);
                    p0[r] = (dbase - c0 >= 0) ? p0[r] : NEGBIG; p1[r] = (dbase - c0 - 32 >= 0) ? p1[r] : NEGBIG; }
            }
        } else {
#pragma unroll
            for (int r = 0; r < 16; ++r) {
                const int c0 = (r & 3) + 8 * (r >> 2);
                const int d0v = dbase - c0, d1v = dbase - c0 - 32;
                const float s0 = __builtin_fmaf(p0[r], cscale, btab[64 + d0v]), s1 = __builtin_fmaf(p1[r], cscale, btab[64 + d1v]);
                if constexpr (MODE == AM_MOBAC) { p0[r] = s0; p1[r] = s1; }
                else {
                    bool v0, v1;
                    if constexpr (MODE == AM_SWA) { v0 = (d0v >= 0) && (d0v < 128); v1 = (d1v >= 0) && (d1v < 128); }
                    else { v0 = (d0v >= 0); v1 = (d1v >= 0); }
                    p0[r] = v0 ? s0 : NEGBIG; p1[r] = v1 ? s1 : NEGBIG;
                }
            }
        }
        float rm = fmaxf(p0[0], p1[0]);
#pragma unroll
        for (int r = 1; r < 16; ++r) rm = fmaxf(fmaxf(rm, p0[r]), p1[r]);
        rm = fmaxf(rm, __shfl_xor(rm, 32));
        if constexpr (MODE == AM_MLA) {
            if (first || __any((int)(rm > ATT_THR))) {
                const float delta = (first || rm > ATT_THR) ? rm : 0.f;
                const float alpha = first ? 1.0f : __builtin_amdgcn_exp2f(-delta);
                mref += delta; lsum *= alpha;
#pragma unroll
                for (int r = 0; r < 16; ++r) { negm[r] = -mref; p0[r] -= delta; p1[r] -= delta; }
                if (!first) {
                    if (hi == 0) wsf[ql] = alpha;
#pragma unroll
                    for (int g4 = 0; g4 < 4; ++g4) { const f32x4 al = *(const LAS f32x4*)(wsf + 8 * g4 + 4 * hi);
                        o[0][4 * g4 + 0] *= al.x; o[0][4 * g4 + 1] *= al.y; o[0][4 * g4 + 2] *= al.z; o[0][4 * g4 + 3] *= al.w;
                        o[1][4 * g4 + 0] *= al.x; o[1][4 * g4 + 1] *= al.y; o[1][4 * g4 + 2] *= al.z; o[1][4 * g4 + 3] *= al.w; }
                }
                first = false;
            }
        } else
        if (__any((int)(rm - mref > ATT_THR))) {
            const float mnew = (rm - mref > ATT_THR) ? rm : mref;
            const float alpha = __builtin_amdgcn_exp2f(mref - mnew);
            mref = mnew; lsum *= alpha;
            if (hi == 0) wsf[ql] = alpha;
#pragma unroll
            for (int g4 = 0; g4 < 4; ++g4) { const f32x4 al = *(const LAS f32x4*)(wsf + 8 * g4 + 4 * hi);
                o[0][4 * g4 + 0] *= al.x; o[0][4 * g4 + 1] *= al.y; o[0][4 * g4 + 2] *= al.z; o[0][4 * g4 + 3] *= al.w;
                o[1][4 * g4 + 0] *= al.x; o[1][4 * g4 + 1] *= al.y; o[1][4 * g4 + 2] *= al.z; o[1][4 * g4 + 3] *= al.w; }
        }
        float ls = 0.f;
        if constexpr (MODE == AM_MLA) {
#pragma unroll
            for (int r = 0; r < 16; ++r) { p0[r] = __builtin_amdgcn_exp2f(p0[r]); p1[r] = __builtin_amdgcn_exp2f(p1[r]); ls += p0[r] + p1[r]; }
        } else {
#pragma unroll
            for (int r = 0; r < 16; ++r) { p0[r] = __builtin_amdgcn_exp2f(p0[r] - mref); p1[r] = __builtin_amdgcn_exp2f(p1[r] - mref); ls += p0[r] + p1[r]; }
        }
        lsum += ls;
    } else {
        float gt[8];
#pragma unroll
        for (int j = 0; j < 8; ++j) {
            float lsn[4], lsp[4];
#pragma unroll
            for (int i = 0; i < 4; ++i) {
                const int r = 4 * (j & 3) + i; const float acc = (j < 4) ? p0[r] : p1[r];
                const int dist = dbase - i - 8 * (j & 3) - 32 * (j >> 2);
                const float z = acc * cscale;
                const float l1 = __builtin_amdgcn_logf(1.0f + __builtin_amdgcn_exp2f(-fabsf(z)));
                const float a_ = fminf(z, 0.f) - l1;
                const bool valid = dist > 0;
                lsp[i] = valid ? a_ : NEGBIG; lsn[i] = valid ? (a_ - z) : 0.f;
            }
            const float s2 = lsn[3], s1 = s2 + lsn[2], s0 = s1 + lsn[1];
            gt[j] = s0 + lsn[0];
            const float e0 = lsp[0] + s0, e1 = lsp[1] + s1, e2 = lsp[2] + s2, e3 = lsp[3];
            if (j < 4) { p0[4 * j + 0] = e0; p0[4 * j + 1] = e1; p0[4 * j + 2] = e2; p0[4 * j + 3] = e3; }
            else { p1[4 * (j - 4) + 0] = e0; p1[4 * (j - 4) + 1] = e1; p1[4 * (j - 4) + 2] = e2; p1[4 * (j - 4) + 3] = e3; }
        }
        float ox[8];
#pragma unroll
        for (int j = 0; j < 8; ++j) ox[j] = __shfl_xor(gt[j], 32);
        float so = 0.f, sx = 0.f;
#pragma unroll
        for (int j = 7; j >= 0; --j) {
            const float sg = carry + so + sx + ((hi == 0) ? ox[j] : 0.f);
            if (j < 4) { p0[4 * j + 0] += sg; p0[4 * j + 1] += sg; p0[4 * j + 2] += sg; p0[4 * j + 3] += sg; }
            else { p1[4 * (j - 4) + 0] += sg; p1[4 * (j - 4) + 1] += sg; p1[4 * (j - 4) + 2] += sg; p1[4 * (j - 4) + 3] += sg; }
            so += gt[j]; sx += ox[j];
        }
        carry += so + sx;
#pragma unroll
        for (int r = 0; r < 16; ++r) { p0[r] = __builtin_amdgcn_exp2f(p0[r]); p1[r] = __builtin_amdgcn_exp2f(p1[r]); }
    }
    v4u pw[4];
    pw[0] = (v4u){pg8::cvt_pk_bf16(p0[0], p0[1]), pg8::cvt_pk_bf16(p0[2], p0[3]), pg8::cvt_pk_bf16(p0[4], p0[5]), pg8::cvt_pk_bf16(p0[6], p0[7])};
    pw[1] = (v4u){pg8::cvt_pk_bf16(p0[8], p0[9]), pg8::cvt_pk_bf16(p0[10], p0[11]), pg8::cvt_pk_bf16(p0[12], p0[13]), pg8::cvt_pk_bf16(p0[14], p0[15])};
    pw[2] = (v4u){pg8::cvt_pk_bf16(p1[0], p1[1]), pg8::cvt_pk_bf16(p1[2], p1[3]), pg8::cvt_pk_bf16(p1[4], p1[5]), pg8::cvt_pk_bf16(p1[6], p1[7])};
    pw[3] = (v4u){pg8::cvt_pk_bf16(p1[8], p1[9]), pg8::cvt_pk_bf16(p1[10], p1[11]), pg8::cvt_pk_bf16(p1[12], p1[13]), pg8::cvt_pk_bf16(p1[14], p1[15])};
#pragma unroll
    for (int s = 0; s < 4; ++s)
#pragma unroll
        for (int d0 = 0; d0 < 2; ++d0) {
            const s16x4 lo = vtr(Vc + vrd + d0 * 4096 + s * 1024), hi4 = vtr(Vc + vrd + d0 * 4096 + s * 1024 + 512);
            const bf16x8 vf = (bf16x8){lo[0], lo[1], lo[2], lo[3], hi4[0], hi4[1], hi4[2], hi4[3]};
            o[d0] = __builtin_amdgcn_mfma_f32_32x32x16_bf16(__builtin_bit_cast(bf16x8, pw[s]), vf, o[d0], 0, 0, 0);
        }
}

struct AttnPtrs {
    const bf16* Q; int qs;
    const bf16* K; int ks;
    const bf16* K2;
    const bf16* V; int vs;
    bf16* O;
};

struct MobaArgs { int q; int slot; bool valid; bool wvalid; int bhbase; bf16* PARTO; f32x2* PARTML; };
template <int MODE>
__device__ __forceinline__ void attn_unit(LAS unsigned char* L, const AttnPtrs& a, int q0u  , int q0w, int t_first, int t_last, float cscale,
                                          float sinkl2, const MobaArgs& mb, int boff, const f32x2* rope, int tid, int lane, int wave) {
    constexpr int DQK = (MODE == AM_MLA) ? 96 : 64, RSK = 2 * DQK + 16, ND0 = DQK / 16;
    const int ql = lane & 31, hi = lane >> 5;
    LAS unsigned char* Kb = L + AK_OFF; LAS unsigned char* Vb = L + AV_OFF;
    LAS float* wsf = (LAS float*)(L + AW_OFF + wave * 1024);
    const int qpos = (MODE == AM_MOBAC) ? mb.q : (q0w + ql);
    const bf16* qrow = (MODE == AM_MOBAC) ? (a.Q + (size_t)mb.q * a.qs) : (a.Q + (size_t)ql * a.qs);
    bf16x8 qf[ND0];
#pragma unroll
    for (int d0 = 0; d0 < ND0; ++d0) qf[d0] = *(const bf16x8*)(qrow + d0 * 16 + hi * 8);
    if constexpr (MODE == AM_MLA) {
        const f32x4* rp = (const f32x4*)(rope + (size_t)qpos * 16 + 8 * hi);
        const v4u w1 = __builtin_bit_cast(v4u, qf[4]), w2 = __builtin_bit_cast(v4u, qf[5]);
        float x1[8], x2[8], cs[16];
        x1[0] = bflo(w1.x); x1[1] = bfhi(w1.x); x1[2] = bflo(w1.y); x1[3] = bfhi(w1.y); x1[4] = bflo(w1.z); x1[5] = bfhi(w1.z); x1[6] = bflo(w1.w); x1[7] = bfhi(w1.w);
        x2[0] = bflo(w2.x); x2[1] = bfhi(w2.x); x2[2] = bflo(w2.y); x2[3] = bfhi(w2.y); x2[4] = bflo(w2.z); x2[5] = bfhi(w2.z); x2[6] = bflo(w2.w); x2[7] = bfhi(w2.w);
#pragma unroll
        for (int k = 0; k < 4; ++k) { const f32x4 v = rp[k]; cs[4 * k] = v.x; cs[4 * k + 1] = v.y; cs[4 * k + 2] = v.z; cs[4 * k + 3] = v.w; }
        float y1[8], y2[8];
#pragma unroll
        for (int j = 0; j < 8; ++j) { const float c = cs[2 * j] * cscale, sn = cs[2 * j + 1] * cscale; y1[j] = x1[j] * c - x2[j] * sn; y2[j] = x2[j] * c + x1[j] * sn; }
#pragma unroll
        for (int d0 = 0; d0 < 4; ++d0) { const v4u w = __builtin_bit_cast(v4u, qf[d0]);
            const v4u ws_ = (v4u){pk2(bflo(w.x) * cscale, bfhi(w.x) * cscale), pk2(bflo(w.y) * cscale, bfhi(w.y) * cscale), pk2(bflo(w.z) * cscale, bfhi(w.z) * cscale), pk2(bflo(w.w) * cscale, bfhi(w.w) * cscale)};
            qf[d0] = __builtin_bit_cast(bf16x8, ws_); }
        const v4u o1 = (v4u){pk2(y1[0], y1[1]), pk2(y1[2], y1[3]), pk2(y1[4], y1[5]), pk2(y1[6], y1[7])};
        const v4u o2 = (v4u){pk2(y2[0], y2[1]), pk2(y2[2], y2[3]), pk2(y2[4], y2[5]), pk2(y2[6], y2[7])};
        qf[4] = __builtin_bit_cast(bf16x8, o1); qf[5] = __builtin_bit_cast(bf16x8, o2);
    }
    const int skey = tid >> 3, sc = tid & 7;
    const bf16* kg = a.K + (size_t)skey * a.ks + sc * 8;
    const bf16* vg = a.V + (size_t)skey * a.vs + sc * 8;
    const bf16* k2g = nullptr; if constexpr (MODE == AM_MLA) k2g = a.K2 + (size_t)(tid >> 2) * 32 + (tid & 3) * 8;
    const int kw_off = skey * RSK + sc * 16, vw_off = (sc >> 2) * 4096 + skey * 64 + (sc & 3) * 16, k2w_off = (tid >> 2) * RSK + 128 + (tid & 3) * 16;
    v4u rk, rv, rk2;
#define ATT_LOAD(t) do { rk = *(const v4u*)(kg + (size_t)(t) * 64 * a.ks); rv = *(const v4u*)(vg + (size_t)(t) * 64 * a.vs); \
        if constexpr (MODE == AM_MLA) { if (tid < 256) rk2 = *(const v4u*)(k2g + (size_t)(t) * 64 * 32); } } while (0)
#define ATT_WRITE(kbuf, vbuf) do { *(LAS v4u*)(Kb + (kbuf) * AK_BUF + kw_off) = rk; *(LAS v4u*)(Vb + (vbuf) * AV_BUF + vw_off) = rv; \
        if constexpr (MODE == AM_MLA) { if (tid < 256) *(LAS v4u*)(Kb + (kbuf) * AK_BUF + k2w_off) = rk2; } } while (0)
    f32x16 o[2]; o[0] = f32x16{}; o[1] = f32x16{};
    float mref = (MODE == AM_MLA) ? 0.f : NEGBIG, lsum = 0.f, carry = 0.f;
    f32x16 negm = f32x16{}; bool first = true;
    const int krd = ql * RSK + hi * 16;
    const int vrd = ((lane >> 4) & 1) * 32 + (lane & 3) * 8 + (4 * hi + ((lane & 15) >> 2)) * 64;
    const LAS float* btab = (const LAS float*)(L + ABIAS_OFF) + boff;
    constexpr bool REV = (MODE == AM_SB);
    const int ntl = t_last - t_first + 1;
    constexpr bool SKEW = false;
    const bool skew = SKEW && (wave >= 4);
    f32x16 p0, p1;
#define ATT_TILE(i) (REV ? (t_last - (i)) : (t_first + (i)))
    ATT_LOAD(ATT_TILE(0));
    __syncthreads();
    ATT_WRITE(0, 0);
    __syncthreads();
    if (skew) { if (ntl > 1) ATT_LOAD(ATT_TILE(1)); __syncthreads(); }
    for (int it = 0; it < ntl; ++it) {
        const int t = ATT_TILE(it), cur = it & 1, k0 = t * 64;
        const bool more = (it + 1 < ntl);
        if (!skew && more) ATT_LOAD(ATT_TILE(it + 1));
        bool need;
        if constexpr (MODE == AM_MLA) need = (k0 <= q0w + 31);
        else if constexpr (MODE == AM_SWA) need = (k0 <= q0w + 31) && (k0 + 63 >= q0w - 127);
        else if constexpr (MODE == AM_MOBAC) need = mb.wvalid;
        else if constexpr (MODE == AM_MOBAO) need = (k0 <= q0w + 31);
        else need = (k0 < q0w + 31) && (__any((int)(carry > -160.f)) != 0);
        if (need) att_qk<ND0, RSK>(Kb + cur * AK_BUF, krd, qf, p0, p1, negm);
        if constexpr (SKEW) {
            if (skew && more) ATT_WRITE(cur ^ 1, cur ^ 1);
            __syncthreads();
            if (skew && it + 2 < ntl) ATT_LOAD(ATT_TILE(it + 2));
        }
        if (need) att_smpv<MODE>(p0, p1, o, mref, lsum, carry, Vb + cur * AV_BUF, vrd, wsf, btab, qpos, q0w, t, hi, ql, cscale, negm, first);
        if (!skew && more) ATT_WRITE(cur ^ 1, cur ^ 1);
        if constexpr (MODE == AM_SB) {
            volatile LAS unsigned* fl = (volatile LAS unsigned*)(L + AFLAG_OFF);
            const bool wdone = (k0 < q0w + 31) && (__any((int)(carry > -160.f)) == 0);
            if (lane == 0) fl[cur * 8 + wave] = wdone ? 1u : 0u;
            __syncthreads();
            unsigned alld = 1u;
#pragma unroll
            for (int w = 0; w < 8; ++w) alld &= fl[cur * 8 + w];
            if (alld) break;
        } else {
            __syncthreads();
        }
    }
    if (SKEW && !skew) __syncthreads();
#undef ATT_TILE
#undef ATT_LOAD
#undef ATT_WRITE
    LAS unsigned short* stg = (LAS unsigned short*)(L + wave * 4096);
    LAS int* wsi = (LAS int*)wsf;
    lsum += __shfl_xor(lsum, 32);
    float inv[16];
    if constexpr (MODE == AM_MOBAC || MODE == AM_MOBAO) {
        const int di = (MODE == AM_MOBAO) ? ((mb.bhbase + qpos) * 4 + 3) : (mb.valid ? ((mb.bhbase + mb.q) * 4 + mb.slot) : -1);
        if (hi == 0) { wsi[ql] = (MODE == AM_MOBAO) ? 0 : (mb.valid ? ((mb.bhbase + mb.q) * 3 + mb.slot) : -1); if (di >= 0) mb.PARTML[di] = (f32x2){mref, lsum}; }
#pragma unroll
        for (int r = 0; r < 16; ++r) inv[r] = 1.0f;
    } else if constexpr (MODE != AM_SB) {
        if constexpr (MODE == AM_SWA) lsum += __builtin_amdgcn_exp2f(sinkl2 - mref);
        if (hi == 0) wsf[32 + ql] = lsum;
#pragma unroll
        for (int g4 = 0; g4 < 4; ++g4) { const f32x4 lv = *(const LAS f32x4*)(wsf + 32 + 8 * g4 + 4 * hi);
            inv[4 * g4 + 0] = 1.0f / lv.x; inv[4 * g4 + 1] = 1.0f / lv.y; inv[4 * g4 + 2] = 1.0f / lv.z; inv[4 * g4 + 3] = 1.0f / lv.w; }
    } else {
#pragma unroll
        for (int r = 0; r < 16; ++r) inv[r] = 1.0f;
    }
#pragma unroll
    for (int r = 0; r < 16; ++r) { const int row = crow(r, hi);
        stg[row * 64 + ql] = (unsigned short)f2bf(o[0][r] * inv[r]); stg[row * 64 + 32 + ql] = (unsigned short)f2bf(o[1][r] * inv[r]); }
#pragma unroll
    for (int i = 0; i < 4; ++i) { const int c = lane + 64 * i, row = c >> 3, part = c & 7;
        const v4u v = *(const LAS v4u*)(stg + row * 64 + part * 8);
        if constexpr (MODE == AM_MOBAC) { const int d = wsi[row]; if (d >= 0) *(v4u*)(mb.PARTO + (size_t)d * 64 + part * 8) = v; }
        else *(v4u*)(a.O + (size_t)row * 1024 + part * 8) = v; }
}

constexpr int RK_OFF = 0, RK_TILE = 9216;
constexpr int RV_OFF = 36864, RV_TILE = 8192;
constexpr int RW_OFF = 69632;
constexpr int RB_OFF = 86016;
static_assert(RB_OFF + 256 + 32768 <= RING_BYTES, "resident MoBA LDS");

__device__ __forceinline__ void moba_resident_load(LAS unsigned char* L, const bf16* Kblk, const bf16* Vblk, int tid) {
    const int skey = tid >> 3, sc = tid & 7;
    v4u rk[4], rv[4];
#pragma unroll
    for (int t = 0; t < 4; ++t) { rk[t] = *(const v4u*)(Kblk + (size_t)(t * 64 + skey) * 3072 + sc * 8); rv[t] = *(const v4u*)(Vblk + (size_t)(t * 64 + skey) * 3072 + sc * 8); }
#pragma unroll
    for (int t = 0; t < 4; ++t) { *(LAS v4u*)(L + RK_OFF + t * RK_TILE + skey * 144 + sc * 16) = rk[t]; *(LAS v4u*)(L + RV_OFF + t * RV_TILE + (sc >> 2) * 4096 + skey * 64 + (sc & 3) * 16) = rv[t]; }
}
__device__ __forceinline__ void moba_resident_wave(LAS unsigned char* L, const bf16* Qb  , int n, int q, int slot, bool valid, int bhbase,
                                                   bf16* PARTO, f32x2* PARTML, int lane, int wave) {
    const int ql = lane & 31, hi = lane >> 5;
    LAS float* wsf = (LAS float*)(L + RW_OFF + wave * 2048);
    LAS int* wsi = (LAS int*)(L + RW_OFF + wave * 2048 + 1024);
    const LAS float* btab = (const LAS float*)(L + RB_OFF);
    bf16x8 qf[4];
#pragma unroll
    for (int d0 = 0; d0 < 4; ++d0) qf[d0] = *(const bf16x8*)(Qb + (size_t)q * 3072 + d0 * 16 + hi * 8);
    f32x16 o[2]; o[0] = f32x16{}; o[1] = f32x16{};
    float mref = NEGBIG, lsum = 0.f, carry = 0.f; f32x16 negm = f32x16{}; bool first = true;
    const int krd = ql * 144 + hi * 16;
    const int vrd = ((lane >> 4) & 1) * 32 + (lane & 3) * 8 + (4 * hi + ((lane & 15) >> 2)) * 64;
    f32x16 p0, p1;
#pragma unroll 1
    for (int t = 0; t < 4; ++t) {
        att_qk<4, 144>(L + RK_OFF + t * RK_TILE, krd, qf, p0, p1, negm);
        att_smpv<AM_MOBAC>(p0, p1, o, mref, lsum, carry, L + RV_OFF + t * RV_TILE, vrd, wsf, btab, q, 0, 4 * n + t, hi, ql, 0.125f * LOG2E, negm, first);
    }
    lsum += __shfl_xor(lsum, 32);
    const int di = valid ? ((bhbase + q) * 4 + slot) : -1;
    if (hi == 0) { wsi[ql] = valid ? ((bhbase + q) * 3 + slot) : -1; if (di >= 0) PARTML[di] = (f32x2){mref, lsum}; }
    LAS unsigned short* stg = (LAS unsigned short*)wsf;
#pragma unroll
    for (int g4 = 0; g4 < 4; ++g4) {
#pragma unroll
        for (int k = 0; k < 4; ++k) { const int r = 4 * g4 + k, lrow = 4 * hi + k;
            stg[lrow * 64 + ql] = (unsigned short)f2bf(o[0][r]); stg[lrow * 64 + 32 + ql] = (unsigned short)f2bf(o[1][r]); }
        const int lrow = lane >> 3, part = lane & 7, d = wsi[8 * g4 + lrow];
        const v4u v = *(const LAS v4u*)(stg + lrow * 64 + part * 8);
        if (d >= 0) *(v4u*)(PARTO + (size_t)d * 64 + part * 8) = v;
    }
}
#ifndef REP_CH
#define REP_CH 1
#endif
#ifndef REPS_INIT
#define REPS_INIT {1,1,1,1,1,1,1,1,1,1,1,1,1,1,1,1,1,1,1,1,1,1}
#endif
__device__ constexpr int REPS[22] = REPS_INIT;
__device__ __forceinline__ void p0_prologue(const Params& p, LAS unsigned char* L, int gw, int NGW, int lane, int wave, int gtid, int NGT) {
    LAS float* scr = (LAS float*)(L + wave * 16384);
    unsigned char* ws = p.ws;
    constexpr int I0 = 592, I1 = 96, I2 = 64, I3 = 512, I4 = 1536, I5 = 512, IM = 24576;
    constexpr int NIT = I0 + I1 + I2 + I3 + I4 + I5; (void)IM;
    for (int it = gw; it < NIT; it += NGW) {
        int r = it;
        if (r < I0) { const int kb = r / 37, nb = r % 37; transpose_item(p.in[5], 1184, 64 * kb, 32 * nb, (bf16*)(ws + WS_WINE) + (size_t)(32 * nb) * 1024, 1024, scr, lane); continue; } r -= I0;
        if (r < I1) { const int kb = r / 24, nb = r % 24; transpose_item(p.in[8], 768, 64 * kb, 32 * nb, (bf16*)(ws + WS_WQB) + (size_t)(32 * nb) * 256, 256, scr, lane); continue; } r -= I1;
        if (r < I2) { const int kb = r / 32, nb = r % 32; transpose_item(p.in[9], 1024, 64 * kb, 32 * nb, (bf16*)(ws + WS_WKVB) + (size_t)(32 * nb) * 128, 128, scr, lane); continue; } r -= I2;
        if (r < I3) { const int kb = r / 32, nb = r % 32; transpose_item(p.in[11], 1024, 64 * kb, 32 * nb, (bf16*)(ws + WS_WOE) + (size_t)(32 * nb) * 1024, 1024, scr, lane); continue; } r -= I3;
        if (r < I4) { const int kb = r / 96, nb = r % 96; transpose_item(p.in[12], 3072, 64 * kb, 32 * nb, (bf16*)(ws + WS_WINO) + (size_t)(32 * nb) * 1024, 1024, scr, lane); continue; } r -= I4;
        { const int kb = r / 32, nb = r % 32; transpose_item(p.in[13], 1024, 64 * kb, 32 * nb, (bf16*)(ws + WS_WOO) + (size_t)(32 * nb) * 1024, 1024, scr, lane); }
    }
    { v4u* z = (v4u*)((bf16*)(ws + WS_WINE) + (size_t)1184 * 1024); for (int i = gtid; i < 96 * 1024 / 8; i += NGT) z[i] = (v4u){0u, 0u, 0u, 0u}; }
    for (int m = gw; m < NTOK / 2; m += NGW) rms_rows2_to_bf16(p.in[0] + (size_t)m * 1024, p.in[0] + (size_t)(m + NTOK / 2) * 1024, p.in[1], (bf16*)(ws + WS_U) + (size_t)m * 1024, (bf16*)(ws + WS_U) + (size_t)(m + NTOK / 2) * 1024, lane);
    { float* bt = (float*)(ws + WS_BIAS); const float* rel = p.in[4];
      for (int i = gtid; i < 8 * 8192; i += NGT) { const int h = i >> 13, n = i & 8191; int b;
          if (n < 16) b = n; else { b = 16 + (int)(log((double)n / 16.0) / log(128.0) * 16.0); if (b > 31) b = 31; }
          bt[i] = rel[b * 8 + h] * LOG2E; } }
    { float* wrt = (float*)(ws + WS_WRT);
      for (int i = gtid; i < 2 * 48 * 1024; i += NGT) { const int d = i & 1023, j = (i >> 10) % 48, l = i / (48 * 1024);
          const float g = p.in[2][l * 1024 + d];
          const float w = (j < 32) ? g * p.in[16][((size_t)l * 1024 + d) * 32 + j] : (j < 36) ? g * p.in[14][((size_t)l * 1024 + d) * 4 + (j - 32)] : 0.f;
          wrt[i] = w; const unsigned hb = f2bf(w);
          const int cch = d >> 5, kq_ = (d >> 3) & 3, e_ = d & 7, jt = j >> 4, col_ = j & 15;
          const size_t fi = ((((size_t)l * 32 + cch) * 3 + jt) * 64 + (kq_ * 16 + col_)) * 8 + e_;
          ((bf16*)(ws + WS_WRT + 512 * 1024))[fi] = (bf16)hb; ((bf16*)(ws + WS_WRT + 768 * 1024))[fi] = (bf16)f2bf(w - bf2f((unsigned short)hb)); } }
    { f32x2* rt = (f32x2*)(ws + WS_ROPE);
      for (int i = gtid; i < 8192 * 16; i += NGT) { const int t = i >> 4, ii = i & 15;
          const float freq = (float)pow(10000.0, -(double)(2 * ii) / 32.0); const float ang = (float)t * freq;
          f32x2 cs; cs.x = (float)cos((double)ang); cs.y = (float)sin((double)ang); rt[i] = cs; } }
}


__device__ __forceinline__ void moe_item(const Params& p, int layer, int it, const float*& W, int& ldw, int& k0, int& n0, bf16*& dst, int& ldk) {
    const int r = layer * 32 * 384 + it, le = r / 384, rr = r % 384, which = rr >> 7, item = rr & 127, e = le & 31;
    unsigned char* lbase = p.ws + WS_MOEW + (size_t)(le >> 5) * 48 * MiB;
    if (which < 2) { W = p.in[18 + which] + (size_t)le * 1024 * 256; ldw = 256; const int kb = item / 8, nb = item % 8; k0 = 64 * kb; n0 = 32 * nb;
        dst = (bf16*)lbase + ((size_t)e * 512 + (n0 >> 7) * 256 + which * 128 + (n0 & 127)) * 1024; ldk = 1024; }
    else { W = p.in[20] + (size_t)le * 256 * 1024; ldw = 1024; const int kb = item / 32, nb = item % 32; k0 = 64 * kb; n0 = 32 * nb;
        dst = (bf16*)(lbase + 32 * MiB) + ((size_t)e * 1024 + 32 * nb) * 256; ldk = 256; }
}
__device__ __forceinline__ void moe_convert(const Params& p, LAS unsigned char* L, int layer, int widx, int nworkers, int lane, int wave) {
    LAS float* scr = (LAS float*)(L + wave * 16384);
    int it = widx;
    if (it >= 32 * 384) return;
    const float* W; int ldw, k0, n0, ldk; bf16* dst;
    moe_item(p, layer, it, W, ldw, k0, n0, dst, ldk);
    float tv[32];
#pragma unroll
    for (int i = 0; i < 32; ++i) tv[i] = W[(size_t)(k0 + 2 * i + (lane >> 5)) * ldw + n0 + (lane & 31)];
    for (;;) {
        const int itn = it + nworkers; const bool more = itn < 32 * 384;
        const float* Wn = W; int ldwn = ldw, k0n = k0, n0n = n0, ldkn = ldk; bf16* dstn = dst;
        if (more) moe_item(p, layer, itn, Wn, ldwn, k0n, n0n, dstn, ldkn);
#pragma unroll
        for (int i = 0; i < 32; ++i) scr[(2 * i + (lane >> 5)) * 33 + (lane & 31)] = tv[i];
        if (more) {
#pragma unroll
            for (int i = 0; i < 32; ++i) tv[i] = Wn[(size_t)(k0n + 2 * i + (lane >> 5)) * ldwn + n0n + (lane & 31)];
        }
        LDS_WAIT(); asm volatile("" ::: "memory");
        const int c = lane & 7;
#pragma unroll
        for (int j = 0; j < 4; ++j) { const int n = (lane >> 3) + 8 * j; const LAS float* s = scr + (8 * c) * 33 + n;
            v4u o; o.x = pk2(s[0 * 33], s[1 * 33]); o.y = pk2(s[2 * 33], s[3 * 33]); o.z = pk2(s[4 * 33], s[5 * 33]); o.w = pk2(s[6 * 33], s[7 * 33]);
            *(v4u*)(dst + (size_t)n * ldk + k0 + 8 * c) = o; }
        LDS_WAIT(); asm volatile("" ::: "memory");
        if (!more) break;
        it = itn; W = Wn; ldw = ldwn; k0 = k0n; n0 = n0n; dst = dstn; ldk = ldkn;
    }
}
constexpr int MOE_T2E_OFF = RING_BYTES + 1024;
template <bool ORD>
__device__ __forceinline__ void moe_tables(const Params& p, LAS unsigned char* L, int layer, int tid, int G, int& ntiles, int& nfull) {
    LAS int* seg = (LAS int*)(L + MOE_T2E_OFF + 256); LAS unsigned char* t2e = L + MOE_T2E_OFF; LAS int* cntL = (LAS int*)(L + MOE_T2E_OFF + 512);
    LAS unsigned char* ord = L + MOE_T2E_OFF + 640; LAS int* nf = (LAS int*)(L + MOE_T2E_OFF + 800);
    const unsigned* cnt = (const unsigned*)(p.ws + WS_CTL) + CW_ECNT + layer * 32 * 64;
    __syncthreads();
    if (tid < 64) {
        const int c = (tid < 32) ? (int)__hip_atomic_load(cnt + tid * 64, __ATOMIC_RELAXED, __HIP_MEMORY_SCOPE_AGENT) : 0;
        const int nt = (c + 255) >> 8; const int r = c - (nt - 1) * 256; const int part = (nt > 0 && r < 256) ? 1 : 0;
        int tl_ = 0;
        if constexpr (ORD) {
            int ncomp = nt - part;
#pragma unroll
            for (int o = 1; o < 64; o <<= 1) ncomp += __shfl_xor(ncomp, o);
            const int slots = ((ncomp * 2 + G - 1) / G) * G / 2 - ncomp;
            int rank = 0;
            const int key = part ? r : -1;
#pragma unroll
            for (int e2 = 0; e2 < 32; ++e2) { const int k2 = __builtin_amdgcn_readlane(key, e2); rank += (k2 > key || (k2 == key && e2 < tid)) ? 1 : 0; }
            tl_ = (part && rank >= slots) ? 1 : 0;
        }
        const int tl = tl_; const int nfe = nt - tl;
        int inc = nt, incf = nfe, inct = tl;
#pragma unroll
        for (int o = 1; o < 32; o <<= 1) { const int v = __shfl_up(inc, o), vf = __shfl_up(incf, o), vt = __shfl_up(inct, o); if ((tid & 63) >= o) { inc += v; incf += vf; inct += vt; } }
        const int nfa = __shfl(incf, 31);
        if (tid < 32) { cntL[tid] = c; seg[tid] = (inc - nt) * 256; for (int t = inc - nt; t < inc; ++t) t2e[t] = (unsigned char)tid;
            for (int t = 0; t < nfe; ++t) ord[incf - nfe + t] = (unsigned char)(inc - nt + t);
            if (tl) ord[nfa + inct - 1] = (unsigned char)(inc - 1); }
        if (tid == 31) { seg[32] = inc * 256; nf[0] = nfa; }
    }
    __syncthreads();
    ntiles = seg[32] >> 8; nfull = nf[0];
}
__device__ __forceinline__ void moe_tail_units(const Params& p, LAS unsigned char* L, const bf16* GU, unsigned* hcnt, int nfull, int ntiles, int q, int G, int tid, int lane, int wave) {
    unsigned char* ws = p.ws;
    const LAS int* seg = (const LAS int*)(L + MOE_T2E_OFF + 256); const LAS unsigned char* t2e = L + MOE_T2E_OFF; const LAS int* cntL = (const LAS int*)(L + MOE_T2E_OFF + 512);
    const LAS unsigned char* ord = L + MOE_T2E_OFF + 640;
    const bf16* UB = (const bf16*)(ws + WS_U); const int* EL = (const int*)(ws + WS_EL); const f32x2* EW = (const f32x2*)(ws + WS_EW); bf16* HH = (bf16*)(ws + WS_HH);
    constexpr int RS = 528;
    const int mb = wave & 3, cg = wave >> 2, fm = lane & 15, kq = lane >> 4;
    int base = 0;
    for (int ti = nfull; ti < ntiles; ++ti) {
        const int pm = (int)ord[ti], e = (int)t2e[pm], cn = cntL[e], off = pm * 256 - seg[e], rows = cn - off, nun = ((rows + 63) >> 6) * 8;
        const unsigned pub = 96u / (unsigned)nun;
        for (int un = (q - base + G) % G; un < nun; un += G) {
            const int rg = un >> 3, s = un & 7, f0 = s * 32, ro = off + rg * 64;
            const bf16* src[8];
#pragma unroll
            for (int i = 0; i < 8; ++i) { const int r = (wave & 3) * 16 + 2 * i + (lane >> 5);
                if (wave < 4) { int li = ro + r; li = li < cn ? li : cn - 1; src[i] = UB + (size_t)EL[(size_t)e * 16384 + li] * 1024 + (lane & 31) * 8; }
                else { const int f = f0 + (r & 31); src[i] = GU + ((size_t)e * 512 + (f >> 7) * 256 + (f & 127) + (r >> 5) * 128) * 1024 + (lane & 31) * 8; } }
            pg8::f32x4 accg = (pg8::f32x4){0.f, 0.f, 0.f, 0.f}, accu = (pg8::f32x4){0.f, 0.f, 0.f, 0.f};
            const bool active = (ro + mb * 16 < cn);
            v4u rr[8];
#pragma unroll
            for (int i = 0; i < 8; ++i) rr[i] = *(const v4u*)(src[i]);
#pragma unroll 1
            for (int ch = 0; ch < 4; ++ch) {
                __syncthreads();
#pragma unroll
                for (int i = 0; i < 8; ++i) *(LAS v4u*)(L + (wave * 16 + 2 * i + (lane >> 5)) * RS + (lane & 31) * 16) = rr[i];
                __syncthreads();
                if (ch < 3) {
#pragma unroll
                    for (int i = 0; i < 8; ++i) rr[i] = *(const v4u*)(src[i] + (ch + 1) * 256);
                }
                if (active) {
#pragma unroll
                    for (int kk = 0; kk < 8; ++kk) {
                        const pg8::bf16x8 af = *(const LAS pg8::bf16x8*)(L + (mb * 16 + fm) * RS + kk * 64 + kq * 16);
                        const pg8::bf16x8 bg = *(const LAS pg8::bf16x8*)(L + (64 + cg * 16 + fm) * RS + kk * 64 + kq * 16);
                        const pg8::bf16x8 bu = *(const LAS pg8::bf16x8*)(L + (96 + cg * 16 + fm) * RS + kk * 64 + kq * 16);
                        accg = __builtin_amdgcn_mfma_f32_16x16x32_bf16(af, bg, accg, 0, 0, 0);
                        accu = __builtin_amdgcn_mfma_f32_16x16x32_bf16(af, bu, accu, 0, 0, 0);
                    }
                }
            }
            if (active) {
#pragma unroll
                for (int i = 0; i < 4; ++i) { const int lr = rg * 64 + mb * 16 + 4 * kq + i, li = off + lr;
                    if (li < cn) { const f32x2 w2 = EW[(size_t)e * 16384 + li]; const float g = accg[i] * w2.y, up = accu[i] * w2.y;
                        const float hv = g * __builtin_amdgcn_rcpf(1.0f + __builtin_amdgcn_exp2f(-g * LOG2E)) * up * w2.x;
                        const unsigned hb = (unsigned)f2bf(hv); bf16* hp = HH + (size_t)(pm * 256 + lr) * 256 + f0 + cg * 16 + fm;
                        asm volatile("global_store_short %0, %1, off sc1" :: "v"(hp), "v"(hb) : "memory"); } }
            }
            asm volatile("s_waitcnt vmcnt(0)" ::: "memory");
            __syncthreads();
            if (tid == 0) (void)__hip_atomic_fetch_add(hcnt + pm * 16, pub, __ATOMIC_RELAXED, __HIP_MEMORY_SCOPE_AGENT);
        }
        base = (base + nun) % G;
    }
}
__device__ __forceinline__ void moe_route(const Params& p, LAS unsigned char* L, int layer, const float* H, int gw, int NGW, int lane, int wave) {
    unsigned char* ws = p.ws;
    const float* b_group = p.in[15] + layer * 4; const float* b_router = p.in[17] + layer * 32; const float* gain = p.in[2] + layer * 1024;
    unsigned* cnt = (unsigned*)(ws + WS_CTL) + CW_ECNT + layer * 32 * 64;
    bf16* UB = (bf16*)(ws + WS_U);
    const int g4 = wave & 3, half = wave >> 2;
    LAS float* lg = (LAS float*)(L + g4 * 4096);
    LAS float* pl = (LAS float*)(L + 16384 + g4 * 4096);
    LAS unsigned* lc = (LAS unsigned*)(L + 32768);
    const int tok = lane & 15, kq = lane >> 4, tid = wave * 64 + lane;
    const int G_ = NGW / NWAVES, vcu_ = gw / NWAVES;
    for (int base = 0; base < NTOK / 16; base += 4 * G_) {
        const int grp = base + g4 * G_ + vcu_;
        const bool active = (grp < NTOK / 16);
        if (tid < 32) lc[tid] = 0u;
        int e0 = 0, e1 = 0; unsigned r0 = 0u, r1 = 0u; float wA = 0.f, wB = 0.f, rtok = 0.f; const int m0 = grp * 16;
        pg8::f32x4 acc0 = {0.f, 0.f, 0.f, 0.f}, acc1 = acc0, acc2 = acc0; float ss = 0.f;
        if (active) {
            const int kb = 512 * half + 8 * kq;
            const float* hrow = H + (size_t)(m0 + tok) * 1024 + kb;
            const float* grow = gain + kb;
            bf16* urow = UB + (size_t)(m0 + tok) * 1024 + kb;
            const bf16* wh = (const bf16*)(ws + WS_WRT + 512 * 1024) + ((size_t)layer * 32 + 16 * half) * 1536 + lane * 8;
            const bf16* wl = (const bf16*)(ws + WS_WRT + 768 * 1024) + ((size_t)layer * 32 + 16 * half) * 1536 + lane * 8;
            f32x4 ra0[2], ra1[2], rq0[2], rq1[2]; bf16x8 rbh0[2], rbl0[2], rbh1[2], rbl1[2], rbh2[2], rbl2[2];
#define RT_LD(S, C) do { ra0[S] = *(const f32x4*)(hrow + 32 * (C)); ra1[S] = *(const f32x4*)(hrow + 32 * (C) + 4); rq0[S] = *(const f32x4*)(grow + 32 * (C)); rq1[S] = *(const f32x4*)(grow + 32 * (C) + 4); \
                rbh0[S] = *(const bf16x8*)(wh + 1536 * (C)); rbl0[S] = *(const bf16x8*)(wl + 1536 * (C)); rbh1[S] = *(const bf16x8*)(wh + 1536 * (C) + 512); rbl1[S] = *(const bf16x8*)(wl + 1536 * (C) + 512); \
                rbh2[S] = *(const bf16x8*)(wh + 1536 * (C) + 1024); rbl2[S] = *(const bf16x8*)(wl + 1536 * (C) + 1024); } while (0)
#define RT_DO(S, C) do { const f32x4 a0 = ra0[S], a1 = ra1[S], q0 = rq0[S], q1 = rq1[S]; \
                ss += ((a0.x * a0.x + a0.y * a0.y) + (a0.z * a0.z + a0.w * a0.w)) + ((a1.x * a1.x + a1.y * a1.y) + (a1.z * a1.z + a1.w * a1.w)); \
                { v4u ub; ub.x = pg8::cvt_pk_bf16(a0.x * q0.x, a0.y * q0.y); ub.y = pg8::cvt_pk_bf16(a0.z * q0.z, a0.w * q0.w); ub.z = pg8::cvt_pk_bf16(a1.x * q1.x, a1.y * q1.y); ub.w = pg8::cvt_pk_bf16(a1.z * q1.z, a1.w * q1.w); \
                  *(v4u*)(urow + 32 * (C)) = ub; } \
                v4u hi4, lo4; \
                hi4.x = pg8::cvt_pk_bf16(a0.x, a0.y); hi4.y = pg8::cvt_pk_bf16(a0.z, a0.w); hi4.z = pg8::cvt_pk_bf16(a1.x, a1.y); hi4.w = pg8::cvt_pk_bf16(a1.z, a1.w); \
                lo4.x = pg8::cvt_pk_bf16(a0.x - bflo(hi4.x), a0.y - bfhi(hi4.x)); lo4.y = pg8::cvt_pk_bf16(a0.z - bflo(hi4.y), a0.w - bfhi(hi4.y)); \
                lo4.z = pg8::cvt_pk_bf16(a1.x - bflo(hi4.z), a1.y - bfhi(hi4.z)); lo4.w = pg8::cvt_pk_bf16(a1.z - bflo(hi4.w), a1.w - bfhi(hi4.w)); \
                const bf16x8 ah = __builtin_bit_cast(bf16x8, hi4), al = __builtin_bit_cast(bf16x8, lo4); \
                acc0 = __builtin_amdgcn_mfma_f32_16x16x32_bf16(ah, rbh0[S], acc0, 0, 0, 0); acc1 = __builtin_amdgcn_mfma_f32_16x16x32_bf16(ah, rbh1[S], acc1, 0, 0, 0); acc2 = __builtin_amdgcn_mfma_f32_16x16x32_bf16(ah, rbh2[S], acc2, 0, 0, 0); \
                acc0 = __builtin_amdgcn_mfma_f32_16x16x32_bf16(ah, rbl0[S], acc0, 0, 0, 0); acc1 = __builtin_amdgcn_mfma_f32_16x16x32_bf16(ah, rbl1[S], acc1, 0, 0, 0); acc2 = __builtin_amdgcn_mfma_f32_16x16x32_bf16(ah, rbl2[S], acc2, 0, 0, 0); \
                acc0 = __builtin_amdgcn_mfma_f32_16x16x32_bf16(al, rbh0[S], acc0, 0, 0, 0); acc1 = __builtin_amdgcn_mfma_f32_16x16x32_bf16(al, rbh1[S], acc1, 0, 0, 0); acc2 = __builtin_amdgcn_mfma_f32_16x16x32_bf16(al, rbh2[S], acc2, 0, 0, 0); } while (0)
            RT_LD(0, 0);
#pragma unroll 1
            for (int c = 0; c < 16; c += 2) {
                RT_LD(1, c + 1);
                RT_DO(0, c);
                if (c + 2 < 16) RT_LD(0, c + 2);
                RT_DO(1, c + 1);
            }
#undef RT_LD
#undef RT_DO
            ss += __shfl_xor(ss, 16); ss += __shfl_xor(ss, 32);
            if (half == 1) {
#pragma unroll
                for (int i = 0; i < 4; ++i) { const int tk = 4 * kq + i; pl[tk * 48 + tok] = acc0[i]; pl[tk * 48 + 16 + tok] = acc1[i]; pl[tk * 48 + 32 + tok] = acc2[i]; }
                if (lane < 16) pl[768 + lane] = ss;
            }
        }
        __syncthreads();
        if (active && half == 0) {
            ss += pl[768 + tok];
            const float r = 1.0f / sqrtf(ss * (1.f / 1024.f) + RMS_EPS);
            rtok = r;
            const int col = lane & 15;
            const float bia0 = b_router[col], bia1 = b_router[16 + col], bia2 = (col < 4) ? b_group[col] : 0.f;
#pragma unroll
            for (int i = 0; i < 4; ++i) { const int tk = 4 * kq + i; const float rt = __shfl(r, tk);
                lg[tk * 48 + col] = (acc0[i] + pl[tk * 48 + col]) * rt + bia0; lg[tk * 48 + 16 + col] = (acc1[i] + pl[tk * 48 + 16 + col]) * rt + bia1; lg[tk * 48 + 32 + col] = (acc2[i] + pl[tk * 48 + 32 + col]) * rt + bia2; }
            LDS_WAIT(); asm volatile("" ::: "memory");
            if (lane < 16) {
                const LAS float* l = lg + lane * 48;
                int gs = 0; float gm = l[32];
#pragma unroll
                for (int j = 1; j < 4; ++j) { const float v = l[32 + j]; if (v > gm) { gm = v; gs = j; } }
                float gsum = 0.f;
#pragma unroll
                for (int j = 0; j < 4; ++j) gsum += expf(l[32 + j] - gm);
                const float ggate = 1.0f / gsum;
                const LAS float* el = l + gs * 8;
                float v0 = el[0]; int a0 = 0;
#pragma unroll
                for (int j = 1; j < 8; ++j) { const float v = el[j]; if (v > v0) { v0 = v; a0 = j; } }
                float v1 = -INFINITY; int a1 = 0;
#pragma unroll
                for (int j = 0; j < 8; ++j) { const float v = el[j]; if (j != a0 && v > v1) { v1 = v; a1 = j; } }
                const float p1 = expf(v1 - v0), ps = 1.0f + p1;
                e0 = gs * 8 + a0; e1 = gs * 8 + a1; wA = ggate / ps; wB = ggate * p1 / ps;
                r0 = __hip_atomic_fetch_add(lc + e0, 1u, __ATOMIC_RELAXED, __HIP_MEMORY_SCOPE_WORKGROUP);
                r1 = __hip_atomic_fetch_add(lc + e1, 1u, __ATOMIC_RELAXED, __HIP_MEMORY_SCOPE_WORKGROUP);
            }
        }
        __syncthreads();
        if (tid < 32) { const unsigned c = lc[tid]; lc[32 + tid] = c ? __hip_atomic_fetch_add(cnt + tid * 64, c, __ATOMIC_RELAXED, __HIP_MEMORY_SCOPE_AGENT) : 0u; }
        __syncthreads();
        if (active && half == 0 && lane < 16) {
            const unsigned pos0 = lc[32 + e0] + r0, pos1 = lc[32 + e1] + r1;
            v4u ti; ti.x = ((unsigned)e0 << 16) | pos0; ti.y = ((unsigned)e1 << 16) | pos1; ti.z = __builtin_bit_cast(unsigned, wA); ti.w = __builtin_bit_cast(unsigned, wB);
            *((v4u*)(ws + WS_TOKINFO) + m0 + lane) = ti;
            { int* EL = (int*)(ws + WS_EL); f32x2* EW = (f32x2*)(ws + WS_EW); EL[e0 * 16384 + pos0] = m0 + lane; EL[e1 * 16384 + pos1] = m0 + lane; EW[e0 * 16384 + pos0] = (f32x2){wA, rtok}; EW[e1 * 16384 + pos1] = (f32x2){wB, rtok}; }
        }
        __syncthreads();
    }
}
template <bool FINAL>
__device__ __forceinline__ void moe_combine(const Params& p, LAS unsigned char* L, float* H, const float* gain, int gw, int NGW, int lane) {
    unsigned char* ws = p.ws; const LAS int* seg = (const LAS int*)(L + MOE_T2E_OFF + 256);
    const bf16* YE = (const bf16*)(ws + WS_XG); bf16* U = (bf16*)(ws + WS_U);
    const f32x4* gr = (const f32x4*)gain + lane;
    for (int m0 = gw; m0 < NTOK / 2; m0 += NGW) {
        const int mA = m0, mB = m0 + NTOK / 2;
        const v2u tA = *((const v2u*)(ws + WS_TOKINFO) + 2 * mA), tB = *((const v2u*)(ws + WS_TOKINFO) + 2 * mB);
        const int rA0 = seg[tA.x >> 16] + (int)(tA.x & 0xffffu), rA1 = seg[tA.y >> 16] + (int)(tA.y & 0xffffu);
        const int rB0 = seg[tB.x >> 16] + (int)(tB.x & 0xffffu), rB1 = seg[tB.y >> 16] + (int)(tB.y & 0xffffu);
        f32x4* hA = (f32x4*)(H + (size_t)mA * 1024) + lane; f32x4* hB = (f32x4*)(H + (size_t)mB * 1024) + lane;
        const v2u* yA0 = (const v2u*)(YE + (size_t)rA0 * 1024) + lane; const v2u* yA1 = (const v2u*)(YE + (size_t)rA1 * 1024) + lane;
        const v2u* yB0 = (const v2u*)(YE + (size_t)rB0 * 1024) + lane; const v2u* yB1 = (const v2u*)(YE + (size_t)rB1 * 1024) + lane;
        f32x4 va[4], vb[4]; v2u a0[4], a1[4], b0[4], b1[4];
#pragma unroll
        for (int j = 0; j < 4; ++j) { va[j] = hA[64 * j]; vb[j] = hB[64 * j]; a0[j] = yA0[64 * j]; a1[j] = yA1[64 * j]; b0[j] = yB0[64 * j]; b1[j] = yB1[64 * j]; }
        float sa = 0.f, sb = 0.f;
#pragma unroll
        for (int j = 0; j < 4; ++j) {
            va[j].x += bflo(a0[j].x) + bflo(a1[j].x); va[j].y += bfhi(a0[j].x) + bfhi(a1[j].x); va[j].z += bflo(a0[j].y) + bflo(a1[j].y); va[j].w += bfhi(a0[j].y) + bfhi(a1[j].y);
            vb[j].x += bflo(b0[j].x) + bflo(b1[j].x); vb[j].y += bfhi(b0[j].x) + bfhi(b1[j].x); vb[j].z += bflo(b0[j].y) + bflo(b1[j].y); vb[j].w += bfhi(b0[j].y) + bfhi(b1[j].y);
            sa += (va[j].x * va[j].x + va[j].y * va[j].y) + (va[j].z * va[j].z + va[j].w * va[j].w);
            sb += (vb[j].x * vb[j].x + vb[j].y * vb[j].y) + (vb[j].z * vb[j].z + vb[j].w * vb[j].w); }
#pragma unroll
        for (int o = 1; o < 64; o <<= 1) { sa += __shfl_xor(sa, o); sb += __shfl_xor(sb, o); }
        const float ra = 1.0f / sqrtf(sa * (1.f / 1024.f) + RMS_EPS), rb = 1.0f / sqrtf(sb * (1.f / 1024.f) + RMS_EPS);
        if (FINAL) {
#pragma unroll
            for (int j = 0; j < 4; ++j) { const f32x4 g = gr[64 * j];
                hA[64 * j] = (f32x4){va[j].x * ra * g.x, va[j].y * ra * g.y, va[j].z * ra * g.z, va[j].w * ra * g.w};
                hB[64 * j] = (f32x4){vb[j].x * rb * g.x, vb[j].y * rb * g.y, vb[j].z * rb * g.z, vb[j].w * rb * g.w}; }
        } else {
            unsigned long long* oA = (unsigned long long*)(U + (size_t)mA * 1024) + lane; unsigned long long* oB = (unsigned long long*)(U + (size_t)mB * 1024) + lane;
#pragma unroll
            for (int j = 0; j < 4; ++j) { const f32x4 g = gr[64 * j]; hA[64 * j] = va[j]; hB[64 * j] = vb[j];
                oA[64 * j] = (unsigned long long)pk2(va[j].x * ra * g.x, va[j].y * ra * g.y) | ((unsigned long long)pk2(va[j].z * ra * g.z, va[j].w * ra * g.w) << 32);
                oB[64 * j] = (unsigned long long)pk2(vb[j].x * rb * g.x, vb[j].y * rb * g.y) | ((unsigned long long)pk2(vb[j].z * rb * g.z, vb[j].w * rb * g.w) << 32); }
        }
    }
}
__device__ __forceinline__ int mbl_off(int n) { return 256 * (31 * n - (n * (n - 1)) / 2); }
constexpr int MBL_PER_BH = 256 * 496;
__global__ void __launch_bounds__(NWAVES * 64, 2) mega(Params p) {
    extern __shared__ __attribute__((aligned(16))) unsigned char lds[];
    LAS unsigned char* L = (LAS unsigned char*)lds;
    const int tid = threadIdx.x, lane = tid & 63, wave = __builtin_amdgcn_readfirstlane(tid >> 6);
    const int G = gridDim.x, bx = blockIdx.x;
    const int vcu = (G % 8 == 0) ? (bx % 8) * (G / 8) + bx / 8 : bx;
    unsigned char* ws = p.ws;
    volatile LAS unsigned* MISC = (volatile LAS unsigned*)(L + MISC_OFF);
    if (tid < 32) MISC[tid] = 0u;
    __syncthreads();
    XcdBarrier bar = xcd_barrier_post((unsigned*)(ws + WS_CTL) + CW_BAR + p.li * XCD_BAR_WORDS, MISC + 8);
    const int lo = p.ph_lo, hi = p.ph_hi;
#define IN(k) (lo <= (k) && (k) < hi)
#define BOTH(k) (IN(k) && IN((k) + 1))
    const int gw = vcu * NWAVES + wave, NGW = G * NWAVES, gtid = vcu * (NWAVES * 64) + tid, NGT = G * NWAVES * 64;

    if (IN(0)) for (int rep = 0; rep < REPS[0]; ++rep) { p0_prologue(p, L, gw, NGW, lane, wave, gtid, NGT); if (BOTH(0) && rep == REPS[0] - 1) xcd_barrier(bar); }

    if (IN(1)) for (int rep = 0; rep < REPS[1]; ++rep) {
        pg8::Gemm g{(const pg8::bf16_t*)(ws + WS_U), (const pg8::bf16_t*)(ws + WS_WINE), NTOK, 1280, 1024};
        pg8::StaticOrder S; S.init(NTOK, 1280, G, bx);
        EpiStore E{(bf16*)(ws + WS_PROJ0), 1280, -1};
        pg8::gemm_phase<EpiStore, pg8::StaticOrder, true, true>(L + RING_OFF, g, S, E);
        { const int total = (NTOK / 256) * 5, rem = total % G, nidle = rem ? G - rem : G;
          if (rep == 0 && bx >= (rem ? rem : 0)) { __syncthreads(); moe_convert(p, L, 0, (bx - rem) * NWAVES + wave, nidle * NWAVES, lane, wave); } }
        if (BOTH(1) && rep == REPS[1] - 1) xcd_barrier(bar);
    }

    if (IN(2)) for (int rep = 0; rep < REPS[2]; ++rep) {
        const bf16* P0 = (const bf16*)(ws + WS_PROJ0); bf16* CQN = (bf16*)(ws + WS_CQN); bf16* CKVN = (bf16*)(ws + WS_CKVN); bf16* KR = (bf16*)(ws + WS_KR);
        const f32x2* rope = (const f32x2*)(ws + WS_ROPE);
        const f32x4 gq = *((const f32x4*)p.in[6] + lane); const f32x2 gkv = *((const f32x2*)p.in[7] + lane);
        for (int m = gw; m < NTOK; m += NGW) {
            const bf16* pr = P0 + (size_t)m * 1280;
            const v2u w = *(const v2u*)(pr + lane * 4); const unsigned w1 = *(const unsigned*)(pr + 256 + lane * 2);
            const float c0 = bflo(w.x), c1 = bfhi(w.x), c2 = bflo(w.y), c3 = bfhi(w.y), k0 = bflo(w1), k1 = bfhi(w1);
            const float r = 1.0f / sqrtf(wsum((c0 * c0 + c1 * c1) + (c2 * c2 + c3 * c3)) * (1.f / 256.f) + RMS_EPS);
            const float r2 = 1.0f / sqrtf(wsum(k0 * k0 + k1 * k1) * (1.f / 128.f) + RMS_EPS);
            v2u o; o.x = pk2(c0 * r * gq.x, c1 * r * gq.y); o.y = pk2(c2 * r * gq.z, c3 * r * gq.w);
            *(v2u*)(CQN + (size_t)m * 256 + lane * 4) = o;
            *(unsigned*)(CKVN + (size_t)m * 128 + lane * 2) = pk2(k0 * r2 * gkv.x, k1 * r2 * gkv.y);
            if (lane < 16) { const float x1 = bf2f(pr[384 + lane]), x2 = bf2f(pr[400 + lane]); const f32x2 cs = rope[(size_t)(m & 8191) * 16 + lane];
                KR[(size_t)m * 32 + lane] = (bf16)f2bf(x1 * cs.x - x2 * cs.y); KR[(size_t)m * 32 + 16 + lane] = (bf16)f2bf(x2 * cs.x + x1 * cs.y); }
        }
        if (BOTH(2) && rep == REPS[2] - 1) xcd_barrier(bar);
    }

    if (IN(3)) for (int rep = 0; rep < REPS[3]; ++rep) {
        { pg8::Gemm g{(const pg8::bf16_t*)(ws + WS_CQN), (const pg8::bf16_t*)(ws + WS_WQB), NTOK, 768, 256};
          pg8::StaticOrder S; S.init(NTOK, 768, G, bx);
          EpiStore E{(bf16*)(ws + WS_Q), 768, -1};
          pg8::gemm_phase<EpiStore, pg8::StaticOrder, false, true>(L + RING_OFF, g, S, E); }
        { pg8::Gemm g{(const pg8::bf16_t*)(ws + WS_CKVN), (const pg8::bf16_t*)(ws + WS_WKVB), NTOK, 1024, 128};
          pg8::StaticOrder S; S.init(NTOK, 1024, G, bx);
          EpiStore E{(bf16*)(ws + WS_KVB), 1024, -1};
          pg8::gemm_phase<EpiStore, pg8::StaticOrder, false, true>(L + RING_OFF, g, S, E); }
        if (BOTH(3) && rep == REPS[3] - 1) xcd_barrier(bar);
    }

    if (IN(4)) for (int rep = 0; rep < REPS[4]; ++rep) {
        const bf16* Qb = (const bf16*)(ws + WS_Q); const bf16* KVB = (const bf16*)(ws + WS_KVB); const bf16* KR = (const bf16*)(ws + WS_KR); const bf16* P0 = (const bf16*)(ws + WS_PROJ0);
        bf16* MIX = (bf16*)(ws + WS_U); const MobaArgs mb0{};
        { const float* BT = (const float*)(ws + WS_BIAS); LAS float* tb = (LAS float*)(L + ABIAS_OFF);
          for (int i = tid; i < 8 * 320; i += NWAVES * 64) { const int h = i / 320, d = (i % 320) - 64; tb[i] = (d >= 0 && d < 128) ? BT[h * 8192 + d] : 0.f; } }
        __syncthreads();
        for (int pi = vcu; pi < 256; pi += G) {
            const int bh = pi >> 4, s = pi & 15, b = bh >> 3, h = bh & 7;
#pragma unroll 1
            for (int ui = 0; ui < 2; ++ui) {
                const int qb = ui ? s : 31 - s, q0u = qb * 256, q0w = q0u + 32 * wave; const size_t r0 = (size_t)b * T_;
                AttnPtrs a; a.Q = Qb + (r0 + q0w) * 768 + h * 96; a.qs = 768; a.K = KVB + r0 * 1024 + h * 128; a.ks = 1024; a.K2 = KR + r0 * 32;
                a.V = KVB + r0 * 1024 + h * 128 + 64; a.vs = 1024; a.O = MIX + (r0 + q0w) * 1024 + h * 64;
                attn_unit<AM_MLA>(L, a, q0u, q0w, 0, (q0u + 255) >> 6, 0.10206207261596575f * LOG2E, 0.f, mb0, 0, (const f32x2*)(ws + WS_ROPE), tid, lane, wave);
            }
        }
        for (int id = vcu; id < 512; id += G) {
            const int b = id >> 8, hkv = (id >> 7) & 1, qt = id & 127, q0u = qt * 64, hq = 4 * hkv + (wave >> 1), q0w = q0u + 32 * (wave & 1); const size_t r0 = (size_t)b * T_;
            AttnPtrs a; a.Q = P0 + (r0 + q0w) * 1280 + 416 + hq * 64; a.qs = 1280; a.K = P0 + r0 * 1280 + 928 + hkv * 64; a.ks = 1280; a.K2 = nullptr;
            a.V = P0 + r0 * 1280 + 1056 + hkv * 64; a.vs = 1280; a.O = MIX + (r0 + q0w) * 1024 + 512 + hq * 64;
            attn_unit<AM_SWA>(L, a, q0u, q0w, qt >= 2 ? qt - 2 : 0, qt, 0.125f * LOG2E, p.in[10][hq] * LOG2E, mb0, hq * 320, nullptr, tid, lane, wave);
        }
        __syncthreads();
        if (BOTH(4) && rep == REPS[4] - 1) xcd_barrier(bar);
    }

    if (IN(5)) for (int rep = 0; rep < REPS[5]; ++rep) {
        pg8::Gemm g{(const pg8::bf16_t*)(ws + WS_U), (const pg8::bf16_t*)(ws + WS_WOE), NTOK, 1024, 1024};
        pg8::StaticOrder S; S.init(NTOK, 1024, G, bx);
        EpiResid E{p.in[0], p.out};
        pg8::gemm_phase<EpiResid, pg8::StaticOrder, false, true>(L + RING_OFF, g, S, E);
        if (BOTH(5) && rep == REPS[5] - 1) xcd_barrier(bar);
    }

    if (IN(6)) { moe_route(p, L, 0, p.out, gw, NGW, lane, wave); if (BOTH(6)) xcd_barrier(bar); }
    if (IN(8)) {
        int nt, nfull; moe_tables<true>(p, L, 0, tid, G, nt, nfull);
        unsigned* hcnt = (unsigned*)(ws + WS_CTL) + CW_HCNT + 0 * 160 * 16;
        const int total1 = nfull * 2, rem = total1 % G, q = ((int)bx + G - rem) % G;
        { pg8::Gemm g{(const pg8::bf16_t*)(ws + WS_U), (const pg8::bf16_t*)(ws + WS_MOEW), nt * 256, 32 * 512, 1024};
          MoeOrderG<2> S{total1, G, bx, L + MOE_T2E_OFF, (const LAS int*)(L + MOE_T2E_OFF + 256), (const LAS int*)(L + MOE_T2E_OFF + 512), (const int*)(ws + WS_EL), hcnt, L + MOE_T2E_OFF + 640};
          EpiSwiGLU E{(bf16*)(ws + WS_HH), (const f32x2*)(ws + WS_EW), L + MOE_T2E_OFF, (const LAS int*)(L + MOE_T2E_OFF + 256)};
          pg8::gemm_phase_g<EpiSwiGLU, MoeOrderG<2>, false, true>(L + RING_OFF, g, S, E); }
        __syncthreads();
        moe_tail_units(p, L, (const bf16*)(ws + WS_MOEW), hcnt, nfull, nt, q, G, tid, lane, wave);
        { const int ntu = (nt - nfull) * 16, nw = (ntu <= G - 64) ? G - ntu : G, r = (ntu <= G - 64) ? q - ntu : q;
          if (r >= 0) { __syncthreads(); moe_convert(p, L, 1, r * NWAVES + wave, nw * NWAVES, lane, wave); __syncthreads(); } }
        { pg8::Gemm g{(const pg8::bf16_t*)(ws + WS_HH), (const pg8::bf16_t*)(ws + WS_MOEW + 32 * MiB), nt * 256, 32 * 1024, 256};
          MoeOrderD<4> S{nt * 4, L + MOE_T2E_OFF, L + MOE_T2E_OFF + 640, hcnt, (unsigned*)(ws + WS_CTL) + CW_TICK + 0 * 64, (LAS unsigned*)(L + MOE_T2E_OFF + 804)};
          EpiStore E{(bf16*)(ws + WS_XG), 1024, 3};
          pg8::gemm_phase<EpiStore, MoeOrderD<4>, false, true>(L + RING_OFF, g, S, E); }
        if (BOTH(8)) xcd_barrier(bar);
    }
    if (IN(10)) { int nt, nfl; moe_tables<false>(p, L, 0, tid, G, nt, nfl); moe_combine<false>(p, L, p.out, p.in[1] + 1024, gw, NGW, lane); __syncthreads(); if (BOTH(10)) xcd_barrier(bar); }

    if (IN(11)) for (int rep = 0; rep < REPS[11]; ++rep) {
        pg8::Gemm g{(const pg8::bf16_t*)(ws + WS_U), (const pg8::bf16_t*)(ws + WS_WINO), NTOK, 3072, 1024};
        pg8::StaticOrder S; S.init(NTOK, 3072, G, bx);
        EpiStore E{(bf16*)(ws + WS_PROJ1), 3072, -1};
        pg8::gemm_phase<EpiStore, pg8::StaticOrder, true, true>(L + RING_OFF, g, S, E);
        if (BOTH(11) && rep == REPS[11] - 1) xcd_barrier(bar);
    }
    if (IN(12)) for (int rep = 0; rep < REPS[12]; ++rep) {
        const bf16* P1 = (const bf16*)(ws + WS_PROJ1); float* KM = (float*)(ws + WS_KMEAN);
        LAS float* part = (LAS float*)L;
        for (int id = vcu; id < 64; id += G) { const int b = id >> 5, n = id & 31;
            const bf16* kp = P1 + ((size_t)b * T_ + n * 256 + wave * 32) * 3072 + 512 + lane * 8;
            float acc[8] = {0.f, 0.f, 0.f, 0.f, 0.f, 0.f, 0.f, 0.f};
#pragma unroll 8
            for (int j = 0; j < 32; ++j) { const v4u w = *(const v4u*)(kp + (size_t)j * 3072);
                acc[0] += bflo(w.x); acc[1] += bfhi(w.x); acc[2] += bflo(w.y); acc[3] += bfhi(w.y); acc[4] += bflo(w.z); acc[5] += bfhi(w.z); acc[6] += bflo(w.w); acc[7] += bfhi(w.w); }
            __syncthreads();
#pragma unroll
            for (int j = 0; j < 8; ++j) part[wave * 512 + lane * 8 + j] = acc[j];
            __syncthreads();
            { const int c = tid;
              float s = 0.f;
#pragma unroll
              for (int w = 0; w < 8; ++w) s += part[w * 512 + c];
              KM[((size_t)(b * 8 + (c >> 6)) * 32 + n) * 64 + (c & 63)] = s * (1.0f / 256.f); }
        }
        __syncthreads();
        if (BOTH(12) && rep == REPS[12] - 1) xcd_barrier(bar);
    }
    if (IN(13)) {
        const bf16* P1 = (const bf16*)(ws + WS_PROJ1); const float* KM = (const float*)(ws + WS_KMEAN);
        unsigned* mcnt = (unsigned*)(ws + WS_CTL) + CW_MBCNT; unsigned* LIST = (unsigned*)(ws + WS_MBLIST);
        LAS float* kml = (LAS float*)L;
        LAS unsigned char* qst = L + 8192 + (wave & 3) * 9216;
        int bhc = -1;
        for (int id0 = vcu * 4; id0 < 1024; id0 += G * 4) {
            const int id = id0 + (wave & 3), bh = id >> 6, qc2 = id & 63, b = bh >> 3, h = bh & 7, own = qc2 >> 1;
            if (bh != bhc) { __syncthreads(); *(LAS f32x4*)(kml + tid * 4) = *(const f32x4*)(KM + (size_t)bh * 2048 + tid * 4); bhc = bh; __syncthreads(); }
            if (wave < 4) {
                float qv[2][64];
#pragma unroll
                for (int s = 0; s < 2; ++s) {
                    const bf16* qb = P1 + ((size_t)b * T_ + qc2 * 128 + s * 64) * 3072 + h * 64; v4u t[8];
#pragma unroll
                    for (int j = 0; j < 8; ++j) t[j] = *(const v4u*)(qb + (size_t)(8 * j + (lane >> 3)) * 3072 + (lane & 7) * 8);
#pragma unroll
                    for (int j = 0; j < 8; ++j) *(LAS v4u*)(qst + (8 * j + (lane >> 3)) * 144 + (lane & 7) * 16) = t[j];
#pragma unroll
                    for (int c = 0; c < 8; ++c) { const v4u w = *(const LAS v4u*)(qst + lane * 144 + c * 16);
                        qv[s][8 * c + 0] = bflo(w.x); qv[s][8 * c + 1] = bfhi(w.x); qv[s][8 * c + 2] = bflo(w.y); qv[s][8 * c + 3] = bfhi(w.y);
                        qv[s][8 * c + 4] = bflo(w.z); qv[s][8 * c + 5] = bfhi(w.z); qv[s][8 * c + 6] = bflo(w.w); qv[s][8 * c + 7] = bfhi(w.w); }
                }
                float b0[2] = {-INFINITY, -INFINITY}, b1[2] = {-INFINITY, -INFINITY}, b2[2] = {-INFINITY, -INFINITY}; int i0[2] = {-1, -1}, i1[2] = {-1, -1}, i2[2] = {-1, -1};
                for (int n = 0; n < own; ++n) {
                    const LAS f32x4* km = (const LAS f32x4*)(kml + n * 64);
                    float g[2] = {0.f, 0.f};
#pragma unroll
                    for (int c = 0; c < 16; ++c) { const f32x4 kv = km[c];
#pragma unroll
                        for (int s = 0; s < 2; ++s) g[s] += qv[s][4 * c] * kv.x + qv[s][4 * c + 1] * kv.y + qv[s][4 * c + 2] * kv.z + qv[s][4 * c + 3] * kv.w; }
#pragma unroll
                    for (int s = 0; s < 2; ++s) {
                        if (g[s] > b0[s]) { b2[s] = b1[s]; i2[s] = i1[s]; b1[s] = b0[s]; i1[s] = i0[s]; b0[s] = g[s]; i0[s] = n; }
                        else if (g[s] > b1[s]) { b2[s] = b1[s]; i2[s] = i1[s]; b1[s] = g[s]; i1[s] = n; }
                        else if (g[s] > b2[s]) { b2[s] = g[s]; i2[s] = n; } }
                }
#pragma unroll
                for (int s = 0; s < 2; ++s) {
                    const int q = qc2 * 128 + s * 64 + lane;
                    int mycnt = 0;
                    for (int n = 0; n < own; ++n) { const unsigned long long mask = __ballot((i0[s] == n) || (i1[s] == n) || (i2[s] == n)); if (lane == n) mycnt = __builtin_popcountll(mask); }
                    unsigned mybase = 0u;
                    if (mycnt > 0) mybase = __hip_atomic_fetch_add(mcnt + (bh * 32 + lane) * 16, (unsigned)mycnt, __ATOMIC_RELAXED, __HIP_MEMORY_SCOPE_AGENT);
                    for (int n = 0; n < own; ++n) {
                        const int sl = (i0[s] == n) ? 0 : (i1[s] == n) ? 1 : (i2[s] == n) ? 2 : -1;
                        const unsigned long long mask = __ballot(sl >= 0);
                        const unsigned base = __shfl(mybase, n);
                        if (sl >= 0) LIST[(size_t)bh * MBL_PER_BH + mbl_off(n) + base + (unsigned)__builtin_popcountll(mask & ((1ull << lane) - 1ull))] = (unsigned)q | ((unsigned)sl << 13);
                    }
                }
            }
        }
        if (BOTH(13)) xcd_barrier(bar);
    }
    if (IN(14)) for (int rep = 0; rep < REPS[14]; ++rep) {
        const bf16* P1 = (const bf16*)(ws + WS_PROJ1); bf16* MIX = (bf16*)(ws + WS_U);
        const float* BT = (const float*)(ws + WS_BIAS);
        const unsigned* mcnt = (const unsigned*)(ws + WS_CTL) + CW_MBCNT; const unsigned* LIST = (const unsigned*)(ws + WS_MBLIST);
        LAS int* pre = (LAS int*)(L + UT_OFF); LAS int* cntL = pre + 513;
        __syncthreads();
        { const int c = (int)__hip_atomic_load(mcnt + tid * 16, __ATOMIC_RELAXED, __HIP_MEMORY_SCOPE_AGENT); cntL[tid] = c; pre[tid + 1] = (c + 255) >> 8; if (tid == 0) pre[0] = 0; }
        __syncthreads();
        if (tid < 64) {
            int v[8], sum = 0;
#pragma unroll
            for (int j = 0; j < 8; ++j) { v[j] = pre[1 + tid * 8 + j]; sum += v[j]; }
            int inc = sum;
#pragma unroll
            for (int o = 1; o < 64; o <<= 1) { const int x = __shfl_up(inc, o); if (tid >= o) inc += x; }
            int run = inc - sum;
#pragma unroll
            for (int j = 0; j < 8; ++j) { run += v[j]; pre[1 + tid * 8 + j] = run; }
        }
        __syncthreads();
        const int nchunks = pre[512], per = (nchunks + G - 1) / G;
        int hcur = -1;
        MobaArgs mb; mb.PARTO = (bf16*)(ws + WS_PARTO); mb.PARTML = (f32x2*)(ws + WS_PARTML);
        int icur = -1;
        for (int rc = 0; rc < REP_CH; ++rc)
        for (int u = vcu * per; u < (vcu + 1) * per && u < nchunks; ++u) {
            int lo = 0, hi_ = 512;
            while (hi_ - lo > 1) { const int mid = (lo + hi_) >> 1; if (pre[mid] <= u) lo = mid; else hi_ = mid; }
            const int i = __builtin_amdgcn_readfirstlane(lo), c = u - __builtin_amdgcn_readfirstlane(pre[lo]), bh = i >> 5, n = i & 31, b = bh >> 3, h = bh & 7, cn = __builtin_amdgcn_readfirstlane(cntL[i]);
            const size_t r0 = (size_t)b * T_;
            if (i != icur) {
                __syncthreads();
                moba_resident_load(L, P1 + (r0 + (size_t)n * 256) * 3072 + 512 + h * 64, P1 + (r0 + (size_t)n * 256) * 3072 + 1024 + h * 64, tid);
                if (h != hcur) { LAS float* tb = (LAS float*)(L + RB_OFF); for (int j = tid; j < 64 + 8192; j += NWAVES * 64) tb[j] = (j >= 64) ? BT[h * 8192 + (j - 64)] : 0.f; hcur = h; }
                icur = i;
                __syncthreads();
            }
            if ((c * 256 + 32 * wave) < cn) {
                const int e = c * 256 + 32 * wave + (lane & 31); const bool valid = e < cn; const unsigned ent = LIST[(size_t)bh * MBL_PER_BH + mbl_off(n) + (valid ? e : cn - 1)];
                moba_resident_wave(L, P1 + r0 * 3072 + h * 64, n, (int)(ent & 8191u), (int)(ent >> 13), valid, bh * 8192, mb.PARTO, mb.PARTML, lane, wave);
            }
        }
        hcur = -1;
        for (int id = vcu; id < 512; id += G) {
            const int bh = id >> 5, qb = 31 - (id & 31), b = bh >> 3, h = bh & 7, q0u = qb * 256, q0w = q0u + 32 * wave; const size_t r0 = (size_t)b * T_;
            if (h != hcur) {
                __syncthreads();
                LAS float* tb = (LAS float*)(L + ABIAS_OFF);
                for (int j = tid; j < 64 + 512; j += NWAVES * 64) tb[j] = (j >= 64) ? BT[h * 8192 + (j - 64)] : 0.f;
                hcur = h;
                __syncthreads();
            }
            mb.q = 0; mb.slot = 3; mb.valid = true; mb.wvalid = true; mb.bhbase = bh * 8192;
            AttnPtrs a; a.Q = P1 + (r0 + q0w) * 3072 + h * 64; a.qs = 3072; a.K = P1 + r0 * 3072 + 512 + h * 64; a.ks = 3072; a.K2 = nullptr;
            a.V = P1 + r0 * 3072 + 1024 + h * 64; a.vs = 3072; a.O = MIX + (r0 + q0w) * 1024 + h * 64;
            attn_unit<AM_MOBAO>(L, a, q0u, q0w, 4 * qb, 4 * qb + 3, 0.125f * LOG2E, 0.f, mb, 0, nullptr, tid, lane, wave);
        }
        for (int id = vcu; id < 512; id += G) {
            const int bh = id >> 5, qb = 31 - (id & 31), b = bh >> 3, h = bh & 7, q0u = qb * 256, q0w = q0u + 32 * wave; const size_t r0 = (size_t)b * T_;
            AttnPtrs a; a.Q = P1 + (r0 + q0w) * 3072 + 1536 + h * 64; a.qs = 3072; a.K = P1 + r0 * 3072 + 2048 + h * 64; a.ks = 3072; a.K2 = nullptr;
            a.V = P1 + r0 * 3072 + 2560 + h * 64; a.vs = 3072; a.O = MIX + (r0 + q0w) * 1024 + 512 + h * 64;
            attn_unit<AM_SB>(L, a, q0u, q0w, 0, (q0u + 255) >> 6, 0.125f * LOG2E, 0.f, mb, 0, nullptr, tid, lane, wave);
        }
        __syncthreads();
        if (BOTH(14) && rep == REPS[14] - 1) xcd_barrier(bar);
    }
    if (IN(15)) for (int rep = 0; rep < REPS[15]; ++rep) {
        bf16* MIX = (bf16*)(ws + WS_U); const bf16* PARTO = (const bf16*)(ws + WS_PARTO); const f32x4* PML = (const f32x4*)(ws + WS_PARTML);
        const int h = lane >> 3, d8 = (lane & 7) * 8;
        if (rep == 0) for (int m0_ = gw; m0_ < NTOK; m0_ += 2 * NGW) {
            f32x4 ml01[2], ml23[2]; v4u vo[2], v0[2], v1[2], v2[2]; int bq[2];
#pragma unroll
            for (int u = 0; u < 2; ++u) { const int m = m0_ + u * NGW < NTOK ? m0_ + u * NGW : m0_; const int b = m >> 13, q = m & 8191; bq[u] = ((b * 8 + h) * 8192 + q);
                ml01[u] = PML[(size_t)bq[u] * 2]; ml23[u] = PML[(size_t)bq[u] * 2 + 1];
                vo[u] = *(const v4u*)(MIX + (size_t)m * 1024 + h * 64 + d8);
                const v4u* pp = (const v4u*)(PARTO + (size_t)bq[u] * 3 * 64 + d8); v0[u] = pp[0]; v1[u] = pp[8]; v2[u] = pp[16]; }
#pragma unroll
            for (int u = 0; u < 2; ++u) { const int m = m0_ + u * NGW; if (m < NTOK) {
                const int q = m & 8191, nsel = (q >> 8) < 3 ? (q >> 8) : 3;
                const float m0 = nsel > 0 ? ml01[u].x : NEGBIG, m1 = nsel > 1 ? ml01[u].z : NEGBIG, m2 = nsel > 2 ? ml23[u].x : NEGBIG, mo = ml23[u].z;
                const float M = fmaxf(fmaxf(m0, m1), fmaxf(m2, mo));
                const float w0 = __builtin_amdgcn_exp2f(m0 - M), w1 = __builtin_amdgcn_exp2f(m1 - M), w2 = __builtin_amdgcn_exp2f(m2 - M), wo = __builtin_amdgcn_exp2f(mo - M);
                const float invL = 1.0f / (wo * ml23[u].w + (nsel > 0 ? w0 * ml01[u].y : 0.f) + (nsel > 1 ? w1 * ml01[u].w : 0.f) + (nsel > 2 ? w2 * ml23[u].y : 0.f));
                float acc[8]; const float co = wo * invL;
                { const v4u v = vo[u]; acc[0] = bflo(v.x) * co; acc[1] = bfhi(v.x) * co; acc[2] = bflo(v.y) * co; acc[3] = bfhi(v.y) * co; acc[4] = bflo(v.z) * co; acc[5] = bfhi(v.z) * co; acc[6] = bflo(v.w) * co; acc[7] = bfhi(v.w) * co; }
                if (nsel > 0) { const v4u v = v0[u]; const float c = w0 * invL; acc[0] += bflo(v.x) * c; acc[1] += bfhi(v.x) * c; acc[2] += bflo(v.y) * c; acc[3] += bfhi(v.y) * c; acc[4] += bflo(v.z) * c; acc[5] += bfhi(v.z) * c; acc[6] += bflo(v.w) * c; acc[7] += bfhi(v.w) * c; }
                if (nsel > 1) { const v4u v = v1[u]; const float c = w1 * invL; acc[0] += bflo(v.x) * c; acc[1] += bfhi(v.x) * c; acc[2] += bflo(v.y) * c; acc[3] += bfhi(v.y) * c; acc[4] += bflo(v.z) * c; acc[5] += bfhi(v.z) * c; acc[6] += bflo(v.w) * c; acc[7] += bfhi(v.w) * c; }
                if (nsel > 2) { const v4u v = v2[u]; const float c = w2 * invL; acc[0] += bflo(v.x) * c; acc[1] += bfhi(v.x) * c; acc[2] += bflo(v.y) * c; acc[3] += bfhi(v.y) * c; acc[4] += bflo(v.z) * c; acc[5] += bfhi(v.z) * c; acc[6] += bflo(v.w) * c; acc[7] += bfhi(v.w) * c; }
                *(v4u*)(MIX + (size_t)m * 1024 + h * 64 + d8) = (v4u){pk2(acc[0], acc[1]), pk2(acc[2], acc[3]), pk2(acc[4], acc[5]), pk2(acc[6], acc[7])}; } }
        }
        if (BOTH(15) && rep == REPS[15] - 1) xcd_barrier(bar);
    }
    if (IN(16)) {
        pg8::Gemm g{(const pg8::bf16_t*)(ws + WS_U), (const pg8::bf16_t*)(ws + WS_WOO), NTOK, 1024, 1024};
        pg8::StaticOrder S; S.init(NTOK, 1024, G, bx);
        EpiResid E{p.out, p.out};
        pg8::gemm_phase<EpiResid, pg8::StaticOrder, false, true>(L + RING_OFF, g, S, E);
        if (BOTH(16)) xcd_barrier(bar);
    }
    if (IN(17)) { moe_route(p, L, 1, p.out, gw, NGW, lane, wave); if (BOTH(17)) xcd_barrier(bar); }
    if (IN(19)) {
        int nt, nfull; moe_tables<true>(p, L, 1, tid, G, nt, nfull);
        unsigned* hcnt = (unsigned*)(ws + WS_CTL) + CW_HCNT + 1 * 160 * 16;
        const int total1 = nfull * 2, rem = total1 % G, q = ((int)bx + G - rem) % G;
        { pg8::Gemm g{(const pg8::bf16_t*)(ws + WS_U), (const pg8::bf16_t*)(ws + WS_MOEW + 48 * MiB), nt * 256, 32 * 512, 1024};
          MoeOrderG<2> S{total1, G, bx, L + MOE_T2E_OFF, (const LAS int*)(L + MOE_T2E_OFF + 256), (const LAS int*)(L + MOE_T2E_OFF + 512), (const int*)(ws + WS_EL), hcnt, L + MOE_T2E_OFF + 640};
          EpiSwiGLU E{(bf16*)(ws + WS_HH), (const f32x2*)(ws + WS_EW), L + MOE_T2E_OFF, (const LAS int*)(L + MOE_T2E_OFF + 256)};
          pg8::gemm_phase_g<EpiSwiGLU, MoeOrderG<2>, false, true>(L + RING_OFF, g, S, E); }
        __syncthreads();
        moe_tail_units(p, L, (const bf16*)(ws + WS_MOEW + 48 * MiB), hcnt, nfull, nt, q, G, tid, lane, wave);
        { pg8::Gemm g{(const pg8::bf16_t*)(ws + WS_HH), (const pg8::bf16_t*)(ws + WS_MOEW + 80 * MiB), nt * 256, 32 * 1024, 256};
          MoeOrderD<4> S{nt * 4, L + MOE_T2E_OFF, L + MOE_T2E_OFF + 640, hcnt, (unsigned*)(ws + WS_CTL) + CW_TICK + 1 * 64, (LAS unsigned*)(L + MOE_T2E_OFF + 804)};
          EpiStore E{(bf16*)(ws + WS_XG), 1024, 3};
          pg8::gemm_phase<EpiStore, MoeOrderD<4>, false, true>(L + RING_OFF, g, S, E); }
        if (BOTH(19)) xcd_barrier(bar);
    }
    if (IN(21)) { int nt, nfl; moe_tables<false>(p, L, 1, tid, G, nt, nfl); moe_combine<true>(p, L, p.out, p.in[3], gw, NGW, lane); }
#undef IN
#undef BOTH
}
extern "C" void kernel_launch(void* const* d_in, const int* in_sizes, int n_in, void* d_out, int out_size, void* d_ws, size_t ws_size, hipStream_t stream) {
    static int grid = 0;
    if (grid == 0) {
        int dev = 0, cus = 0;
        if (n_in != 21 || in_sizes[0] != NTOK * DM || out_size != NTOK * DM || ws_size < 282 * MiB) { fprintf(stderr, "kernel_launch: unexpected n_in %d / sizes / ws_size %zu; nothing launched\n", n_in, ws_size); grid = -1; return; }
        if (hipGetDevice(&dev) != hipSuccess || hipDeviceGetAttribute(&cus, hipDeviceAttributeMultiprocessorCount, dev) != hipSuccess) { grid = -1; return; }
        if (hipFuncSetAttribute((const void*)mega, hipFuncAttributeMaxDynamicSharedMemorySize, LDS_BYTES) != hipSuccess) { fprintf(stderr, "kernel_launch: hipFuncSetAttribute failed\n"); grid = -1; return; }
        (void)hipGetLastError();
        grid = cus;
    }
    if (grid < 0) return;
    (void)hipMemsetAsync((char*)d_ws + WS_CTL, 0, CTL_ZERO_BYTES, stream);
    Params p{};
    for (int i = 0; i < 21; ++i) p.in[i] = (const float*)d_in[i];
    p.out = (float*)d_out; p.ws = (unsigned char*)d_ws; p.ph_lo = 0; p.ph_hi = 22; p.li = 0;
    hipLaunchKernelGGL(mega, dim3(grid), dim3(NWAVES * 64), LDS_BYTES, stream, p);
}
```

```cpp
#include <hip/hip_runtime.h>
#include <stdint.h>
#include <math.h>
#include <cstdio>

constexpr int NB = 2, T_ = 8192, DM = 1024, NTOK = NB * T_;
constexpr float RMS_EPS = 1e-6f;
#define GAS __attribute__((address_space(1)))
#define LAS __attribute__((address_space(3)))
namespace pg8 {
#define PG8_LAS __attribute__((address_space(3)))
typedef unsigned short bf16_t;
typedef short bf16x8 __attribute__((ext_vector_type(8)));
typedef float f32x4 __attribute__((ext_vector_type(4)));
typedef unsigned u32x4 __attribute__((ext_vector_type(4)));
constexpr int BM = 256, BK = 64, HALF = 128, HTB = HALF * BK * 2  , STAGE_BYTES = 8 * HTB, NXCD = 8, WGM = 8;

__host__ __device__ __forceinline__ int lds_byte(int r, int c) { const int st = (r >> 4) * 2 + (c >> 5), rr = r & 15, cc = c & 31, ob = rr * 64 + cc * 2; return st * 1024 + (ob ^ (((ob >> 9) & 1) << 5)); }
__host__ __device__ __forceinline__ void stage_rc(int b, int& R, int& C) { const int st = b / 1024, sb = b % 1024, swz = sb ^ (((sb >> 9) & 1) << 5); R = (st >> 1) * 16 + swz / 64; C = (st & 1) * 32 + (swz % 64) / 2; }
__host__ __device__ __forceinline__ int perm32(int rho) { const int n = rho >> 4, i = rho & 15; return 8 * (i >> 2) + 4 * n + (i & 3); }

struct Unit { int pm, pn; };
struct Gemm { const bf16_t* A; const bf16_t* Bt; int M, N, K; };

struct StaticOrder {
    int nM, nN, nwg, G, c;
    __host__ __device__ void init(int M, int N, int G_, int c_) { nM = M / BM; nN = N / BM; nwg = nM * nN; G = G_; c = c_; }
    __host__ __device__ bool next(int i, Unit& u) const {
        const long L = (long)i * G + c; if (L >= nwg) return false;
        int wgid = (int)L; { const int q = nwg / NXCD, r = nwg % NXCD, xcd = wgid % NXCD, off = wgid / NXCD; wgid = (xcd < r ? xcd * (q + 1) : r * (q + 1) + (xcd - r) * q) + off; }
        const int nig = WGM * nN, gid = wgid / nig, fm = gid * WGM, gsz = (nM - fm) < WGM ? (nM - fm) : WGM;
        u.pm = fm + ((wgid % nig) % gsz); u.pn = (wgid % nig) / gsz; return true;
    }
    __device__ __forceinline__ void a_ready(const Unit&) const {}
    __device__ __forceinline__ void done(const Unit&) const {}
};

__device__ __forceinline__ unsigned cvt_pk_bf16(float lo, float hi) { unsigned r; asm volatile("v_cvt_pk_bf16_f32 %0, %1, %2" : "=v"(r) : "v"(lo), "v"(hi)); return r; }
template <class Epi, class Sched, bool ALIGN_EPI = false, bool SP2 = false>
__device__ __forceinline__ void gemm_phase(PG8_LAS unsigned char* lds, const Gemm g, const Sched& S, const Epi& E) {
    const int tid = threadIdx.x, wid = __builtin_amdgcn_readfirstlane(tid >> 6), lane = tid & 63, wr = wid >> 2, wc = wid & 3, fr = lane & 15, fq = lane >> 4;
    const int K = g.K, nt = K / BK;
    unsigned voffA[2], voffB[2];
#pragma unroll
    for (int i = 0; i < 2; ++i) { int R, C; stage_rc(tid * 16 + i * 8192, R, C); const int Rb = Epi::PERM ? ((R & ~31) + perm32(R & 31)) : R;
        voffA[i] = (unsigned)(R * K + C) * 2u; voffB[i] = (unsigned)(Rb * K + C) * 2u; }
    const size_t kstep = (size_t)(BK * 2);
    const size_t hstep = (size_t)HALF * K * 2;
    const size_t tstep = 2 * hstep;
    const unsigned ldsw = (unsigned)wid * 1024u;
    const int aoff = lds_byte(wr * 64 + fr, fq * 8), boff = lds_byte(wc * 32 + fr, fq * 8);
#define PG8_SA(b, h) (((b) * 2 + (h)) * HTB)
#define PG8_SB(b, h) ((4 + (b) * 2 + (h)) * HTB)
#define PG8_STAGE(bufoff, gbase, voff) do { _Pragma("unroll") for (int _i = 0; _i < 2; ++_i) \
        __builtin_amdgcn_global_load_lds((const unsigned*)((const char*)(gbase) + (voff)[_i]), (PG8_LAS unsigned*)(lds + (bufoff) + ldsw + _i * 8192), 16, 0, 0); } while (0)
#define PG8_LDA(dst, b, h) do { _Pragma("unroll") for (int m = 0; m < 4; ++m) _Pragma("unroll") for (int k = 0; k < 2; ++k) dst[m][k] = *(const PG8_LAS bf16x8*)(lds + PG8_SA(b, h) + aoff + m * 2048 + k * 1024); } while (0)
#define PG8_LDB(dst, b, h) do { _Pragma("unroll") for (int n = 0; n < 2; ++n) _Pragma("unroll") for (int k = 0; k < 2; ++k) dst[n][k] = *(const PG8_LAS bf16x8*)(lds + PG8_SB(b, h) + boff + n * 2048 + k * 1024); } while (0)
#define PG8_MMA(ai, bj, At, Bt) do { __builtin_amdgcn_s_setprio(1); _Pragma("unroll") for (int m = 0; m < 4; ++m) _Pragma("unroll") for (int n = 0; n < 2; ++n) _Pragma("unroll") for (int k = 0; k < 2; ++k) \
        acc[ai][bj][m][n] = __builtin_amdgcn_mfma_f32_16x16x32_bf16(Bt[n][k], At[m][k], acc[ai][bj][m][n], 0, 0, 0); __builtin_amdgcn_s_setprio(0); } while (0)
#define PG8_WAIT_V(n) asm volatile("s_waitcnt vmcnt(" #n ")" ::: "memory")
#define PG8_WAIT_L(n) asm volatile("s_waitcnt lgkmcnt(" #n ")" ::: "memory")
#define PG8_BAR __builtin_amdgcn_s_barrier()
#define PG8_SCHED __builtin_amdgcn_sched_barrier(0)
    Unit cur, nxt; int ui = 0;
    if (!S.next(0, cur)) return;
    f32x4 acc[2][2][4][2];
#pragma unroll
    for (int a = 0; a < 2; ++a)
#pragma unroll
        for (int b = 0; b < 2; ++b)
#pragma unroll
            for (int m = 0; m < 4; ++m)
#pragma unroll
                for (int n = 0; n < 2; ++n) acc[a][b][m][n] = (f32x4){0.f, 0.f, 0.f, 0.f};
    bf16x8 At[4][2], B0[2][2], B1[2][2];
    const char* cA = (const char*)g.A + (size_t)cur.pm * tstep; const char* cB = (const char*)g.Bt + (size_t)cur.pn * tstep;
    S.a_ready(cur);
    if constexpr (SP2) {
        PG8_STAGE(PG8_SB(0, 0), cB, voffB); PG8_STAGE(PG8_SB(0, 1), cB + hstep, voffB); PG8_STAGE(PG8_SA(0, 0), cA, voffA); PG8_STAGE(PG8_SA(0, 1), cA + hstep, voffA);
        if (wr == 1) PG8_BAR;
        PG8_WAIT_V(2); PG8_BAR;
        PG8_STAGE(PG8_SB(1, 0), cB + kstep, voffB); PG8_STAGE(PG8_SA(1, 0), cA + kstep, voffA); PG8_STAGE(PG8_SB(1, 1), cB + hstep + kstep, voffB);
        PG8_WAIT_V(6); PG8_BAR;
    } else {
        PG8_STAGE(PG8_SB(0, 0), cB, voffB); PG8_STAGE(PG8_SA(0, 0), cA, voffA); PG8_STAGE(PG8_SB(0, 1), cB + hstep, voffB); PG8_STAGE(PG8_SA(0, 1), cA + hstep, voffA);
        if (wr == 1) PG8_BAR;
        PG8_WAIT_V(4); PG8_BAR;
        PG8_STAGE(PG8_SB(1, 0), cB + kstep, voffB); PG8_STAGE(PG8_SA(1, 0), cA + kstep, voffA); PG8_STAGE(PG8_SB(1, 1), cB + hstep + kstep, voffB);
        PG8_WAIT_V(6); PG8_BAR;
    }
    for (;;) {
        const bool has_next = S.next(ui + 1, nxt);
        const char* nA = has_next ? (const char*)g.A + (size_t)nxt.pm * tstep : cA; const char* nB = has_next ? (const char*)g.Bt + (size_t)nxt.pn * tstep : cB;
        for (int t = 0; t < nt; t += 2) {
            const bool last = (t == nt - 2);
            const char* a1 = cA + (size_t)(t + 1) * kstep;
            const char* a2 = last ? nA : cA + (size_t)(t + 2) * kstep; const char* b2 = last ? nB : cB + (size_t)(t + 2) * kstep;
            const char* a3 = a2 + kstep; const char* b3 = b2 + kstep;
            if (last && has_next) S.a_ready(nxt);
            if constexpr (SP2) {
            PG8_LDB(B0, 0, 0); PG8_LDB(B1, 0, 1); PG8_SCHED; PG8_LDA(At, 0, 0); PG8_STAGE(PG8_SA(1, 1), a1 + hstep, voffA);
            PG8_WAIT_V(8); PG8_WAIT_L(0); PG8_BAR; PG8_MMA(0, 0, At, B0); PG8_MMA(0, 1, At, B1); PG8_BAR; PG8_SCHED;
            PG8_LDA(At, 0, 1); PG8_STAGE(PG8_SB(0, 0), b2, voffB); PG8_STAGE(PG8_SB(0, 1), b2 + hstep, voffB); PG8_STAGE(PG8_SA(0, 0), a2, voffA);
            PG8_WAIT_V(8); PG8_WAIT_L(0); PG8_BAR; PG8_MMA(1, 0, At, B0); PG8_MMA(1, 1, At, B1); PG8_BAR; PG8_SCHED;
            PG8_LDB(B0, 1, 0); PG8_LDB(B1, 1, 1); PG8_SCHED; PG8_LDA(At, 1, 0); PG8_STAGE(PG8_SA(0, 1), a2 + hstep, voffA);
            PG8_WAIT_V(8); PG8_WAIT_L(0); PG8_BAR; PG8_MMA(0, 0, At, B0); PG8_MMA(0, 1, At, B1); PG8_BAR; PG8_SCHED;
            PG8_LDA(At, 1, 1); PG8_STAGE(PG8_SB(1, 0), b3, voffB); PG8_STAGE(PG8_SB(1, 1), b3 + hstep, voffB); PG8_STAGE(PG8_SA(1, 0), a3, voffA);
            PG8_WAIT_V(8); PG8_WAIT_L(0); PG8_BAR; PG8_MMA(1, 0, At, B0); PG8_MMA(1, 1, At, B1); PG8_BAR; PG8_SCHED;
            } else {
            PG8_LDB(B0, 0, 0); PG8_SCHED; PG8_LDA(At, 0, 0); PG8_STAGE(PG8_SA(1, 1), a1 + hstep, voffA);
            PG8_WAIT_L(8); PG8_BAR; PG8_WAIT_L(0); PG8_MMA(0, 0, At, B0); PG8_BAR; PG8_SCHED;
            PG8_LDB(B1, 0, 1); PG8_STAGE(PG8_SB(0, 0), b2, voffB);
            PG8_BAR; PG8_WAIT_L(0); PG8_MMA(0, 1, At, B1); PG8_BAR;
            PG8_LDA(At, 0, 1); PG8_STAGE(PG8_SA(0, 0), a2, voffA);
            PG8_BAR; PG8_WAIT_L(0); PG8_MMA(1, 0, At, B0); PG8_BAR; PG8_SCHED;
            PG8_STAGE(PG8_SB(0, 1), b2 + hstep, voffB);
            PG8_WAIT_V(6); PG8_BAR; PG8_MMA(1, 1, At, B1); PG8_BAR;
            PG8_LDB(B0, 1, 0); PG8_SCHED; PG8_LDA(At, 1, 0); PG8_STAGE(PG8_SA(0, 1), a2 + hstep, voffA);
            PG8_WAIT_L(8); PG8_BAR; PG8_WAIT_L(0); PG8_MMA(0, 0, At, B0); PG8_BAR; PG8_SCHED;
            PG8_LDB(B1, 1, 1); PG8_STAGE(PG8_SB(1, 0), b3, voffB);
            PG8_BAR; PG8_WAIT_L(0); PG8_MMA(0, 1, At, B1); PG8_BAR;
            PG8_LDA(At, 1, 1); PG8_STAGE(PG8_SA(1, 0), a3, voffA);
            PG8_BAR; PG8_WAIT_L(0); PG8_MMA(1, 0, At, B0); PG8_BAR; PG8_SCHED;
            PG8_STAGE(PG8_SB(1, 1), b3 + hstep, voffB);
            PG8_WAIT_V(6); PG8_BAR; PG8_MMA(1, 1, At, B1); PG8_BAR;
            }
        }
        if constexpr (ALIGN_EPI) { if (wr == 0) PG8_BAR; }
        if constexpr (!Epi::AFTER_DRAIN) { E(acc, cur, wr, wc, fr, fq); S.done(cur); }
        if (!has_next) break;
#pragma unroll
        for (int a = 0; a < 2; ++a)
#pragma unroll
            for (int b = 0; b < 2; ++b)
#pragma unroll
                for (int m = 0; m < 4; ++m)
#pragma unroll
                    for (int n = 0; n < 2; ++n) acc[a][b][m][n] = (f32x4){0.f, 0.f, 0.f, 0.f};
        cur = nxt; cA = nA; cB = nB; ++ui;
        if constexpr (ALIGN_EPI) { if (wr == 1) PG8_BAR; }
    }
    PG8_WAIT_V(0);
    if constexpr (!ALIGN_EPI) { if (wr == 0) PG8_BAR; }
    PG8_BAR;
    if constexpr (Epi::AFTER_DRAIN) { E.fused(acc, cur, wr, wc, fr, fq, lds, wid, lane); S.done(cur); }
#undef PG8_SA
#undef PG8_SB
#undef PG8_STAGE
#undef PG8_LDA
#undef PG8_LDB
#undef PG8_MMA
#undef PG8_WAIT_V
#undef PG8_WAIT_L
#undef PG8_BAR
#undef PG8_SCHED
}

template <class Epi, class Sched, bool ALIGN_EPI = false, bool SP2 = false>
__device__ __forceinline__ void gemm_phase_g(PG8_LAS unsigned char* lds, const Gemm g, const Sched& S, const Epi& E) {
    const int tid = threadIdx.x, wid = __builtin_amdgcn_readfirstlane(tid >> 6), lane = tid & 63, wr = wid >> 2, wc = wid & 3, fr = lane & 15, fq = lane >> 4;
    const int K = g.K, nt = K / BK;
    unsigned voffA[2], voffB[2]; int RA[2], CA[2]; (void)voffA;
#pragma unroll
    for (int i = 0; i < 2; ++i) { int R, C; stage_rc(tid * 16 + i * 8192, R, C); const int Rb = Epi::PERM ? ((R & ~31) + perm32(R & 31)) : R;
        voffA[i] = (unsigned)(R * K + C) * 2u; voffB[i] = (unsigned)(Rb * K + C) * 2u; RA[i] = R; CA[i] = C; }
    const size_t kstep = (size_t)(BK * 2);
    const size_t hstep = (size_t)HALF * K * 2;
    const size_t tstep = 2 * hstep;
    const unsigned ldsw = (unsigned)wid * 1024u;
    const int aoff = lds_byte(wr * 64 + fr, fq * 8), boff = lds_byte(wc * 32 + fr, fq * 8);
#define PG8_SA(b, h) (((b) * 2 + (h)) * HTB)
#define PG8_SB(b, h) ((4 + (b) * 2 + (h)) * HTB)
#define PG8_STAGE(bufoff, gbase, voff) do { _Pragma("unroll") for (int _i = 0; _i < 2; ++_i) \
        __builtin_amdgcn_global_load_lds((const unsigned*)((const char*)(gbase) + (voff)[_i]), (PG8_LAS unsigned*)(lds + (bufoff) + ldsw + _i * 8192), 16, 0, 0); } while (0)
#define PG8_LDA(dst, b, h) do { _Pragma("unroll") for (int m = 0; m < 4; ++m) _Pragma("unroll") for (int k = 0; k < 2; ++k) dst[m][k] = *(const PG8_LAS bf16x8*)(lds + PG8_SA(b, h) + aoff + m * 2048 + k * 1024); } while (0)
#define PG8_LDB(dst, b, h) do { _Pragma("unroll") for (int n = 0; n < 2; ++n) _Pragma("unroll") for (int k = 0; k < 2; ++k) dst[n][k] = *(const PG8_LAS bf16x8*)(lds + PG8_SB(b, h) + boff + n * 2048 + k * 1024); } while (0)
#define PG8_MMA(ai, bj, At, Bt) do { __builtin_amdgcn_s_setprio(1); _Pragma("unroll") for (int m = 0; m < 4; ++m) _Pragma("unroll") for (int n = 0; n < 2; ++n) _Pragma("unroll") for (int k = 0; k < 2; ++k) \
        acc[ai][bj][m][n] = __builtin_amdgcn_mfma_f32_16x16x32_bf16(Bt[n][k], At[m][k], acc[ai][bj][m][n], 0, 0, 0); __builtin_amdgcn_s_setprio(0); } while (0)
#define PG8_WAIT_V(n) asm volatile("s_waitcnt vmcnt(" #n ")" ::: "memory")
#define PG8_WAIT_L(n) asm volatile("s_waitcnt lgkmcnt(" #n ")" ::: "memory")
#define PG8_BAR __builtin_amdgcn_s_barrier()
#define PG8_SCHED __builtin_amdgcn_sched_barrier(0)
    Unit cur, nxt; int ui = 0;
    if (!S.next(0, cur)) return;
    f32x4 acc[2][2][4][2];
#pragma unroll
    for (int a = 0; a < 2; ++a)
#pragma unroll
        for (int b = 0; b < 2; ++b)
#pragma unroll
            for (int m = 0; m < 4; ++m)
#pragma unroll
                for (int n = 0; n < 2; ++n) acc[a][b][m][n] = (f32x4){0.f, 0.f, 0.f, 0.f};
    bf16x8 At[4][2], B0[2][2], B1[2][2];
    const char* cA = (const char*)g.A; const char* cB = (const char*)g.Bt + (size_t)cur.pn * tstep;
    unsigned gC[2][2], gN[2][2];
#pragma unroll
    for (int h = 0; h < 2; ++h)
#pragma unroll
        for (int i = 0; i < 2; ++i) gC[h][i] = S.goff(cur, h, RA[i], CA[i]);
    S.a_ready(cur);
    if constexpr (SP2) {
        PG8_STAGE(PG8_SB(0, 0), cB, voffB); PG8_STAGE(PG8_SB(0, 1), cB + hstep, voffB); PG8_STAGE(PG8_SA(0, 0), cA, gC[0]); PG8_STAGE(PG8_SA(0, 1), cA, gC[1]);
        if (wr == 1) PG8_BAR;
        PG8_WAIT_V(2); PG8_BAR;
        PG8_STAGE(PG8_SB(1, 0), cB + kstep, voffB); PG8_STAGE(PG8_SA(1, 0), cA + kstep, gC[0]); PG8_STAGE(PG8_SB(1, 1), cB + hstep + kstep, voffB);
        PG8_WAIT_V(6); PG8_BAR;
    } else {
        PG8_STAGE(PG8_SB(0, 0), cB, voffB); PG8_STAGE(PG8_SA(0, 0), cA, gC[0]); PG8_STAGE(PG8_SB(0, 1), cB + hstep, voffB); PG8_STAGE(PG8_SA(0, 1), cA, gC[1]);
        if (wr == 1) PG8_BAR;
        PG8_WAIT_V(4); PG8_BAR;
        PG8_STAGE(PG8_SB(1, 0), cB + kstep, voffB); PG8_STAGE(PG8_SA(1, 0), cA + kstep, gC[0]); PG8_STAGE(PG8_SB(1, 1), cB + hstep + kstep, voffB);
        PG8_WAIT_V(6); PG8_BAR;
    }
    for (;;) {
        const bool has_next = S.next(ui + 1, nxt);
        const char* nA = cA; const char* nB = has_next ? (const char*)g.Bt + (size_t)nxt.pn * tstep : cB;
#pragma unroll
        for (int h = 0; h < 2; ++h)
#pragma unroll
            for (int i = 0; i < 2; ++i) gN[h][i] = has_next ? S.goff(nxt, h, RA[i], CA[i]) : gC[h][i];
        for (int t = 0; t < nt; t += 2) {
            const bool last = (t == nt - 2);
            const char* a1 = cA + (size_t)(t + 1) * kstep;
            const char* a2 = last ? nA : cA + (size_t)(t + 2) * kstep; const char* b2 = last ? nB : cB + (size_t)(t + 2) * kstep;
            const char* a3 = a2 + kstep; const char* b3 = b2 + kstep;
            unsigned g0[2], g1[2]; g0[0] = last ? gN[0][0] : gC[0][0]; g0[1] = last ? gN[0][1] : gC[0][1]; g1[0] = last ? gN[1][0] : gC[1][0]; g1[1] = last ? gN[1][1] : gC[1][1];
            if (last && has_next) S.a_ready(nxt);
            if constexpr (SP2) {
            PG8_LDB(B0, 0, 0); PG8_LDB(B1, 0, 1); PG8_SCHED; PG8_LDA(At, 0, 0); PG8_STAGE(PG8_SA(1, 1), a1, gC[1]);
            PG8_WAIT_V(8); PG8_WAIT_L(0); PG8_BAR; PG8_MMA(0, 0, At, B0); PG8_MMA(0, 1, At, B1); PG8_BAR; PG8_SCHED;
            PG8_LDA(At, 0, 1); PG8_STAGE(PG8_SB(0, 0), b2, voffB); PG8_STAGE(PG8_SB(0, 1), b2 + hstep, voffB); PG8_STAGE(PG8_SA(0, 0), a2, g0);
            PG8_WAIT_V(8); PG8_WAIT_L(0); PG8_BAR; PG8_MMA(1, 0, At, B0); PG8_MMA(1, 1, At, B1); PG8_BAR; PG8_SCHED;
            PG8_LDB(B0, 1, 0); PG8_LDB(B1, 1, 1); PG8_SCHED; PG8_LDA(At, 1, 0); PG8_STAGE(PG8_SA(0, 1), a2, g1);
            PG8_WAIT_V(8); PG8_WAIT_L(0); PG8_BAR; PG8_MMA(0, 0, At, B0); PG8_MMA(0, 1, At, B1); PG8_BAR; PG8_SCHED;
            PG8_LDA(At, 1, 1); PG8_STAGE(PG8_SB(1, 0), b3, voffB); PG8_STAGE(PG8_SB(1, 1), b3 + hstep, voffB); PG8_STAGE(PG8_SA(1, 0), a3, g0);
            PG8_WAIT_V(8); PG8_WAIT_L(0); PG8_BAR; PG8_MMA(1, 0, At, B0); PG8_MMA(1, 1, At, B1); PG8_BAR; PG8_SCHED;
            } else {
            PG8_LDB(B0, 0, 0); PG8_SCHED; PG8_LDA(At, 0, 0); PG8_STAGE(PG8_SA(1, 1), a1, gC[1]);
            PG8_WAIT_L(8); PG8_BAR; PG8_WAIT_L(0); PG8_MMA(0, 0, At, B0); PG8_BAR; PG8_SCHED;
            PG8_LDB(B1, 0, 1); PG8_STAGE(PG8_SB(0, 0), b2, voffB);
            PG8_BAR; PG8_WAIT_L(0); PG8_MMA(0, 1, At, B1); PG8_BAR;
            PG8_LDA(At, 0, 1); PG8_STAGE(PG8_SA(0, 0), a2, g0);
            PG8_BAR; PG8_WAIT_L(0); PG8_MMA(1, 0, At, B0); PG8_BAR; PG8_SCHED;
            PG8_STAGE(PG8_SB(0, 1), b2 + hstep, voffB);
            PG8_WAIT_V(6); PG8_BAR; PG8_MMA(1, 1, At, B1); PG8_BAR;
            PG8_LDB(B0, 1, 0); PG8_SCHED; PG8_LDA(At, 1, 0); PG8_STAGE(PG8_SA(0, 1), a2, g1);
            PG8_WAIT_L(8); PG8_BAR; PG8_WAIT_L(0); PG8_MMA(0, 0, At, B0); PG8_BAR; PG8_SCHED;
            PG8_LDB(B1, 1, 1); PG8_STAGE(PG8_SB(1, 0), b3, voffB);
            PG8_BAR; PG8_WAIT_L(0); PG8_MMA(0, 1, At, B1); PG8_BAR;
            PG8_LDA(At, 1, 1); PG8_STAGE(PG8_SA(1, 0), a3, g0);
            PG8_BAR; PG8_WAIT_L(0); PG8_MMA(1, 0, At, B0); PG8_BAR; PG8_SCHED;
            PG8_STAGE(PG8_SB(1, 1), b3 + hstep, voffB);
            PG8_WAIT_V(6); PG8_BAR; PG8_MMA(1, 1, At, B1); PG8_BAR;
            }
        }
        if constexpr (ALIGN_EPI) { if (wr == 0) PG8_BAR; }
        if constexpr (!Epi::AFTER_DRAIN) { E(acc, cur, wr, wc, fr, fq); S.done(cur); }
        if (!has_next) break;
#pragma unroll
        for (int a = 0; a < 2; ++a)
#pragma unroll
            for (int b = 0; b < 2; ++b)
#pragma unroll
                for (int m = 0; m < 4; ++m)
#pragma unroll
                    for (int n = 0; n < 2; ++n) acc[a][b][m][n] = (f32x4){0.f, 0.f, 0.f, 0.f};
        cur = nxt; cA = nA; cB = nB; ++ui;
#pragma unroll
        for (int h = 0; h < 2; ++h)
#pragma unroll
            for (int i = 0; i < 2; ++i) gC[h][i] = gN[h][i];
        if constexpr (ALIGN_EPI) { if (wr == 1) PG8_BAR; }
    }
    PG8_WAIT_V(0);
    if constexpr (!ALIGN_EPI) { if (wr == 0) PG8_BAR; }
    PG8_BAR;
    if constexpr (Epi::AFTER_DRAIN) { E.fused(acc, cur, wr, wc, fr, fq, lds, wid, lane); S.done(cur); }
#undef PG8_SA
#undef PG8_SB
#undef PG8_STAGE
#undef PG8_LDA
#undef PG8_LDB
#undef PG8_MMA
#undef PG8_WAIT_V
#undef PG8_WAIT_L
#undef PG8_BAR
#undef PG8_SCHED
}
}
#define XB_TMO      128
#define XB_XCNT(j)  (256  + 64 * (j))
#define XB_XSUB(j)  (1280 + 64 * (j))
#define XB_XGEN(j)  (2304 + 64 * (j))
#define XB_TOP      3328
#define XB_TOPGEN   3392
#define XCD_BAR_WORDS 3456
#define XB_SPIN_CAP (1u << 18)

__device__ __forceinline__ unsigned xb_ld(unsigned* p)              { return __hip_atomic_load(p, __ATOMIC_RELAXED, __HIP_MEMORY_SCOPE_AGENT); }
__device__ __forceinline__ unsigned xb_add(unsigned* p, unsigned v) { return __hip_atomic_fetch_add(p, v, __ATOMIC_RELAXED, __HIP_MEMORY_SCOPE_AGENT); }
__device__ __forceinline__ unsigned xb_xcc_id() { return (unsigned)__builtin_amdgcn_s_getreg((3 << 11) | 20) & 0xFu; }
#define XB_SPIN(cond, bar) do { unsigned _sp = 0; while (cond) { __builtin_amdgcn_s_sleep(1); \
    if ((++_sp & 255u) == 0u) { if (xb_ld(&(bar)[XB_TMO])) break; if (_sp > XB_SPIN_CAP) { atomicAdd(&(bar)[XB_TMO], 1u); break; } } } } while (0)

struct XcdBarrier {
    unsigned* bar; unsigned x;
    volatile LAS unsigned* st;
};

__device__ __forceinline__ XcdBarrier xcd_barrier_post(unsigned* bar, volatile LAS unsigned* st) {
    XcdBarrier b; b.bar = bar; b.x = xb_xcc_id(); b.st = st;
    if (threadIdx.x == 0) (void)xb_add(&bar[XB_XCNT(b.x)], 1u);
    return b;
}
__device__ __forceinline__ void xcd_barrier_complete(unsigned* bar, unsigned x, unsigned& nloc, unsigned& nx) {
    const unsigned G = gridDim.x * gridDim.y * gridDim.z;
    unsigned sum, cnt, mine, sp = 0u;
    for (;;) {
        sum = 0u; cnt = 0u; mine = 0u;
#pragma unroll
        for (unsigned j = 0; j < 16; ++j) { const unsigned c = xb_ld(&bar[XB_XCNT(j)]); sum += c; cnt += (c > 0u) ? 1u : 0u; mine = (j == x) ? c : mine; }
        if (sum == G) break;
        __builtin_amdgcn_s_sleep(1);
        if ((++sp & 255u) == 0u) { if (xb_ld(&bar[XB_TMO])) break; if (sp > XB_SPIN_CAP) { atomicAdd(&bar[XB_TMO], 1u); break; } }
    }
    nloc = mine > 0u ? mine : 1u; nx = cnt > 0u ? cnt : 1u;
}

__device__ __forceinline__ void xcd_barrier(const XcdBarrier& b) {
    asm volatile("s_waitcnt vmcnt(0)" ::: "memory");
    __syncthreads();
    if (threadIdx.x == 0) {
        unsigned* bar = b.bar;
        __builtin_amdgcn_s_waitcnt(0);
        unsigned nloc = b.st[0], nx = b.st[1];
        if (nloc == 0u) { xcd_barrier_complete(bar, b.x, nloc, nx); b.st[0] = nloc; b.st[1] = nx; }
        const unsigned old = xb_add(&bar[XB_XSUB(b.x)], 1u);
        const unsigned gen = old / nloc;
        if (old + 1u == (gen + 1u) * nloc) {
            __builtin_amdgcn_fence(__ATOMIC_RELEASE, "agent");
            asm volatile("s_waitcnt vmcnt(0)" ::: "memory");
            const unsigned og = xb_add(&bar[XB_TOP], 1u);
            const unsigned tg = og / nx;
            if (og + 1u == (tg + 1u) * nx) xb_add(&bar[XB_TOPGEN], 1u);
            else XB_SPIN(xb_ld(&bar[XB_TOPGEN]) == tg, bar);
            __builtin_amdgcn_fence(__ATOMIC_ACQUIRE, "agent");
            xb_add(&bar[XB_XGEN(b.x)], 1u);
            asm volatile("s_waitcnt vmcnt(0)" ::: "memory");
        } else {
            XB_SPIN(xb_ld(&bar[XB_XGEN(b.x)]) == gen, bar);
            __builtin_amdgcn_fence(__ATOMIC_ACQUIRE, "agent");
            asm volatile("s_waitcnt vmcnt(0)" ::: "memory");
        }
    }
    __syncthreads();
}

typedef unsigned short bf16;
typedef unsigned v4u __attribute__((ext_vector_type(4)));
typedef unsigned v2u __attribute__((ext_vector_type(2)));
typedef float f32x4 __attribute__((ext_vector_type(4)));
typedef float f32x2 __attribute__((ext_vector_type(2)));
typedef float f32x16 __attribute__((ext_vector_type(16)));
typedef short bf16x8 __attribute__((ext_vector_type(8)));
typedef short s16x4 __attribute__((ext_vector_type(4)));
#define LDS_WAIT() asm volatile("s_waitcnt lgkmcnt(0)" ::: "memory")
#define VM_WAIT() asm volatile("s_waitcnt vmcnt(0)" ::: "memory")
__device__ __forceinline__ unsigned f2bf(float f) { unsigned u = __builtin_bit_cast(unsigned, f); return (u + 0x7fffu + ((u >> 16) & 1u)) >> 16; }
__device__ __forceinline__ unsigned pk2(float lo, float hi) { return f2bf(lo) | (f2bf(hi) << 16); }
__device__ __forceinline__ float bf2f(unsigned short b) { return __builtin_bit_cast(float, (unsigned)b << 16); }
__device__ __forceinline__ float bflo(unsigned w) { return __builtin_bit_cast(float, w << 16); }
__device__ __forceinline__ float bfhi(unsigned w) { return __builtin_bit_cast(float, w & 0xffff0000u); }

constexpr int NWAVES = 8;
constexpr float LOG2E = 1.4426950408889634f;
constexpr size_t MiB = 1u << 20;
constexpr size_t WS_CTL = 0, CTL_ZERO_BYTES = 1 * MiB;
constexpr size_t WS_BIAS = 1 * MiB;
constexpr size_t WS_KMEAN = 1 * MiB + 256 * 1024;
constexpr size_t WS_ROPE = 1 * MiB + 512 * 1024;
constexpr size_t WS_TOKINFO = 2 * MiB + 512 * 1024;
constexpr size_t WS_ROWW = 2 * MiB + 768 * 1024;
constexpr size_t WS_WRT = 3 * MiB;
constexpr size_t WS_WINE = 4 * MiB;
constexpr size_t WS_WQB = 6 * MiB + 512 * 1024;
constexpr size_t WS_WKVB = 7 * MiB;
constexpr size_t WS_WOE = 8 * MiB;
constexpr size_t WS_WINO = 10 * MiB;
constexpr size_t WS_WOO = 16 * MiB;
constexpr size_t WS_MOEW = 18 * MiB;
constexpr size_t WS_U = 114 * MiB;
constexpr size_t WS_PROJ0 = 146 * MiB;
constexpr size_t WS_CQN = 186 * MiB;
constexpr size_t WS_CKVN = 194 * MiB;
constexpr size_t WS_KR = 198 * MiB;
constexpr size_t WS_Q = 200 * MiB;
constexpr size_t WS_KVB = 224 * MiB;
constexpr size_t WS_XG = 146 * MiB;
constexpr size_t WS_HH = 226 * MiB;
constexpr size_t WS_PROJ1 = 146 * MiB;
constexpr size_t WS_MBLIST = 256 * MiB;
constexpr size_t WS_PARTO = 18 * MiB;
constexpr size_t WS_PARTML = 242 * MiB;
constexpr size_t WS_EL = 246 * MiB;
constexpr size_t WS_EW = 250 * MiB;
constexpr size_t WS_END = 272 * MiB;
constexpr int CW_BAR = 4096;
constexpr int CW_ECNT = 65536;
constexpr int CW_MBCNT = 131072;
constexpr int CW_HCNT = 147456;
constexpr int CW_TICK = 200000;
constexpr int CW_TMO = 16;
constexpr int RING_OFF = 0, RING_BYTES = 131072;
constexpr int MISC_OFF = RING_BYTES + 320;
constexpr int LDS_BYTES = 147456;

struct Params { const float* in[21]; float* out; unsigned char* ws; int ph_lo, ph_hi, li, pad; };

__device__ __forceinline__ void transpose_item(const float* W, int ldw, int k0, int n0, bf16* WTrow0, int ldk, LAS float* scr, int lane) {
#pragma unroll 8
    for (int i = 0; i < 32; ++i) { const int kk = 2 * i + (lane >> 5); scr[kk * 33 + (lane & 31)] = W[(size_t)(k0 + kk) * ldw + n0 + (lane & 31)]; }
    LDS_WAIT(); asm volatile("" ::: "memory");
    const int c = lane & 7;
#pragma unroll
    for (int j = 0; j < 4; ++j) { const int n = (lane >> 3) + 8 * j; const LAS float* s = scr + (8 * c) * 33 + n;
        v4u o; o.x = pk2(s[0 * 33], s[1 * 33]); o.y = pk2(s[2 * 33], s[3 * 33]); o.z = pk2(s[4 * 33], s[5 * 33]); o.w = pk2(s[6 * 33], s[7 * 33]);
        *(v4u*)(WTrow0 + (size_t)n * ldk + k0 + 8 * c) = o; }
    LDS_WAIT(); asm volatile("" ::: "memory");
}
__device__ __forceinline__ float wsum(float v) {
#pragma unroll
    for (int o = 1; o < 64; o <<= 1) v += __shfl_xor(v, o);
    return v;
}
__device__ __forceinline__ void rms_row_to_bf16(const float* xrow, const float* gain, bf16* orow, int lane) {
    const f32x4* xr = (const f32x4*)xrow + lane; const f32x4* gr = (const f32x4*)gain + lane;
    f32x4 v[4]; float s = 0.f;
#pragma unroll
    for (int j = 0; j < 4; ++j) { v[j] = xr[64 * j]; s += (v[j].x * v[j].x + v[j].y * v[j].y) + (v[j].z * v[j].z + v[j].w * v[j].w); }
    const float r = 1.0f / sqrtf(wsum(s) * (1.f / 1024.f) + RMS_EPS);
    unsigned long long* o8 = (unsigned long long*)orow + lane;
#pragma unroll
    for (int j = 0; j < 4; ++j) { const f32x4 g = gr[64 * j];
        o8[64 * j] = (unsigned long long)pk2(v[j].x * r * g.x, v[j].y * r * g.y) | ((unsigned long long)pk2(v[j].z * r * g.z, v[j].w * r * g.w) << 32); }
}

__device__ __forceinline__ void rms_rows2_to_bf16(const float* x0, const float* x1, const float* gain, bf16* o0, bf16* o1, int lane) {
    const f32x4* xa = (const f32x4*)x0 + lane; const f32x4* xb = (const f32x4*)x1 + lane; const f32x4* gr = (const f32x4*)gain + lane;
    f32x4 va[4], vb[4]; float sa = 0.f, sb = 0.f;
#pragma unroll
    for (int j = 0; j < 4; ++j) { va[j] = xa[64 * j]; vb[j] = xb[64 * j]; }
#pragma unroll
    for (int j = 0; j < 4; ++j) { sa += (va[j].x * va[j].x + va[j].y * va[j].y) + (va[j].z * va[j].z + va[j].w * va[j].w); sb += (vb[j].x * vb[j].x + vb[j].y * vb[j].y) + (vb[j].z * vb[j].z + vb[j].w * vb[j].w); }
#pragma unroll
    for (int o = 1; o < 64; o <<= 1) { sa += __shfl_xor(sa, o); sb += __shfl_xor(sb, o); }
    const float ra = 1.0f / sqrtf(sa * (1.f / 1024.f) + RMS_EPS), rb = 1.0f / sqrtf(sb * (1.f / 1024.f) + RMS_EPS);
    unsigned long long* pa = (unsigned long long*)o0 + lane; unsigned long long* pb = (unsigned long long*)o1 + lane;
#pragma unroll
    for (int j = 0; j < 4; ++j) { const f32x4 g = gr[64 * j];
        pa[64 * j] = (unsigned long long)pk2(va[j].x * ra * g.x, va[j].y * ra * g.y) | ((unsigned long long)pk2(va[j].z * ra * g.z, va[j].w * ra * g.w) << 32);
        pb[64 * j] = (unsigned long long)pk2(vb[j].x * rb * g.x, vb[j].y * rb * g.y) | ((unsigned long long)pk2(vb[j].z * rb * g.z, vb[j].w * rb * g.w) << 32); }
}
struct EpiStore {
    static constexpr bool PERM = true, AFTER_DRAIN = false;
    bf16* O; int ldc; int pnmask;
    __device__ __forceinline__ void operator()(const pg8::f32x4 (&acc)[2][2][4][2], const pg8::Unit& u, int wr, int wc, int fr, int fq) const {
        const int row0 = u.pm * 256 + wr * 64 + fr, col0 = (u.pn & pnmask) * 256 + wc * 32 + 8 * fq;
#pragma unroll
        for (int ai = 0; ai < 2; ++ai)
#pragma unroll
            for (int m = 0; m < 4; ++m) { bf16* rowp = O + (size_t)(row0 + ai * 128 + m * 16) * ldc + col0;
#pragma unroll
                for (int bj = 0; bj < 2; ++bj) { const pg8::f32x4 v0 = acc[ai][bj][m][0], v1 = acc[ai][bj][m][1];
                    v4u w; w.x = pg8::cvt_pk_bf16(v0[0], v0[1]); w.y = pg8::cvt_pk_bf16(v0[2], v0[3]); w.z = pg8::cvt_pk_bf16(v1[0], v1[1]); w.w = pg8::cvt_pk_bf16(v1[2], v1[3]);
                    *(v4u*)(rowp + bj * 128) = w; } }
    }
};

struct EpiQRope {
    static constexpr bool PERM = false, AFTER_DRAIN = false;
    bf16* O; const f32x2* rope;
    __device__ __forceinline__ void operator()(const pg8::f32x4 (&acc)[2][2][4][2], const pg8::Unit& u, int wr, int wc, int fr, int fq) const {
        const int row0 = u.pm * 256 + wr * 64 + fr;
#pragma unroll
        for (int ai = 0; ai < 2; ++ai)
#pragma unroll
            for (int m = 0; m < 4; ++m) { const int row = row0 + ai * 128 + m * 16, t = row & 8191; asm volatile("" ::: "memory");
#pragma unroll
                for (int bj = 0; bj < 2; ++bj) { const int colg = u.pn * 256 + bj * 128 + wc * 32;
                    pg8::f32x4 v0 = acc[ai][bj][m][0], v1 = acc[ai][bj][m][1];
                    if (((colg >> 5) % 3) == 2) {
                        const f32x4* rp = (const f32x4*)(rope + (size_t)t * 16 + 4 * fq); const f32x4 a = rp[0], b = rp[1];
                        const pg8::f32x4 x1 = v0, x2 = v1;
                        v0[0] = x1[0] * a.x - x2[0] * a.y; v1[0] = x2[0] * a.x + x1[0] * a.y;
                        v0[1] = x1[1] * a.z - x2[1] * a.w; v1[1] = x2[1] * a.z + x1[1] * a.w;
                        v0[2] = x1[2] * b.x - x2[2] * b.y; v1[2] = x2[2] * b.x + x1[2] * b.y;
                        v0[3] = x1[3] * b.z - x2[3] * b.w; v1[3] = x2[3] * b.z + x1[3] * b.w;
                    }
                    bf16* op = O + (size_t)row * 768 + colg + 4 * fq;
                    v2u w0, w1; w0.x = pg8::cvt_pk_bf16(v0[0], v0[1]); w0.y = pg8::cvt_pk_bf16(v0[2], v0[3]); w1.x = pg8::cvt_pk_bf16(v1[0], v1[1]); w1.y = pg8::cvt_pk_bf16(v1[2], v1[3]);
                    *(v2u*)op = w0; *(v2u*)(op + 16) = w1; } }
    }
};
struct EpiResid {
    static constexpr bool PERM = true, AFTER_DRAIN = false;
    const float* X; float* OUT;
    __device__ __forceinline__ void operator()(const pg8::f32x4 (&acc)[2][2][4][2], const pg8::Unit& u, int wr, int wc, int fr, int fq) const {
        const int row0 = u.pm * 256 + wr * 64 + fr, col0 = u.pn * 256 + wc * 32 + 8 * fq;
#pragma unroll
        for (int ai = 0; ai < 2; ++ai)
#pragma unroll
            for (int m = 0; m < 4; ++m) { const size_t off = (size_t)(row0 + ai * 128 + m * 16) * 1024 + col0;
#pragma unroll
                for (int bj = 0; bj < 2; ++bj) { const f32x4* xp = (const f32x4*)(X + off + bj * 128); f32x4* op = (f32x4*)(OUT + off + bj * 128);
                    const f32x4 x0 = xp[0], x1 = xp[1]; const pg8::f32x4 v0 = acc[ai][bj][m][0], v1 = acc[ai][bj][m][1];
                    op[0] = (f32x4){x0.x + v0[0], x0.y + v0[1], x0.z + v0[2], x0.w + v0[3]};
                    op[1] = (f32x4){x1.x + v1[0], x1.y + v1[1], x1.z + v1[2], x1.w + v1[3]}; } }
    }
};

struct EpiSwiGLU {
    static constexpr bool PERM = true, AFTER_DRAIN = false;
    bf16* HH; const f32x2* EW; const LAS unsigned char* t2e; const LAS int* seg;
    __device__ __forceinline__ void operator()(const pg8::f32x4 (&acc)[2][2][4][2], const pg8::Unit& u, int wr, int wc, int fr, int fq) const {
        const int row0 = u.pm * 256 + wr * 64 + fr, j = u.pn & 1, col0 = j * 128 + wc * 32 + 8 * fq;
        const int e_ = __builtin_amdgcn_readfirstlane((int)t2e[u.pm]); const f32x2* roww = EW + (size_t)e_ * 16384 - __builtin_amdgcn_readfirstlane(seg[e_]);
#pragma unroll
        for (int ai = 0; ai < 2; ++ai)
#pragma unroll
            for (int m = 0; m < 4; ++m) { const int row = row0 + ai * 128 + m * 16; const f32x2 wr2 = roww[row]; const float w = wr2.x, rr = wr2.y;
                float hv[8];
#pragma unroll
                for (int n = 0; n < 2; ++n)
#pragma unroll
                    for (int k = 0; k < 4; ++k) { const float g = acc[ai][0][m][n][k] * rr, up = acc[ai][1][m][n][k] * rr;
                        hv[4 * n + k] = g * __builtin_amdgcn_rcpf(1.0f + __builtin_amdgcn_exp2f(-g * LOG2E)) * up * w; }
                v4u o; o.x = pg8::cvt_pk_bf16(hv[0], hv[1]); o.y = pg8::cvt_pk_bf16(hv[2], hv[3]); o.z = pg8::cvt_pk_bf16(hv[4], hv[5]); o.w = pg8::cvt_pk_bf16(hv[6], hv[7]);
                { bf16* hp = HH + (size_t)row * 256 + col0; asm volatile("global_store_dwordx4 %0, %1, off sc1" :: "v"(hp), "v"(o) : "memory"); } }
    }
};
template <int ntn> struct MoeOrder {
    int total, G, c; const LAS unsigned char* t2e;
    __device__ __forceinline__ bool next(int i, pg8::Unit& u) const {
        const int Lx = i * G + c; if (Lx >= total) return false;
        const int pm = Lx / ntn, j = Lx - pm * ntn; u.pm = pm; u.pn = __builtin_amdgcn_readfirstlane((int)t2e[pm]) * ntn + j; return true;
    }
    __device__ __forceinline__ void a_ready(const pg8::Unit&) const {}
    __device__ __forceinline__ void done(const pg8::Unit&) const {}
};

template <int ntn> struct MoeOrderG {
    int total, G, c; const LAS unsigned char* t2e; const LAS int* seg; const LAS int* cntL; const int* EL;
    __device__ __forceinline__ bool next(int i, pg8::Unit& u) const {
        const int Lx = i * G + c; if (Lx >= total) return false;
        const int pi = Lx / ntn, j = Lx - pi * ntn, pm = __builtin_amdgcn_readfirstlane((int)ord[pi]); u.pm = pm; u.pn = __builtin_amdgcn_readfirstlane((int)t2e[pm]) * ntn + j; return true;
    }
    __device__ __forceinline__ unsigned goff(const pg8::Unit& u, int h, int R, int C) const {
        const int e = __builtin_amdgcn_readfirstlane((int)t2e[u.pm]); const int cn = __builtin_amdgcn_readfirstlane(cntL[e]);
        int li = u.pm * 256 - __builtin_amdgcn_readfirstlane(seg[e]) + h * 128 + R; li = li < cn ? li : cn - 1;
        return (unsigned)EL[(size_t)e * 16384 + li] * 2048u + (unsigned)C * 2u;
    }
    __device__ __forceinline__ void a_ready(const pg8::Unit&) const {}
    unsigned* hcnt;
    const LAS unsigned char* ord;
    __device__ __forceinline__ void done(const pg8::Unit& u) const {
        asm volatile("s_waitcnt vmcnt(0)" ::: "memory");
        if ((threadIdx.x & 63) == 0) (void)__hip_atomic_fetch_add(hcnt + u.pm * 16, 6u, __ATOMIC_RELAXED, __HIP_MEMORY_SCOPE_AGENT);
    }
};
template <int ntn> struct MoeOrderD {
    int total; const LAS unsigned char* t2e; const LAS unsigned char* ord; const unsigned* hcnt; unsigned* tick; LAS unsigned* slot;
    __device__ __forceinline__ bool next(int i, pg8::Unit& u) const {
        (void)i;
        if (__builtin_amdgcn_readfirstlane((int)(threadIdx.x >> 6)) == 0) {
            unsigned tk = 0;
            if ((threadIdx.x & 63) == 0) tk = __hip_atomic_fetch_add(tick, 1u, __ATOMIC_RELAXED, __HIP_MEMORY_SCOPE_AGENT);
            tk = (unsigned)__builtin_amdgcn_readfirstlane((int)tk);
            if (tk < (unsigned)total) {
                const unsigned* w = hcnt + 16 * (int)ord[tk / ntn];
                for (unsigned polls = 0; polls < (1u << 20); ++polls) {
                    if ((unsigned)__builtin_amdgcn_readfirstlane((int)__hip_atomic_load(w, __ATOMIC_RELAXED, __HIP_MEMORY_SCOPE_AGENT)) >= 96u) break;
                    __builtin_amdgcn_s_sleep(2); }
                __builtin_amdgcn_fence(__ATOMIC_ACQUIRE, "agent");
            }
            if ((threadIdx.x & 63) == 0) *slot = tk;
            asm volatile("s_waitcnt vmcnt(0) lgkmcnt(0)" ::: "memory");
        }
        asm volatile("" ::: "memory"); __builtin_amdgcn_s_barrier(); asm volatile("" ::: "memory");
        const unsigned tk = (unsigned)__builtin_amdgcn_readfirstlane((int)*slot);
        if (tk >= (unsigned)total) return false;
        const int pm = __builtin_amdgcn_readfirstlane((int)ord[tk / ntn]), j = (int)(tk % ntn); u.pm = pm; u.pn = __builtin_amdgcn_readfirstlane((int)t2e[pm]) * ntn + j;
        return true;
    }
    __device__ __forceinline__ void a_ready(const pg8::Unit&) const {}
    __device__ __forceinline__ void done(const pg8::Unit&) const {}
};
constexpr int AM_MLA = 0, AM_SWA = 1, AM_MOBAC = 2, AM_SB = 3, AM_MOBAO = 4;
constexpr int AK_OFF = 0, AK_BUF = 13312;
constexpr int AV_OFF = 26624, AV_BUF = 8192;
constexpr int AW_OFF = 43008;
constexpr int AFLAG_OFF = 51200;
constexpr int ABIAS_OFF = 51456;
constexpr int UT_OFF = RING_BYTES + 1024;
constexpr int ATT_LDS_END = ABIAS_OFF + 256 + 32768;
static_assert(ATT_LDS_END <= RING_BYTES, "attention LDS");
constexpr float NEGBIG = -1.0e30f;
constexpr float ATT_THR = 8.0f;

__device__ __forceinline__ int crow(int r, int hi) { return (r & 3) + 8 * (r >> 2) + 4 * hi; }
typedef short v4i16_t __attribute__((ext_vector_type(4)));
__device__ __forceinline__ s16x4 vtr(const LAS unsigned char* p) { return __builtin_bit_cast(s16x4, __builtin_amdgcn_ds_read_tr16_b64_v4i16((LAS v4i16_t*)p)); }


template <int ND0, int RSK>
__device__ __forceinline__ void att_qk(const LAS unsigned char* Kc, int krd, const bf16x8 (&qf)[ND0], f32x16& p0, f32x16& p1, const f32x16& cinit) {
    p0 = cinit; p1 = cinit;
#pragma unroll
    for (int d0 = 0; d0 < ND0; ++d0) {
        const bf16x8 ka = *(const LAS bf16x8*)(Kc + krd + d0 * 32);
        const bf16x8 kb = *(const LAS bf16x8*)(Kc + krd + 32 * RSK + d0 * 32);
        p0 = __builtin_amdgcn_mfma_f32_32x32x16_bf16(ka, qf[d0], p0, 0, 0, 0);
        p1 = __builtin_amdgcn_mfma_f32_32x32x16_bf16(kb, qf[d0], p1, 0, 0, 0);
    }
}
template <int MODE>
__device__ __forceinline__ void att_smpv(f32x16& p0, f32x16& p1, f32x16 (&o)[2], float& mref, float& lsum, float& carry, const LAS unsigned char* Vc, int vrd,
                                         LAS float* wsf, const LAS float* btab, int qpos, int q0w, int t, int hi, int ql, float cscale, f32x16& negm, bool& first) {
    const int k0 = t * 64;
    const int dbase = qpos - k0 - 4 * hi;
    if constexpr (MODE != AM_SB) {
        if constexpr (MODE == AM_MLA) {
            if (k0 + 63 > q0w) {
#pragma unroll
                for (int r = 0; r < 16; ++r) { const int c0 = (r & 3) + 8 * (r >> 2);
                    p0[r] = (dbase - c0 >= 0) ? p0[r] : NEGBIG; p1[r] = (dbase - c0 - 32 >= 0) ? p1[r] : NEGBIG; }
            }
        } else {
#pragma unroll
            for (int r = 0; r < 16; ++r) {
                const int c0 = (r & 3) + 8 * (r >> 2);
                const int d0v = dbase - c0, d1v = dbase - c0 - 32;
                const float s0 = __builtin_fmaf(p0[r], cscale, btab[64 + d0v]), s1 = __builtin_fmaf(p1[r], cscale, btab[64 + d1v]);
                if constexpr (MODE == AM_MOBAC) { p0[r] = s0; p1[r] = s1; }
                else {
                    bool v0, v1;
                    if constexpr (MODE == AM_SWA) { v0 = (d0v >= 0) && (d0v < 128); v1 = (d1v >= 0) && (d1v < 128); }
                    else { v0 = (d0v >= 0); v1 = (d1v >= 0); }
                    p0[r] = v0 ? s0 : NEGBIG; p1[r] = v1 ? s1 : NEGBIG;
                }
            }
        }
        float rm = fmaxf(p0[0], p1[0]);
#pragma unroll
        for (int r = 1; r < 16; ++r) rm = fmaxf(fmaxf(rm, p0[r]), p1[r]);
        rm = fmaxf(rm, __shfl_xor(rm, 32));
        if constexpr (MODE == AM_MLA) {
            if (first || __any((int)(rm > ATT_THR))) {
                const float delta = (first || rm > ATT_THR) ? rm : 0.f;
                const float alpha = first ? 1.0f : __builtin_amdgcn_exp2f(-delta);
                mref += delta; lsum *= alpha;
#pragma unroll
                for (int r = 0; r < 16; ++r) { negm[r] = -mref; p0[r] -= delta; p1[r] -= delta; }
                if (!first) {
                    if (hi == 0) wsf[ql] = alpha;
#pragma unroll
                    for (int g4 = 0; g4 < 4; ++g4) { const f32x4 al = *(const LAS f32x4*)(wsf + 8 * g4 + 4 * hi);
                        o[0][4 * g4 + 0] *= al.x; o[0][4 * g4 + 1] *= al.y; o[0][4 * g4 + 2] *= al.z; o[0][4 * g4 + 3] *= al.w;
                        o[1][4 * g4 + 0] *= al.x; o[1][4 * g4 + 1] *= al.y; o[1][4 * g4 + 2] *= al.z; o[1][4 * g4 + 3] *= al.w; }
                }
                first = false;
            }
        } else
        if (__any((int)(rm - mref > ATT_THR))) {
            const float mnew = (rm - mref > ATT_THR) ? rm : mref;
            const float alpha = __builtin_amdgcn_exp2f(mref - mnew);
            mref = mnew; lsum *= alpha;
            if (hi == 0) wsf[ql] = alpha;
#pragma unroll
            for (int g4 = 0; g4 < 4; ++g4) { const f32x4 al = *(const LAS f32x4*)(wsf + 8 * g4 + 4 * hi);
                o[0][4 * g4 + 0] *= al.x; o[0][4 * g4 + 1] *= al.y; o[0][4 * g4 + 2] *= al.z; o[0][4 * g4 + 3] *= al.w;
                o[1][4 * g4 + 0] *= al.x; o[1][4 * g4 + 1] *= al.y; o[1][4 * g4 + 2] *= al.z; o[1][4 * g4 + 3] *= al.w; }
        }
        float ls = 0.f;
        if constexpr (MODE == AM_MLA) {
#pragma unroll
            for (int r = 0; r < 16; ++r) { p0[r] = __builtin_amdgcn_exp2f(p0[r]); p1[r] = __builtin_amdgcn_exp2f(p1[r]); ls += p0[r] + p1[r]; }
        } else {
#pragma unroll
            for (int r = 0; r < 16; ++r) { p0[r] = __builtin_amdgcn_exp2f(p0[r] - mref); p1[r] = __builtin_amdgcn_exp2f(p1[r] - mref); ls += p0[r] + p1[r]; }
        }
        lsum += ls;
    } else {
        float gt[8];
#pragma unroll
        for (int j = 0; j < 8; ++j) {
            float lsn[4], lsp[4];
#pragma unroll
            for (int i = 0; i < 4; ++i) {
                const int r = 4 * (j & 3) + i; const float acc = (j < 4) ? p0[r] : p1[r];
                const int dist = dbase - i - 8 * (j & 3) - 32 * (j >> 2);
                const float z = acc * cscale;
                const float l1 = __builtin_amdgcn_logf(1.0f + __builtin_amdgcn_exp2f(-fabsf(z)));
                const float a_ = fminf(z, 0.f) - l1;
                const bool valid = dist > 0;
                lsp[i] = valid ? a_ : NEGBIG; lsn[i] = valid ? (a_ - z) : 0.f;
            }
            const float s2 = lsn[3], s1 = s2 + lsn[2], s0 = s1 + lsn[1];
            gt[j] = s0 + lsn[0];
            const float e0 = lsp[0] + s0, e1 = lsp[1] + s1, e2 = lsp[2] + s2, e3 = lsp[3];
            if (j < 4) { p0[4 * j + 0] = e0; p0[4 * j + 1] = e1; p0[4 * j + 2] = e2; p0[4 * j + 3] = e3; }
            else { p1[4 * (j - 4) + 0] = e0; p1[4 * (j - 4) + 1] = e1; p1[4 * (j - 4) + 2] = e2; p1[4 * (j - 4) + 3] = e3; }
        }
        float ox[8];
#pragma unroll
        for (int j = 0; j < 8; ++j) ox[j] = __shfl_xor(gt[j], 32);
        float so = 0.f, sx = 0.f;
#pragma unroll
        for (int j = 7; j >= 0; --j) {
            const float sg = carry + so + sx + ((hi == 0) ? ox[j] : 0.f);
            if (j < 4) { p0[4 * j + 0] += sg; p0[4 * j + 1] += sg; p0[4 * j + 2] += sg; p0[4 * j + 3] += sg; }
            else { p1[4 * (j - 4) + 0] += sg; p1[4 * (j - 4) + 1] += sg; p1[4 * (j - 4) + 2] += sg; p1[4 * (j - 4) + 3] += sg; }
            so += gt[j]; sx += ox[j];
        }
        carry += so + sx;
#pragma unroll
        for (int r = 0; r < 16; ++r) { p0[r] = __builtin_amdgcn_exp2f(p0[r]); p1[r] = __builtin_amdgcn_exp2f(p1[r]); }
    }
    v4u pw[4];
    pw[0] = (v4u){pg8::cvt_pk_bf16(p0[0], p0[1]), pg8::cvt_pk_bf16(p0[2], p0[3]), pg8::cvt_pk_bf16(p0[4], p0[5]), pg8::cvt_pk_bf16(p0[6], p0[7])};
    pw[1] = (v4u){pg8::cvt_pk_bf16(p0[8], p0[9]), pg8::cvt_pk_bf16(p0[10], p0[11]), pg8::cvt_pk_bf16(p0[12], p0[13]), pg8::cvt_pk_bf16(p0[14], p0[15])};
    pw[2] = (v4u){pg8::cvt_pk_bf16(p1[0], p1[1]), pg8::cvt_pk_bf16(p1[2], p1[3]), pg8::cvt_pk_bf16(p1[4], p1[5]), pg8::cvt_pk_bf16(p1[6], p1[7])};
    pw[3] = (v4u){pg8::cvt_pk_bf16(p1[8], p1[9]), pg8::cvt_pk_bf16(p1[10], p1[11]), pg8::cvt_pk_bf16(p1[12], p1[13]), pg8::cvt_pk_bf16(p1[14], p1[15])};
#pragma unroll
    for (int s = 0; s < 4; ++s)
#pragma unroll
        for (int d0 = 0; d0 < 2; ++d0) {
            const s16x4 lo = vtr(Vc + vrd + d0 * 4096 + s * 1024), hi4 = vtr(Vc + vrd + d0 * 4096 + s * 1024 + 512);
            const bf16x8 vf = (bf16x8){lo[0], lo[1], lo[2], lo[3], hi4[0], hi4[1], hi4[2], hi4[3]};
            o[d0] = __builtin_amdgcn_mfma_f32_32x32x16_bf16(__builtin_bit_cast(bf16x8, pw[s]), vf, o[d0], 0, 0, 0);
        }
}

struct AttnPtrs {
    const bf16* Q; int qs;
    const bf16* K; int ks;
    const bf16* K2;
    const bf16* V; int vs;
    bf16* O;
};

struct MobaArgs { int q; int slot; bool valid; bool wvalid; int bhbase; bf16* PARTO; f32x2* PARTML; };
template <int MODE>
__device__ __forceinline__ void attn_unit(LAS unsigned char* L, const AttnPtrs& a, int q0u  , int q0w, int t_first, int t_last, float cscale,
                                          float sinkl2, const MobaArgs& mb, int boff, const f32x2* rope, int tid, int lane, int wave) {
    constexpr int DQK = (MODE == AM_MLA) ? 96 : 64, RSK = 2 * DQK + 16, ND0 = DQK / 16;
    const int ql = lane & 31, hi = lane >> 5;
    LAS unsigned char* Kb = L + AK_OFF; LAS unsigned char* Vb = L + AV_OFF;
    LAS float* wsf = (LAS float*)(L + AW_OFF + wave * 1024);
    const int qpos = (MODE == AM_MOBAC) ? mb.q : (q0w + ql);
    const bf16* qrow = (MODE == AM_MOBAC) ? (a.Q + (size_t)mb.q * a.qs) : (a.Q + (size_t)ql * a.qs);
    bf16x8 qf[ND0];
#pragma unroll
    for (int d0 = 0; d0 < ND0; ++d0) qf[d0] = *(const bf16x8*)(qrow + d0 * 16 + hi * 8);
    if constexpr (MODE == AM_MLA) {
        const f32x4* rp = (const f32x4*)(rope + (size_t)qpos * 16 + 8 * hi);
        const v4u w1 = __builtin_bit_cast(v4u, qf[4]), w2 = __builtin_bit_cast(v4u, qf[5]);
        float x1[8], x2[8], cs[16];
        x1[0] = bflo(w1.x); x1[1] = bfhi(w1.x); x1[2] = bflo(w1.y); x1[3] = bfhi(w1.y); x1[4] = bflo(w1.z); x1[5] = bfhi(w1.z); x1[6] = bflo(w1.w); x1[7] = bfhi(w1.w);
        x2[0] = bflo(w2.x); x2[1] = bfhi(w2.x); x2[2] = bflo(w2.y); x2[3] = bfhi(w2.y); x2[4] = bflo(w2.z); x2[5] = bfhi(w2.z); x2[6] = bflo(w2.w); x2[7] = bfhi(w2.w);
#pragma unroll
        for (int k = 0; k < 4; ++k) { const f32x4 v = rp[k]; cs[4 * k] = v.x; cs[4 * k + 1] = v.y; cs[4 * k + 2] = v.z; cs[4 * k + 3] = v.w; }
        float y1[8], y2[8];
#pragma unroll
        for (int j = 0; j < 8; ++j) { const float c = cs[2 * j] * cscale, sn = cs[2 * j + 1] * cscale; y1[j] = x1[j] * c - x2[j] * sn; y2[j] = x2[j] * c + x1[j] * sn; }
#pragma unroll
        for (int d0 = 0; d0 < 4; ++d0) { const v4u w = __builtin_bit_cast(v4u, qf[d0]);
            const v4u ws_ = (v4u){pk2(bflo(w.x) * cscale, bfhi(w.x) * cscale), pk2(bflo(w.y) * cscale, bfhi(w.y) * cscale), pk2(bflo(w.z) * cscale, bfhi(w.z) * cscale), pk2(bflo(w.w) * cscale, bfhi(w.w) * cscale)};
            qf[d0] = __builtin_bit_cast(bf16x8, ws_); }
        const v4u o1 = (v4u){pk2(y1[0], y1[1]), pk2(y1[2], y1[3]), pk2(y1[4], y1[5]), pk2(y1[6], y1[7])};
        const v4u o2 = (v4u){pk2(y2[0], y2[1]), pk2(y2[2], y2[3]), pk2(y2[4], y2[5]), pk2(y2[6], y2[7])};
        qf[4] = __builtin_bit_cast(bf16x8, o1); qf[5] = __builtin_bit_cast(bf16x8, o2);
    }
    const int skey = tid >> 3, sc = tid & 7;
    const bf16* kg = a.K + (size_t)skey * a.ks + sc * 8;
    const bf16* vg = a.V + (size_t)skey * a.vs + sc * 8;
    const bf16* k2g = nullptr; if constexpr (MODE == AM_MLA) k2g = a.K2 + (size_t)(tid >> 2) * 32 + (tid & 3) * 8;
    const int kw_off = skey * RSK + sc * 16, vw_off = (sc >> 2) * 4096 + skey * 64 + (sc & 3) * 16, k2w_off = (tid >> 2) * RSK + 128 + (tid & 3) * 16;
    v4u rk, rv, rk2;
#define ATT_LOAD(t) do { rk = *(const v4u*)(kg + (size_t)(t) * 64 * a.ks); rv = *(const v4u*)(vg + (size_t)(t) * 64 * a.vs); \
        if constexpr (MODE == AM_MLA) { if (tid < 256) rk2 = *(const v4u*)(k2g + (size_t)(t) * 64 * 32); } } while (0)
#define ATT_WRITE(kbuf, vbuf) do { *(LAS v4u*)(Kb + (kbuf) * AK_BUF + kw_off) = rk; *(LAS v4u*)(Vb + (vbuf) * AV_BUF + vw_off) = rv; \
        if constexpr (MODE == AM_MLA) { if (tid < 256) *(LAS v4u*)(Kb + (kbuf) * AK_BUF + k2w_off) = rk2; } } while (0)
    f32x16 o[2]; o[0] = f32x16{}; o[1] = f32x16{};
    float mref = (MODE == AM_MLA) ? 0.f : NEGBIG, lsum = 0.f, carry = 0.f;
    f32x16 negm = f32x16{}; bool first = true;
    const int krd = ql * RSK + hi * 16;
    const int vrd = ((lane >> 4) & 1) * 32 + (lane & 3) * 8 + (4 * hi + ((lane & 15) >> 2)) * 64;
    const LAS float* btab = (const LAS float*)(L + ABIAS_OFF) + boff;
    constexpr bool REV = (MODE == AM_SB);
    const int ntl = t_last - t_first + 1;
    constexpr bool SKEW = false;
    const bool skew = SKEW && (wave >= 4);
    f32x16 p0, p1;
#define ATT_TILE(i) (REV ? (t_last - (i)) : (t_first + (i)))
    ATT_LOAD(ATT_TILE(0));
    __syncthreads();
    ATT_WRITE(0, 0);
    __syncthreads();
    if (skew) { if (ntl > 1) ATT_LOAD(ATT_TILE(1)); __syncthreads(); }
    for (int it = 0; it < ntl; ++it) {
        const int t = ATT_TILE(it), cur = it & 1, k0 = t * 64;
        const bool more = (it + 1 < ntl);
        if (!skew && more) ATT_LOAD(ATT_TILE(it + 1));
        bool need;
        if constexpr (MODE == AM_MLA) need = (k0 <= q0w + 31);
        else if constexpr (MODE == AM_SWA) need = (k0 <= q0w + 31) && (k0 + 63 >= q0w - 127);
        else if constexpr (MODE == AM_MOBAC) need = mb.wvalid;
        else if constexpr (MODE == AM_MOBAO) need = (k0 <= q0w + 31);
        else need = (k0 < q0w + 31) && (__any((int)(carry > -160.f)) != 0);
        if (need) att_qk<ND0, RSK>(Kb + cur * AK_BUF, krd, qf, p0, p1, negm);
        if constexpr (SKEW) {
            if (skew && more) ATT_WRITE(cur ^ 1, cur ^ 1);
            __syncthreads();
            if (skew && it + 2 < ntl) ATT_LOAD(ATT_TILE(it + 2));
        }
        if (need) att_smpv<MODE>(p0, p1, o, mref, lsum, carry, Vb + cur * AV_BUF, vrd, wsf, btab, qpos, q0w, t, hi, ql, cscale, negm, first);
        if (!skew && more) ATT_WRITE(cur ^ 1, cur ^ 1);
        if constexpr (MODE == AM_SB) {
            volatile LAS unsigned* fl = (volatile LAS unsigned*)(L + AFLAG_OFF);
            const bool wdone = (k0 < q0w + 31) && (__any((int)(carry > -160.f)) == 0);
            if (lane == 0) fl[cur * 8 + wave] = wdone ? 1u : 0u;
            __syncthreads();
            unsigned alld = 1u;
#pragma unroll
            for (int w = 0; w < 8; ++w) alld &= fl[cur * 8 + w];
            if (alld) break;
        } else {
            __syncthreads();
        }
    }
    if (SKEW && !skew) __syncthreads();
#undef ATT_TILE
#undef ATT_LOAD
#undef ATT_WRITE
    LAS unsigned short* stg = (LAS unsigned short*)(L + wave * 4096);
    LAS int* wsi = (LAS int*)wsf;
    lsum += __shfl_xor(lsum, 32);
    float inv[16];
    if constexpr (MODE == AM_MOBAC || MODE == AM_MOBAO) {
        const int di = (MODE == AM_MOBAO) ? ((mb.bhbase + qpos) * 4 + 3) : (mb.valid ? ((mb.bhbase + mb.q) * 4 + mb.slot) : -1);
        if (hi == 0) { wsi[ql] = (MODE == AM_MOBAO) ? 0 : (mb.valid ? ((mb.bhbase + mb.q) * 3 + mb.slot) : -1); if (di >= 0) mb.PARTML[di] = (f32x2){mref, lsum}; }
#pragma unroll
        for (int r = 0; r < 16; ++r) inv[r] = 1.0f;
    } else if constexpr (MODE != AM_SB) {
        if constexpr (MODE == AM_SWA) lsum += __builtin_amdgcn_exp2f(sinkl2 - mref);
        if (hi == 0) wsf[32 + ql] = lsum;
#pragma unroll
        for (int g4 = 0; g4 < 4; ++g4) { const f32x4 lv = *(const LAS f32x4*)(wsf + 32 + 8 * g4 + 4 * hi);
            inv[4 * g4 + 0] = 1.0f / lv.x; inv[4 * g4 + 1] = 1.0f / lv.y; inv[4 * g4 + 2] = 1.0f / lv.z; inv[4 * g4 + 3] = 1.0f / lv.w; }
    } else {
#pragma unroll
        for (int r = 0; r < 16; ++r) inv[r] = 1.0f;
    }
#pragma unroll
    for (int r = 0; r < 16; ++r) { const int row = crow(r, hi);
        stg[row * 64 + ql] = (unsigned short)f2bf(o[0][r] * inv[r]); stg[row * 64 + 32 + ql] = (unsigned short)f2bf(o[1][r] * inv[r]); }
#pragma unroll
    for (int i = 0; i < 4; ++i) { const int c = lane + 64 * i, row = c >> 3, part = c & 7;
        const v4u v = *(const LAS v4u*)(stg + row * 64 + part * 8);
        if constexpr (MODE == AM_MOBAC) { const int d = wsi[row]; if (d >= 0) *(v4u*)(mb.PARTO + (size_t)d * 64 + part * 8) = v; }
        else *(v4u*)(a.O + (size_t)row * 1024 + part * 8) = v; }
}

constexpr int RK_OFF = 0, RK_TILE = 9216;
constexpr int RV_OFF = 36864, RV_TILE = 8192;
constexpr int RW_OFF = 69632;
constexpr int RB_OFF = 86016;
static_assert(RB_OFF + 256 + 32768 <= RING_BYTES, "resident MoBA LDS");

__device__ __forceinline__ void moba_resident_load(LAS unsigned char* L, const bf16* Kblk, const bf16* Vblk, int tid) {
    const int skey = tid >> 3, sc = tid & 7;
    v4u rk[4], rv[4];
#pragma unroll
    for (int t = 0; t < 4; ++t) { rk[t] = *(const v4u*)(Kblk + (size_t)(t * 64 + skey) * 3072 + sc * 8); rv[t] = *(const v4u*)(Vblk + (size_t)(t * 64 + skey) * 3072 + sc * 8); }
#pragma unroll
    for (int t = 0; t < 4; ++t) { *(LAS v4u*)(L + RK_OFF + t * RK_TILE + skey * 144 + sc * 16) = rk[t]; *(LAS v4u*)(L + RV_OFF + t * RV_TILE + (sc >> 2) * 4096 + skey * 64 + (sc & 3) * 16) = rv[t]; }
}
__device__ __forceinline__ void moba_resident_wave(LAS unsigned char* L, const bf16* Qb  , int n, int q, int slot, bool valid, int bhbase,
                                                   bf16* PARTO, f32x2* PARTML, int lane, int wave) {
    const int ql = lane & 31, hi = lane >> 5;
    LAS float* wsf = (LAS float*)(L + RW_OFF + wave * 2048);
    LAS int* wsi = (LAS int*)(L + RW_OFF + wave * 2048 + 1024);
    const LAS float* btab = (const LAS float*)(L + RB_OFF);
    bf16x8 qf[4];
#pragma unroll
    for (int d0 = 0; d0 < 4; ++d0) qf[d0] = *(const bf16x8*)(Qb + (size_t)q * 3072 + d0 * 16 + hi * 8);
    f32x16 o[2]; o[0] = f32x16{}; o[1] = f32x16{};
    float mref = NEGBIG, lsum = 0.f, carry = 0.f; f32x16 negm = f32x16{}; bool first = true;
    const int krd = ql * 144 + hi * 16;
    const int vrd = ((lane >> 4) & 1) * 32 + (lane & 3) * 8 + (4 * hi + ((lane & 15) >> 2)) * 64;
    f32x16 p0, p1;
#pragma unroll 1
    for (int t = 0; t < 4; ++t) {
        att_qk<4, 144>(L + RK_OFF + t * RK_TILE, krd, qf, p0, p1, negm);
        att_smpv<AM_MOBAC>(p0, p1, o, mref, lsum, carry, L + RV_OFF + t * RV_TILE, vrd, wsf, btab, q, 0, 4 * n + t, hi, ql, 0.125f * LOG2E, negm, first);
    }
    lsum += __shfl_xor(lsum, 32);
    const int di = valid ? ((bhbase + q) * 4 + slot) : -1;
    if (hi == 0) { wsi[ql] = valid ? ((bhbase + q) * 3 + slot) : -1; if (di >= 0) PARTML[di] = (f32x2){mref, lsum}; }
    LAS unsigned short* stg = (LAS unsigned short*)wsf;
#pragma unroll
    for (int g4 = 0; g4 < 4; ++g4) {
#pragma unroll
        for (int k = 0; k < 4; ++k) { const int r = 4 * g4 + k, lrow = 4 * hi + k;
            stg[lrow * 64 + ql] = (unsigned short)f2bf(o[0][r]); stg[lrow * 64 + 32 + ql] = (unsigned short)f2bf(o[1][r]); }
        const int lrow = lane >> 3, part = lane & 7, d = wsi[8 * g4 + lrow];
        const v4u v = *(const LAS v4u*)(stg + lrow * 64 + part * 8);
        if (d >= 0) *(v4u*)(PARTO + (size_t)d * 64 + part * 8) = v;
    }
}
#ifndef REP_CH
#define REP_CH 1
#endif
#ifndef REPS_INIT
#define REPS_INIT {1,1,1,1,1,1,1,1,1,1,1,1,1,1,1,1,1,1,1,1,1,1}
#endif
__device__ constexpr int REPS[22] = REPS_INIT;
__device__ __forceinline__ void p0_prologue(const Params& p, LAS unsigned char* L, int gw, int NGW, int lane, int wave, int gtid, int NGT) {
    LAS float* scr = (LAS float*)(L + wave * 16384);
    unsigned char* ws = p.ws;
    constexpr int I0 = 592, I1 = 96, I2 = 64, I3 = 512, I4 = 1536, I5 = 512, IM = 24576;
    constexpr int NIT = I0 + I1 + I2 + I3 + I4 + I5; (void)IM;
    for (int it = gw; it < NIT; it += NGW) {
        int r = it;
        if (r < I0) { const int kb = r / 37, nb = r % 37; transpose_item(p.in[5], 1184, 64 * kb, 32 * nb, (bf16*)(ws + WS_WINE) + (size_t)(32 * nb) * 1024, 1024, scr, lane); continue; } r -= I0;
        if (r < I1) { const int kb = r / 24, nb = r % 24; transpose_item(p.in[8], 768, 64 * kb, 32 * nb, (bf16*)(ws + WS_WQB) + (size_t)(32 * nb) * 256, 256, scr, lane); continue; } r -= I1;
        if (r < I2) { const int kb = r / 32, nb = r % 32; transpose_item(p.in[9], 1024, 64 * kb, 32 * nb, (bf16*)(ws + WS_WKVB) + (size_t)(32 * nb) * 128, 128, scr, lane); continue; } r -= I2;
        if (r < I3) { const int kb = r / 32, nb = r % 32; transpose_item(p.in[11], 1024, 64 * kb, 32 * nb, (bf16*)(ws + WS_WOE) + (size_t)(32 * nb) * 1024, 1024, scr, lane); continue; } r -= I3;
        if (r < I4) { const int kb = r / 96, nb = r % 96; transpose_item(p.in[12], 3072, 64 * kb, 32 * nb, (bf16*)(ws + WS_WINO) + (size_t)(32 * nb) * 1024, 1024, scr, lane); continue; } r -= I4;
        { const int kb = r / 32, nb = r % 32; transpose_item(p.in[13], 1024, 64 * kb, 32 * nb, (bf16*)(ws + WS_WOO) + (size_t)(32 * nb) * 1024, 1024, scr, lane); }
    }
    { v4u* z = (v4u*)((bf16*)(ws + WS_WINE) + (size_t)1184 * 1024); for (int i = gtid; i < 96 * 1024 / 8; i += NGT) z[i] = (v4u){0u, 0u, 0u, 0u}; }
    for (int m = gw; m < NTOK / 2; m += NGW) rms_rows2_to_bf16(p.in[0] + (size_t)m * 1024, p.in[0] + (size_t)(m + NTOK / 2) * 1024, p.in[1], (bf16*)(ws + WS_U) + (size_t)m * 1024, (bf16*)(ws + WS_U) + (size_t)(m + NTOK / 2) * 1024, lane);
    { float* bt = (float*)(ws + WS_BIAS); const float* rel = p.in[4];
      for (int i = gtid; i < 8 * 8192; i += NGT) { const int h = i >> 13, n = i & 8191; int b;
          if (n < 16) b = n; else { b = 16 + (int)(log((double)n / 16.0) / log(128.0) * 16.0); if (b > 31) b = 31; }
          bt[i] = rel[b * 8 + h] * LOG2E; } }
    { float* wrt = (float*)(ws + WS_WRT);
      for (int i = gtid; i < 2 * 48 * 1024; i += NGT) { const int d = i & 1023, j = (i >> 10) % 48, l = i / (48 * 1024);
          const float g = p.in[2][l * 1024 + d];
          const float w = (j < 32) ? g * p.in[16][((size_t)l * 1024 + d) * 32 + j] : (j < 36) ? g * p.in[14][((size_t)l * 1024 + d) * 4 + (j - 32)] : 0.f;
          wrt[i] = w; const unsigned hb = f2bf(w);
          const int cch = d >> 5, kq_ = (d >> 3) & 3, e_ = d & 7, jt = j >> 4, col_ = j & 15;
          const size_t fi = ((((size_t)l * 32 + cch) * 3 + jt) * 64 + (kq_ * 16 + col_)) * 8 + e_;
          ((bf16*)(ws + WS_WRT + 512 * 1024))[fi] = (bf16)hb; ((bf16*)(ws + WS_WRT + 768 * 1024))[fi] = (bf16)f2bf(w - bf2f((unsigned short)hb)); } }
    { f32x2* rt = (f32x2*)(ws + WS_ROPE);
      for (int i = gtid; i < 8192 * 16; i += NGT) { const int t = i >> 4, ii = i & 15;
          const float freq = (float)pow(10000.0, -(double)(2 * ii) / 32.0); const float ang = (float)t * freq;
          f32x2 cs; cs.x = (float)cos((double)ang); cs.y = (float)sin((double)ang); rt[i] = cs; } }
}


__device__ __forceinline__ void moe_item(const Params& p, int layer, int it, const float*& W, int& ldw, int& k0, int& n0, bf16*& dst, int& ldk) {
    const int r = layer * 32 * 384 + it, le = r / 384, rr = r % 384, which = rr >> 7, item = rr & 127, e = le & 31;
    unsigned char* lbase = p.ws + WS_MOEW + (size_t)(le >> 5) * 48 * MiB;
    if (which < 2) { W = p.in[18 + which] + (size_t)le * 1024 * 256; ldw = 256; const int kb = item / 8, nb = item % 8; k0 = 64 * kb; n0 = 32 * nb;
        dst = (bf16*)lbase + ((size_t)e * 512 + (n0 >> 7) * 256 + which * 128 + (n0 & 127)) * 1024; ldk = 1024; }
    else { W = p.in[20] + (size_t)le * 256 * 1024; ldw = 1024; const int kb = item / 32, nb = item % 32; k0 = 64 * kb; n0 = 32 * nb;
        dst = (bf16*)(lbase + 32 * MiB) + ((size_t)e * 1024 + 32 * nb) * 256; ldk = 256; }
}
__device__ __forceinline__ void moe_convert(const Params& p, LAS unsigned char* L, int layer, int widx, int nworkers, int lane, int wave) {
    LAS float* scr = (LAS float*)(L + wave * 16384);
    int it = widx;
    if (it >= 32 * 384) return;
    const float* W; int ldw, k0, n0, ldk; bf16* dst;
    moe_item(p, layer, it, W, ldw, k0, n0, dst, ldk);
    float tv[32];
#pragma unroll
    for (int i = 0; i < 32; ++i) tv[i] = W[(size_t)(k0 + 2 * i + (lane >> 5)) * ldw + n0 + (lane & 31)];
    for (;;) {
        const int itn = it + nworkers; const bool more = itn < 32 * 384;
        const float* Wn = W; int ldwn = ldw, k0n = k0, n0n = n0, ldkn = ldk; bf16* dstn = dst;
        if (more) moe_item(p, layer, itn, Wn, ldwn, k0n, n0n, dstn, ldkn);
#pragma unroll
        for (int i = 0; i < 32; ++i) scr[(2 * i + (lane >> 5)) * 33 + (lane & 31)] = tv[i];
        if (more) {
#pragma unroll
            for (int i = 0; i < 32; ++i) tv[i] = Wn[(size_t)(k0n + 2 * i + (lane >> 5)) * ldwn + n0n + (lane & 31)];
        }
        LDS_WAIT(); asm volatile("" ::: "memory");
        const int c = lane & 7;
#pragma unroll
        for (int j = 0; j < 4; ++j) { const int n = (lane >> 3) + 8 * j; const LAS float* s = scr + (8 * c) * 33 + n;
            v4u o; o.x = pk2(s[0 * 33], s[1 * 33]); o.y = pk2(s[2 * 33], s[3 * 33]); o.z = pk2(s[4 * 33], s[5 * 33]); o.w = pk2(s[6 * 33], s[7 * 33]);
            *(v4u*)(dst + (size_t)n * ldk + k0 + 8 * c) = o; }
        LDS_WAIT(); asm volatile("" ::: "memory");
        if (!more) break;
        it = itn; W = Wn; ldw = ldwn; k0 = k0n; n0 = n0n; dst = dstn; ldk = ldkn;
    }
}
constexpr int MOE_T2E_OFF = RING_BYTES + 1024;
template <bool ORD>
__device__ __forceinline__ void moe_tables(const Params& p, LAS unsigned char* L, int layer, int tid, int G, int& ntiles, int& nfull) {
    LAS int* seg = (LAS int*)(L + MOE_T2E_OFF + 256); LAS unsigned char* t2e = L + MOE_T2E_OFF; LAS int* cntL = (LAS int*)(L + MOE_T2E_OFF + 512);
    LAS unsigned char* ord = L + MOE_T2E_OFF + 640; LAS int* nf = (LAS int*)(L + MOE_T2E_OFF + 800);
    const unsigned* cnt = (const unsigned*)(p.ws + WS_CTL) + CW_ECNT + layer * 32 * 64;
    __syncthreads();
    if (tid < 64) {
        const int c = (tid < 32) ? (int)__hip_atomic_load(cnt + tid * 64, __ATOMIC_RELAXED, __HIP_MEMORY_SCOPE_AGENT) : 0;
        const int nt = (c + 255) >> 8; const int r = c - (nt - 1) * 256; const int part = (nt > 0 && r < 256) ? 1 : 0;
        int tl_ = 0;
        if constexpr (ORD) {
            int ncomp = nt - part;
#pragma unroll
            for (int o = 1; o < 64; o <<= 1) ncomp += __shfl_xor(ncomp, o);
            const int slots = ((ncomp * 2 + G - 1) / G) * G / 2 - ncomp;
            int rank = 0;
            const int key = part ? r : -1;
#pragma unroll
            for (int e2 = 0; e2 < 32; ++e2) { const int k2 = __builtin_amdgcn_readlane(key, e2); rank += (k2 > key || (k2 == key && e2 < tid)) ? 1 : 0; }
            tl_ = (part && rank >= slots) ? 1 : 0;
        }
        const int tl = tl_; const int nfe = nt - tl;
        int inc = nt, incf = nfe, inct = tl;
#pragma unroll
        for (int o = 1; o < 32; o <<= 1) { const int v = __shfl_up(inc, o), vf = __shfl_up(incf, o), vt = __shfl_up(inct, o); if ((tid & 63) >= o) { inc += v; incf += vf; inct += vt; } }
        const int nfa = __shfl(incf, 31);
        if (tid < 32) { cntL[tid] = c; seg[tid] = (inc - nt) * 256; for (int t = inc - nt; t < inc; ++t) t2e[t] = (unsigned char)tid;
            for (int t = 0; t < nfe; ++t) ord[incf - nfe + t] = (unsigned char)(inc - nt + t);
            if (tl) ord[nfa + inct - 1] = (unsigned char)(inc - 1); }
        if (tid == 31) { seg[32] = inc * 256; nf[0] = nfa; }
    }
    __syncthreads();
    ntiles = seg[32] >> 8; nfull = nf[0];
}
__device__ __forceinline__ void moe_tail_units(const Params& p, LAS unsigned char* L, const bf16* GU, unsigned* hcnt, int nfull, int ntiles, int q, int G, int tid, int lane, int wave) {
    unsigned char* ws = p.ws;
    const LAS int* seg = (const LAS int*)(L + MOE_T2E_OFF + 256); const LAS unsigned char* t2e = L + MOE_T2E_OFF; const LAS int* cntL = (const LAS int*)(L + MOE_T2E_OFF + 512);
    const LAS unsigned char* ord = L + MOE_T2E_OFF + 640;
    const bf16* UB = (const bf16*)(ws + WS_U); const int* EL = (const int*)(ws + WS_EL); const f32x2* EW = (const f32x2*)(ws + WS_EW); bf16* HH = (bf16*)(ws + WS_HH);
    constexpr int RS = 528;
    const int mb = wave & 3, cg = wave >> 2, fm = lane & 15, kq = lane >> 4;
    int base = 0;
    for (int ti = nfull; ti < ntiles; ++ti) {
        const int pm = (int)ord[ti], e = (int)t2e[pm], cn = cntL[e], off = pm * 256 - seg[e], rows = cn - off, nun = ((rows + 63) >> 6) * 8;
        const unsigned pub = 96u / (unsigned)nun;
        for (int un = (q - base + G) % G; un < nun; un += G) {
            const int rg = un >> 3, s = un & 7, f0 = s * 32, ro = off + rg * 64;
            const bf16* src[8];
#pragma unroll
            for (int i = 0; i < 8; ++i) { const int r = (wave & 3) * 16 + 2 * i + (lane >> 5);
                if (wave < 4) { int li = ro + r; li = li < cn ? li : cn - 1; src[i] = UB + (size_t)EL[(size_t)e * 16384 + li] * 1024 + (lane & 31) * 8; }
                else { const int f = f0 + (r & 31); src[i] = GU + ((size_t)e * 512 + (f >> 7) * 256 + (f & 127) + (r >> 5) * 128) * 1024 + (lane & 31) * 8; } }
            pg8::f32x4 accg = (pg8::f32x4){0.f, 0.f, 0.f, 0.f}, accu = (pg8::f32x4){0.f, 0.f, 0.f, 0.f};
            const bool active = (ro + mb * 16 < cn);
            v4u rr[8];
#pragma unroll
            for (int i = 0; i < 8; ++i) rr[i] = *(const v4u*)(src[i]);
#pragma unroll 1
            for (int ch = 0; ch < 4; ++ch) {
                __syncthreads();
#pragma unroll
                for (int i = 0; i < 8; ++i) *(LAS v4u*)(L + (wave * 16 + 2 * i + (lane >> 5)) * RS + (lane & 31) * 16) = rr[i];
                __syncthreads();
                if (ch < 3) {
#pragma unroll
                    for (int i = 0; i < 8; ++i) rr[i] = *(const v4u*)(src[i] + (ch + 1) * 256);
                }
                if (active) {
#pragma unroll
                    for (int kk = 0; kk < 8; ++kk) {
                        const pg8::bf16x8 af = *(const LAS pg8::bf16x8*)(L + (mb * 16 + fm) * RS + kk * 64 + kq * 16);
                        const pg8::bf16x8 bg = *(const LAS pg8::bf16x8*)(L + (64 + cg * 16 + fm) * RS + kk * 64 + kq * 16);
                        const pg8::bf16x8 bu = *(const LAS pg8::bf16x8*)(L + (96 + cg * 16 + fm) * RS + kk * 64 + kq * 16);
                        accg = __builtin_amdgcn_mfma_f32_16x16x32_bf16(af, bg, accg, 0, 0, 0);
                        accu = __builtin_amdgcn_mfma_f32_16x16x32_bf16(af, bu, accu, 0, 0, 0);
                    }
                }
            }
            if (active) {
#pragma unroll
                for (int i = 0; i < 4; ++i) { const int lr = rg * 64 + mb * 16 + 4 * kq + i, li = off + lr;
                    if (li < cn) { const f32x2 w2 = EW[(size_t)e * 16384 + li]; const float g = accg[i] * w2.y, up = accu[i] * w2.y;
                        const float hv = g * __builtin_amdgcn_rcpf(1.0f + __builtin_amdgcn_exp2f(-g * LOG2E)) * up * w2.x;
                        const unsigned hb = (unsigned)f2bf(hv); bf16* hp = HH + (size_t)(pm * 256 + lr) * 256 + f0 + cg * 16 + fm;
                        asm volatile("global_store_short %0, %1, off sc1" :: "v"(hp), "v"(hb) : "memory"); } }
            }
            asm volatile("s_waitcnt vmcnt(0)" ::: "memory");
            __syncthreads();
            if (tid == 0) (void)__hip_atomic_fetch_add(hcnt + pm * 16, pub, __ATOMIC_RELAXED, __HIP_MEMORY_SCOPE_AGENT);
        }
        base = (base + nun) % G;
    }
}
__device__ __forceinline__ void moe_route(const Params& p, LAS unsigned char* L, int layer, const float* H, int gw, int NGW, int lane, int wave) {
    unsigned char* ws = p.ws;
    const float* b_group = p.in[15] + layer * 4; const float* b_router = p.in[17] + layer * 32; const float* gain = p.in[2] + layer * 1024;
    unsigned* cnt = (unsigned*)(ws + WS_CTL) + CW_ECNT + layer * 32 * 64;
    bf16* UB = (bf16*)(ws + WS_U);
    const int g4 = wave & 3, half = wave >> 2;
    LAS float* lg = (LAS float*)(L + g4 * 4096);
    LAS float* pl = (LAS float*)(L + 16384 + g4 * 4096);
    LAS unsigned* lc = (LAS unsigned*)(L + 32768);
    const int tok = lane & 15, kq = lane >> 4, tid = wave * 64 + lane;
    const int G_ = NGW / NWAVES, vcu_ = gw / NWAVES;
    for (int base = 0; base < NTOK / 16; base += 4 * G_) {
        const int grp = base + g4 * G_ + vcu_;
        const bool active = (grp < NTOK / 16);
        if (tid < 32) lc[tid] = 0u;
        int e0 = 0, e1 = 0; unsigned r0 = 0u, r1 = 0u; float wA = 0.f, wB = 0.f, rtok = 0.f; const int m0 = grp * 16;
        pg8::f32x4 acc0 = {0.f, 0.f, 0.f, 0.f}, acc1 = acc0, acc2 = acc0; float ss = 0.f;
        if (active) {
            const int kb = 512 * half + 8 * kq;
            const float* hrow = H + (size_t)(m0 + tok) * 1024 + kb;
            const float* grow = gain + kb;
            bf16* urow = UB + (size_t)(m0 + tok) * 1024 + kb;
            const bf16* wh = (const bf16*)(ws + WS_WRT + 512 * 1024) + ((size_t)layer * 32 + 16 * half) * 1536 + lane * 8;
            const bf16* wl = (const bf16*)(ws + WS_WRT + 768 * 1024) + ((size_t)layer * 32 + 16 * half) * 1536 + lane * 8;
            f32x4 ra0[2], ra1[2], rq0[2], rq1[2]; bf16x8 rbh0[2], rbl0[2], rbh1[2], rbl1[2], rbh2[2], rbl2[2];
#define RT_LD(S, C) do { ra0[S] = *(const f32x4*)(hrow + 32 * (C)); ra1[S] = *(const f32x4*)(hrow + 32 * (C) + 4); rq0[S] = *(const f32x4*)(grow + 32 * (C)); rq1[S] = *(const f32x4*)(grow + 32 * (C) + 4); \
                rbh0[S] = *(const bf16x8*)(wh + 1536 * (C)); rbl0[S] = *(const bf16x8*)(wl + 1536 * (C)); rbh1[S] = *(const bf16x8*)(wh + 1536 * (C) + 512); rbl1[S] = *(const bf16x8*)(wl + 1536 * (C) + 512); \
                rbh2[S] = *(const bf16x8*)(wh + 1536 * (C) + 1024); rbl2[S] = *(const bf16x8*)(wl + 1536 * (C) + 1024); } while (0)
#define RT_DO(S, C) do { const f32x4 a0 = ra0[S], a1 = ra1[S], q0 = rq0[S], q1 = rq1[S]; \
                ss += ((a0.x * a0.x + a0.y * a0.y) + (a0.z * a0.z + a0.w * a0.w)) + ((a1.x * a1.x + a1.y * a1.y) + (a1.z * a1.z + a1.w * a1.w)); \
                { v4u ub; ub.x = pg8::cvt_pk_bf16(a0.x * q0.x, a0.y * q0.y); ub.y = pg8::cvt_pk_bf16(a0.z * q0.z, a0.w * q0.w); ub.z = pg8::cvt_pk_bf16(a1.x * q1.x, a1.y * q1.y); ub.w = pg8::cvt_pk_bf16(a1.z * q1.z, a1.w * q1.w); \
                  *(v4u*)(urow + 32 * (C)) = ub; } \
                v4u hi4, lo4; \
                hi4.x = pg8::cvt_pk_bf16(a0.x, a0.y); hi4.y = pg8::cvt_pk_bf16(a0.z, a0.w); hi4.z = pg8::cvt_pk_bf16(a1.x, a1.y); hi4.w = pg8::cvt_pk_bf16(a1.z, a1.w); \
                lo4.x = pg8::cvt_pk_bf16(a0.x - bflo(hi4.x), a0.y - bfhi(hi4.x)); lo4.y = pg8::cvt_pk_bf16(a0.z - bflo(hi4.y), a0.w - bfhi(hi4.y)); \
                lo4.z = pg8::cvt_pk_bf16(a1.x - bflo(hi4.z), a1.y - bfhi(hi4.z)); lo4.w = pg8::cvt_pk_bf16(a1.z - bflo(hi4.w), a1.w - bfhi(hi4.w)); \
                const bf16x8 ah = __builtin_bit_cast(bf16x8, hi4), al = __builtin_bit_cast(bf16x8, lo4); \
                acc0 = __builtin_amdgcn_mfma_f32_16x16x32_bf16(ah, rbh0[S], acc0, 0, 0, 0); acc1 = __builtin_amdgcn_mfma_f32_16x16x32_bf16(ah, rbh1[S], acc1, 0, 0, 0); acc2 = __builtin_amdgcn_mfma_f32_16x16x32_bf16(ah, rbh2[S], acc2, 0, 0, 0); \
                acc0 = __builtin_amdgcn_mfma_f32_16x16x32_bf16(ah, rbl0[S], acc0, 0, 0, 0); acc1 = __builtin_amdgcn_mfma_f32_16x16x32_bf16(ah, rbl1[S], acc1, 0, 0, 0); acc2 = __builtin_amdgcn_mfma_f32_16x16x32_bf16(ah, rbl2[S], acc2, 0, 0, 0); \
                acc0 = __builtin_amdgcn_mfma_f32_16x16x32_bf16(al, rbh0[S], acc0, 0, 0, 0); acc1 = __builtin_amdgcn_mfma_f32_16x16x32_bf16(al, rbh1[S], acc1, 0, 0, 0); acc2 = __builtin_amdgcn_mfma_f32_16x16x32_bf16(al, rbh2[S], acc2, 0, 0, 0); } while (0)
            RT_LD(0, 0);
#pragma unroll 1
            for (int c = 0; c < 16; c += 2) {
                RT_LD(1, c + 1);
                RT_DO(0, c);
                if (c + 2 < 16) RT_LD(0, c + 2);
                RT_DO(1, c + 1);
            }
#undef RT_LD
#undef RT_DO
            ss += __shfl_xor(ss, 16); ss += __shfl_xor(ss, 32);
            if (half == 1) {
#pragma unroll
                for (int i = 0; i < 4; ++i) { const int tk = 4 * kq + i; pl[tk * 48 + tok] = acc0[i]; pl[tk * 48 + 16 + tok] = acc1[i]; pl[tk * 48 + 32 + tok] = acc2[i]; }
                if (lane < 16) pl[768 + lane] = ss;
            }
        }
        __syncthreads();
        if (active && half == 0) {
            ss += pl[768 + tok];
            const float r = 1.0f / sqrtf(ss * (1.f / 1024.f) + RMS_EPS);
            rtok = r;
            const int col = lane & 15;
            const float bia0 = b_router[col], bia1 = b_router[16 + col], bia2 = (col < 4) ? b_group[col] : 0.f;
#pragma unroll
            for (int i = 0; i < 4; ++i) { const int tk = 4 * kq + i; const float rt = __shfl(r, tk);
                lg[tk * 48 + col] = (acc0[i] + pl[tk * 48 + col]) * rt + bia0; lg[tk * 48 + 16 + col] = (acc1[i] + pl[tk * 48 + 16 + col]) * rt + bia1; lg[tk * 48 + 32 + col] = (acc2[i] + pl[tk * 48 + 32 + col]) * rt + bia2; }
            LDS_WAIT(); asm volatile("" ::: "memory");
            if (lane < 16) {
                const LAS float* l = lg + lane * 48;
                int gs = 0; float gm = l[32];
#pragma unroll
                for (int j = 1; j < 4; ++j) { const float v = l[32 + j]; if (v > gm) { gm = v; gs = j; } }
                float gsum = 0.f;
#pragma unroll
                for (int j = 0; j < 4; ++j) gsum += expf(l[32 + j] - gm);
                const float ggate = 1.0f / gsum;
                const LAS float* el = l + gs * 8;
                float v0 = el[0]; int a0 = 0;
#pragma unroll
                for (int j = 1; j < 8; ++j) { const float v = el[j]; if (v > v0) { v0 = v; a0 = j; } }
                float v1 = -INFINITY; int a1 = 0;
#pragma unroll
                for (int j = 0; j < 8; ++j) { const float v = el[j]; if (j != a0 && v > v1) { v1 = v; a1 = j; } }
                const float p1 = expf(v1 - v0), ps = 1.0f + p1;
                e0 = gs * 8 + a0; e1 = gs * 8 + a1; wA = ggate / ps; wB = ggate * p1 / ps;
                r0 = __hip_atomic_fetch_add(lc + e0, 1u, __ATOMIC_RELAXED, __HIP_MEMORY_SCOPE_WORKGROUP);
                r1 = __hip_atomic_fetch_add(lc + e1, 1u, __ATOMIC_RELAXED, __HIP_MEMORY_SCOPE_WORKGROUP);
            }
        }
        __syncthreads();
        if (tid < 32) { const unsigned c = lc[tid]; lc[32 + tid] = c ? __hip_atomic_fetch_add(cnt + tid * 64, c, __ATOMIC_RELAXED, __HIP_MEMORY_SCOPE_AGENT) : 0u; }
        __syncthreads();
        if (active && half == 0 && lane < 16) {
            const unsigned pos0 = lc[32 + e0] + r0, pos1 = lc[32 + e1] + r1;
            v4u ti; ti.x = ((unsigned)e0 << 16) | pos0; ti.y = ((unsigned)e1 << 16) | pos1; ti.z = __builtin_bit_cast(unsigned, wA); ti.w = __builtin_bit_cast(unsigned, wB);
            *((v4u*)(ws + WS_TOKINFO) + m0 + lane) = ti;
            { int* EL = (int*)(ws + WS_EL); f32x2* EW = (f32x2*)(ws + WS_EW); EL[e0 * 16384 + pos0] = m0 + lane; EL[e1 * 16384 + pos1] = m0 + lane; EW[e0 * 16384 + pos0] = (f32x2){wA, rtok}; EW[e1 * 16384 + pos1] = (f32x2){wB, rtok}; }
        }
        __syncthreads();
    }
}
template <bool FINAL>
__device__ __forceinline__ void moe_combine(const Params& p, LAS unsigned char* L, float* H, const float* gain, int gw, int NGW, int lane) {
    unsigned char* ws = p.ws; const LAS int* seg = (const LAS int*)(L + MOE_T2E_OFF + 256);
    const bf16* YE = (const bf16*)(ws + WS_XG); bf16* U = (bf16*)(ws + WS_U);
    const f32x4* gr = (const f32x4*)gain + lane;
    for (int m0 = gw; m0 < NTOK / 2; m0 += NGW) {
        const int mA = m0, mB = m0 + NTOK / 2;
        const v2u tA = *((const v2u*)(ws + WS_TOKINFO) + 2 * mA), tB = *((const v2u*)(ws + WS_TOKINFO) + 2 * mB);
        const int rA0 = seg[tA.x >> 16] + (int)(tA.x & 0xffffu), rA1 = seg[tA.y >> 16] + (int)(tA.y & 0xffffu);
        const int rB0 = seg[tB.x >> 16] + (int)(tB.x & 0xffffu), rB1 = seg[tB.y >> 16] + (int)(tB.y & 0xffffu);
        f32x4* hA = (f32x4*)(H + (size_t)mA * 1024) + lane; f32x4* hB = (f32x4*)(H + (size_t)mB * 1024) + lane;
        const v2u* yA0 = (const v2u*)(YE + (size_t)rA0 * 1024) + lane; const v2u* yA1 = (const v2u*)(YE + (size_t)rA1 * 1024) + lane;
        const v2u* yB0 = (const v2u*)(YE + (size_t)rB0 * 1024) + lane; const v2u* yB1 = (const v2u*)(YE + (size_t)rB1 * 1024) + lane;
        f32x4 va[4], vb[4]; v2u a0[4], a1[4], b0[4], b1[4];
#pragma unroll
        for (int j = 0; j < 4; ++j) { va[j] = hA[64 * j]; vb[j] = hB[64 * j]; a0[j] = yA0[64 * j]; a1[j] = yA1[64 * j]; b0[j] = yB0[64 * j]; b1[j] = yB1[64 * j]; }
        float sa = 0.f, sb = 0.f;
#pragma unroll
        for (int j = 0; j < 4; ++j) {
            va[j].x += bflo(a0[j].x) + bflo(a1[j].x); va[j].y += bfhi(a0[j].x) + bfhi(a1[j].x); va[j].z += bflo(a0[j].y) + bflo(a1[j].y); va[j].w += bfhi(a0[j].y) + bfhi(a1[j].y);
            vb[j].x += bflo(b0[j].x) + bflo(b1[j].x); vb[j].y += bfhi(b0[j].x) + bfhi(b1[j].x); vb[j].z += bflo(b0[j].y) + bflo(b1[j].y); vb[j].w += bfhi(b0[j].y) + bfhi(b1[j].y);
            sa += (va[j].x * va[j].x + va[j].y * va[j].y) + (va[j].z * va[j].z + va[j].w * va[j].w);
            sb += (vb[j].x * vb[j].x + vb[j].y * vb[j].y) + (vb[j].z * vb[j].z + vb[j].w * vb[j].w); }
#pragma unroll
        for (int o = 1; o < 64; o <<= 1) { sa += __shfl_xor(sa, o); sb += __shfl_xor(sb, o); }
        const float ra = 1.0f / sqrtf(sa * (1.f / 1024.f) + RMS_EPS), rb = 1.0f / sqrtf(sb * (1.f / 1024.f) + RMS_EPS);
        if (FINAL) {
#pragma unroll
            for (int j = 0; j < 4; ++j) { const f32x4 g = gr[64 * j];
                hA[64 * j] = (f32x4){va[j].x * ra * g.x, va[j].y * ra * g.y, va[j].z * ra * g.z, va[j].w * ra * g.w};
                hB[64 * j] = (f32x4){vb[j].x * rb * g.x, vb[j].y * rb * g.y, vb[j].z * rb * g.z, vb[j].w * rb * g.w}; }
        } else {
            unsigned long long* oA = (unsigned long long*)(U + (size_t)mA * 1024) + lane; unsigned long long* oB = (unsigned long long*)(U + (size_t)mB * 1024) + lane;
#pragma unroll
            for (int j = 0; j < 4; ++j) { const f32x4 g = gr[64 * j]; hA[64 * j] = va[j]; hB[64 * j] = vb[j];
                oA[64 * j] = (unsigned long long)pk2(va[j].x * ra * g.x, va[j].y * ra * g.y) | ((unsigned long long)pk2(va[j].z * ra * g.z, va[j].w * ra * g.w) << 32);
                oB[64 * j] = (unsigned long long)pk2(vb[j].x * rb * g.x, vb[j].y * rb * g.y) | ((unsigned long long)pk2(vb[j].z * rb * g.z, vb[j].w * rb * g.w) << 32); }
        }
    }
}
__device__ __forceinline__ int mbl_off(int n) { return 256 * (31 * n - (n * (n - 1)) / 2); }
constexpr int MBL_PER_BH = 256 * 496;
__global__ void __launch_bounds__(NWAVES * 64, 2) mega(Params p) {
    extern __shared__ __attribute__((aligned(16))) unsigned char lds[];
    LAS unsigned char* L = (LAS unsigned char*)lds;
    const int tid = threadIdx.x, lane = tid & 63, wave = __builtin_amdgcn_readfirstlane(tid >> 6);
    const int G = gridDim.x, bx = blockIdx.x;
    const int vcu = (G % 8 == 0) ? (bx % 8) * (G / 8) + bx / 8 : bx;
    unsigned char* ws = p.ws;
    volatile LAS unsigned* MISC = (volatile LAS unsigned*)(L + MISC_OFF);
    if (tid < 32) MISC[tid] = 0u;
    __syncthreads();
    XcdBarrier bar = xcd_barrier_post((unsigned*)(ws + WS_CTL) + CW_BAR + p.li * XCD_BAR_WORDS, MISC + 8);
    const int lo = p.ph_lo, hi = p.ph_hi;
#define IN(k) (lo <= (k) && (k) < hi)
#define BOTH(k) (IN(k) && IN((k) + 1))
    const int gw = vcu * NWAVES + wave, NGW = G * NWAVES, gtid = vcu * (NWAVES * 64) + tid, NGT = G * NWAVES * 64;

    if (IN(0)) for (int rep = 0; rep < REPS[0]; ++rep) { p0_prologue(p, L, gw, NGW, lane, wave, gtid, NGT); if (BOTH(0) && rep == REPS[0] - 1) xcd_barrier(bar); }

    if (IN(1)) for (int rep = 0; rep < REPS[1]; ++rep) {
        pg8::Gemm g{(const pg8::bf16_t*)(ws + WS_U), (const pg8::bf16_t*)(ws + WS_WINE), NTOK, 1280, 1024};
        pg8::StaticOrder S; S.init(NTOK, 1280, G, bx);
        EpiStore E{(bf16*)(ws + WS_PROJ0), 1280, -1};
        pg8::gemm_phase<EpiStore, pg8::StaticOrder, true, true>(L + RING_OFF, g, S, E);
        { const int total = (NTOK / 256) * 5, rem = total % G, nidle = rem ? G - rem : G;
          if (rep == 0 && bx >= (rem ? rem : 0)) { __syncthreads(); moe_convert(p, L, 0, (bx - rem) * NWAVES + wave, nidle * NWAVES, lane, wave); } }
        if (BOTH(1) && rep == REPS[1] - 1) xcd_barrier(bar);
    }

    if (IN(2)) for (int rep = 0; rep < REPS[2]; ++rep) {
        const bf16* P0 = (const bf16*)(ws + WS_PROJ0); bf16* CQN = (bf16*)(ws + WS_CQN); bf16* CKVN = (bf16*)(ws + WS_CKVN); bf16* KR = (bf16*)(ws + WS_KR);
        const f32x2* rope = (const f32x2*)(ws + WS_ROPE);
        const f32x4 gq = *((const f32x4*)p.in[6] + lane); const f32x2 gkv = *((const f32x2*)p.in[7] + lane);
        for (int m = gw; m < NTOK; m += NGW) {
            const bf16* pr = P0 + (size_t)m * 1280;
            const v2u w = *(const v2u*)(pr + lane * 4); const unsigned w1 = *(const unsigned*)(pr + 256 + lane * 2);
            const float c0 = bflo(w.x), c1 = bfhi(w.x), c2 = bflo(w.y), c3 = bfhi(w.y), k0 = bflo(w1), k1 = bfhi(w1);
            const float r = 1.0f / sqrtf(wsum((c0 * c0 + c1 * c1) + (c2 * c2 + c3 * c3)) * (1.f / 256.f) + RMS_EPS);
            const float r2 = 1.0f / sqrtf(wsum(k0 * k0 + k1 * k1) * (1.f / 128.f) + RMS_EPS);
            v2u o; o.x = pk2(c0 * r * gq.x, c1 * r * gq.y); o.y = pk2(c2 * r * gq.z, c3 * r * gq.w);
            *(v2u*)(CQN + (size_t)m * 256 + lane * 4) = o;
            *(unsigned*)(CKVN + (size_t)m * 128 + lane * 2) = pk2(k0 * r2 * gkv.x, k1 * r2 * gkv.y);
            if (lane < 16) { const float x1 = bf2f(pr[384 + lane]), x2 = bf2f(pr[400 + lane]); const f32x2 cs = rope[(size_t)(m & 8191) * 16 + lane];
                KR[(size_t)m * 32 + lane] = (bf16)f2bf(x1 * cs.x - x2 * cs.y); KR[(size_t)m * 32 + 16 + lane] = (bf16)f2bf(x2 * cs.x + x1 * cs.y); }
        }
        if (BOTH(2) && rep == REPS[2] - 1) xcd_barrier(bar);
    }

    if (IN(3)) for (int rep = 0; rep < REPS[3]; ++rep) {
        { pg8::Gemm g{(const pg8::bf16_t*)(ws + WS_CQN), (const pg8::bf16_t*)(ws + WS_WQB), NTOK, 768, 256};
          pg8::StaticOrder S; S.init(NTOK, 768, G, bx);
          EpiStore E{(bf16*)(ws + WS_Q), 768, -1};
          pg8::gemm_phase<EpiStore, pg8::StaticOrder, false, true>(L + RING_OFF, g, S, E); }
        { pg8::Gemm g{(const pg8::bf16_t*)(ws + WS_CKVN), (const pg8::bf16_t*)(ws + WS_WKVB), NTOK, 1024, 128};
          pg8::StaticOrder S; S.init(NTOK, 1024, G, bx);
          EpiStore E{(bf16*)(ws + WS_KVB), 1024, -1};
          pg8::gemm_phase<EpiStore, pg8::StaticOrder, false, true>(L + RING_OFF, g, S, E); }
        if (BOTH(3) && rep == REPS[3] - 1) xcd_barrier(bar);
    }

    if (IN(4)) for (int rep = 0; rep < REPS[4]; ++rep) {
        const bf16* Qb = (const bf16*)(ws + WS_Q); const bf16* KVB = (const bf16*)(ws + WS_KVB); const bf16* KR = (const bf16*)(ws + WS_KR); const bf16* P0 = (const bf16*)(ws + WS_PROJ0);
        bf16* MIX = (bf16*)(ws + WS_U); const MobaArgs mb0{};
        { const float* BT = (const float*)(ws + WS_BIAS); LAS float* tb = (LAS float*)(L + ABIAS_OFF);
          for (int i = tid; i < 8 * 320; i += NWAVES * 64) { const int h = i / 320, d = (i % 320) - 64; tb[i] = (d >= 0 && d < 128) ? BT[h * 8192 + d] : 0.f; } }
        __syncthreads();
        for (int pi = vcu; pi < 256; pi += G) {
            const int bh = pi >> 4, s = pi & 15, b = bh >> 3, h = bh & 7;
#pragma unroll 1
            for (int ui = 0; ui < 2; ++ui) {
                const int qb = ui ? s : 31 - s, q0u = qb * 256, q0w = q0u + 32 * wave; const size_t r0 = (size_t)b * T_;
                AttnPtrs a; a.Q = Qb + (r0 + q0w) * 768 + h * 96; a.qs = 768; a.K = KVB + r0 * 1024 + h * 128; a.ks = 1024; a.K2 = KR + r0 * 32;
                a.V = KVB + r0 * 1024 + h * 128 + 64; a.vs = 1024; a.O = MIX + (r0 + q0w) * 1024 + h * 64;
                attn_unit<AM_MLA>(L, a, q0u, q0w, 0, (q0u + 255) >> 6, 0.10206207261596575f * LOG2E, 0.f, mb0, 0, (const f32x2*)(ws + WS_ROPE), tid, lane, wave);
            }
        }
        for (int id = vcu; id < 512; id += G) {
            const int b = id >> 8, hkv = (id >> 7) & 1, qt = id & 127, q0u = qt * 64, hq = 4 * hkv + (wave >> 1), q0w = q0u + 32 * (wave & 1); const size_t r0 = (size_t)b * T_;
            AttnPtrs a; a.Q = P0 + (r0 + q0w) * 1280 + 416 + hq * 64; a.qs = 1280; a.K = P0 + r0 * 1280 + 928 + hkv * 64; a.ks = 1280; a.K2 = nullptr;
            a.V = P0 + r0 * 1280 + 1056 + hkv * 64; a.vs = 1280; a.O = MIX + (r0 + q0w) * 1024 + 512 + hq * 64;
            attn_unit<AM_SWA>(L, a, q0u, q0w, qt >= 2 ? qt - 2 : 0, qt, 0.125f * LOG2E, p.in[10][hq] * LOG2E, mb0, hq * 320, nullptr, tid, lane, wave);
        }
        __syncthreads();
        if (BOTH(4) && rep == REPS[4] - 1) xcd_barrier(bar);
    }

    if (IN(5)) for (int rep = 0; rep < REPS[5]; ++rep) {
        pg8::Gemm g{(const pg8::bf16_t*)(ws + WS_U), (const pg8::bf16_t*)(ws + WS_WOE), NTOK, 1024, 1024};
        pg8::StaticOrder S; S.init(NTOK, 1024, G, bx);
        EpiResid E{p.in[0], p.out};
        pg8::gemm_phase<EpiResid, pg8::StaticOrder, false, true>(L + RING_OFF, g, S, E);
        if (BOTH(5) && rep == REPS[5] - 1) xcd_barrier(bar);
    }

    if (IN(6)) { moe_route(p, L, 0, p.out, gw, NGW, lane, wave); if (BOTH(6)) xcd_barrier(bar); }
    if (IN(8)) {
        int nt, nfull; moe_tables<true>(p, L, 0, tid, G, nt, nfull);
        unsigned* hcnt = (unsigned*)(ws + WS_CTL) + CW_HCNT + 0 * 160 * 16;
        const int total1 = nfull * 2, rem = total1 % G, q = ((int)bx + G - rem) % G;
        { pg8::Gemm g{(const pg8::bf16_t*)(ws + WS_U), (const pg8::bf16_t*)(ws + WS_MOEW), nt * 256, 32 * 512, 1024};
          MoeOrderG<2> S{total1, G, bx, L + MOE_T2E_OFF, (const LAS int*)(L + MOE_T2E_OFF + 256), (const LAS int*)(L + MOE_T2E_OFF + 512), (const int*)(ws + WS_EL), hcnt, L + MOE_T2E_OFF + 640};
          EpiSwiGLU E{(bf16*)(ws + WS_HH), (const f32x2*)(ws + WS_EW), L + MOE_T2E_OFF, (const LAS int*)(L + MOE_T2E_OFF + 256)};
          pg8::gemm_phase_g<EpiSwiGLU, MoeOrderG<2>, false, true>(L + RING_OFF, g, S, E); }
        __syncthreads();
        moe_tail_units(p, L, (const bf16*)(ws + WS_MOEW), hcnt, nfull, nt, q, G, tid, lane, wave);
        { const int ntu = (nt - nfull) * 16, nw = (ntu <= G - 64) ? G - ntu : G, r = (ntu <= G - 64) ? q - ntu : q;
          if (r >= 0) { __syncthreads(); moe_convert(p, L, 1, r * NWAVES + wave, nw * NWAVES, lane, wave); __syncthreads(); } }
        { pg8::Gemm g{(const pg8::bf16_t*)(ws + WS_HH), (const pg8::bf16_t*)(ws + WS_MOEW + 32 * MiB), nt * 256, 32 * 1024, 256};
          MoeOrderD<4> S{nt * 4, L + MOE_T2E_OFF, L + MOE_T2E_OFF + 640, hcnt, (unsigned*)(ws + WS_CTL) + CW_TICK + 0 * 64, (LAS unsigned*)(L + MOE_T2E_OFF + 804)};
          EpiStore E{(bf16*)(ws + WS_XG), 1024, 3};
          pg8::gemm_phase<EpiStore, MoeOrderD<4>, false, true>(L + RING_OFF, g, S, E); }
        if (BOTH(8)) xcd_barrier(bar);
    }
    if (IN(10)) { int nt, nfl; moe_tables<false>(p, L, 0, tid, G, nt, nfl); moe_combine<false>(p, L, p.out, p.in[1] + 1024, gw, NGW, lane); __syncthreads(); if (BOTH(10)) xcd_barrier(bar); }

    if (IN(11)) for (int rep = 0; rep < REPS[11]; ++rep) {
        pg8::Gemm g{(const pg8::bf16_t*)(ws + WS_U), (const pg8::bf16_t*)(ws + WS_WINO), NTOK, 3072, 1024};
        pg8::StaticOrder S; S.init(NTOK, 3072, G, bx);
        EpiStore E{(bf16*)(ws + WS_PROJ1), 3072, -1};
        pg8::gemm_phase<EpiStore, pg8::StaticOrder, true, true>(L + RING_OFF, g, S, E);
        if (BOTH(11) && rep == REPS[11] - 1) xcd_barrier(bar);
    }
    if (IN(12)) for (int rep = 0; rep < REPS[12]; ++rep) {
        const bf16* P1 = (const bf16*)(ws + WS_PROJ1); float* KM = (float*)(ws + WS_KMEAN);
        LAS float* part = (LAS float*)L;
        for (int id = vcu; id < 64; id += G) { const int b = id >> 5, n = id & 31;
            const bf16* kp = P1 + ((size_t)b * T_ + n * 256 + wave * 32) * 3072 + 512 + lane * 8;
            float acc[8] = {0.f, 0.f, 0.f, 0.f, 0.f, 0.f, 0.f, 0.f};
#pragma unroll 8
            for (int j = 0; j < 32; ++j) { const v4u w = *(const v4u*)(kp + (size_t)j * 3072);
                acc[0] += bflo(w.x); acc[1] += bfhi(w.x); acc[2] += bflo(w.y); acc[3] += bfhi(w.y); acc[4] += bflo(w.z); acc[5] += bfhi(w.z); acc[6] += bflo(w.w); acc[7] += bfhi(w.w); }
            __syncthreads();
#pragma unroll
            for (int j = 0; j < 8; ++j) part[wave * 512 + lane * 8 + j] = acc[j];
            __syncthreads();
            { const int c = tid;
              float s = 0.f;
#pragma unroll
              for (int w = 0; w < 8; ++w) s += part[w * 512 + c];
              KM[((size_t)(b * 8 + (c >> 6)) * 32 + n) * 64 + (c & 63)] = s * (1.0f / 256.f); }
        }
        __syncthreads();
        if (BOTH(12) && rep == REPS[12] - 1) xcd_barrier(bar);
    }
    if (IN(13)) {
        const bf16* P1 = (const bf16*)(ws + WS_PROJ1); const float* KM = (const float*)(ws + WS_KMEAN);
        unsigned* mcnt = (unsigned*)(ws + WS_CTL) + CW_MBCNT; unsigned* LIST = (unsigned*)(ws + WS_MBLIST);
        LAS float* kml = (LAS float*)L;
        LAS unsigned char* qst = L + 16384 + wave * 9216;
        int bhc = -1;
        for (int id = gw; id < 2048; id += NGW) {
            const int bh = id >> 7, qc = id & 127, b = bh >> 3, h = bh & 7, q = qc * 64 + lane, own = (qc * 64) >> 8;
            if (bh != bhc) { __syncthreads(); *(LAS f32x4*)(kml + (tid >> 4) * 68 + (tid & 15) * 4) = *(const f32x4*)(KM + (size_t)bh * 2048 + tid * 4); bhc = bh; __syncthreads(); }
            { const bf16* qb = P1 + ((size_t)b * T_ + qc * 64) * 3072 + h * 64; v4u t[8];
#pragma unroll
              for (int j = 0; j < 8; ++j) t[j] = *(const v4u*)(qb + (size_t)(8 * j + (lane >> 3)) * 3072 + (lane & 7) * 8);
#pragma unroll
              for (int j = 0; j < 8; ++j) *(LAS v4u*)(qst + (8 * j + (lane >> 3)) * 144 + (lane & 7) * 16) = t[j]; }
            const int ql = lane & 31, hf = lane >> 5;
            f32x16 sc[2]; sc[0] = f32x16{}; sc[1] = f32x16{};
#pragma unroll
            for (int ks = 0; ks < 4; ++ks) {
                const f32x4 x0 = *(const LAS f32x4*)(kml + ql * 68 + ks * 16 + hf * 8), x1 = *(const LAS f32x4*)(kml + ql * 68 + ks * 16 + hf * 8 + 4);
                const float xv[8] = {x0.x, x0.y, x0.z, x0.w, x1.x, x1.y, x1.z, x1.w};
                unsigned hb[8], lb[8];
#pragma unroll
                for (int j = 0; j < 8; ++j) { hb[j] = f2bf(xv[j]); lb[j] = f2bf(xv[j] - bf2f((unsigned short)hb[j])); }
                const bf16x8 ahi = __builtin_bit_cast(bf16x8, (v4u){hb[0] | (hb[1] << 16), hb[2] | (hb[3] << 16), hb[4] | (hb[5] << 16), hb[6] | (hb[7] << 16)});
                const bf16x8 alo = __builtin_bit_cast(bf16x8, (v4u){lb[0] | (lb[1] << 16), lb[2] | (lb[3] << 16), lb[4] | (lb[5] << 16), lb[6] | (lb[7] << 16)});
#pragma unroll
                for (int t = 0; t < 2; ++t) { const bf16x8 bq = *(const LAS bf16x8*)(qst + (t * 32 + ql) * 144 + ks * 32 + hf * 16);
                    sc[t] = __builtin_amdgcn_mfma_f32_32x32x16_bf16(ahi, bq, sc[t], 0, 0, 0);
                    sc[t] = __builtin_amdgcn_mfma_f32_32x32x16_bf16(alo, bq, sc[t], 0, 0, 0); }
            }
            float b0 = -INFINITY, b1 = -INFINITY, b2 = -INFINITY; int i0 = -1, i1 = -1, i2 = -1;
#pragma unroll
            for (int t = 0; t < 2; ++t) {
                float c0 = -INFINITY, c1 = -INFINITY, c2 = -INFINITY; int j0 = -1, j1 = -1, j2 = -1;
#pragma unroll
                for (int r = 0; r < 16; ++r) { const int n = crow(r, hf); const float g = sc[t][r];
                    if (n < own) {
                        if (g > c0) { c2 = c1; j2 = j1; c1 = c0; j1 = j0; c0 = g; j0 = n; }
                        else if (g > c1) { c2 = c1; j2 = j1; c1 = g; j1 = n; }
                        else if (g > c2) { c2 = g; j2 = n; } } }
                const float o0 = __shfl_xor(c0, 32), o1 = __shfl_xor(c1, 32), o2 = __shfl_xor(c2, 32); const int p0 = __shfl_xor(j0, 32), p1 = __shfl_xor(j1, 32), p2 = __shfl_xor(j2, 32);
#define MB_INS(G_, N_) do { const float g_ = (G_); const int n_ = (N_); \
                    if (n_ >= 0) { \
                        if (g_ > c0 || (g_ == c0 && n_ < j0)) { c2 = c1; j2 = j1; c1 = c0; j1 = j0; c0 = g_; j0 = n_; } \
                        else if (g_ > c1 || (g_ == c1 && n_ < j1)) { c2 = c1; j2 = j1; c1 = g_; j1 = n_; } \
                        else if (g_ > c2 || (g_ == c2 && n_ < j2)) { c2 = g_; j2 = n_; } } } while (0)
                MB_INS(o0, p0); MB_INS(o1, p1); MB_INS(o2, p2);
#undef MB_INS
                if (hf == t) { b0 = c0; b1 = c1; b2 = c2; i0 = j0; i1 = j1; i2 = j2; }
            }
            (void)b0; (void)b1; (void)b2;
            int mycnt = 0;
            for (int n = 0; n < own; ++n) { const unsigned long long mask = __ballot((i0 == n) || (i1 == n) || (i2 == n)); if (lane == n) mycnt = __builtin_popcountll(mask); }
            unsigned mybase = 0u;
            if (mycnt > 0) mybase = __hip_atomic_fetch_add(mcnt + (bh * 32 + lane) * 16, (unsigned)mycnt, __ATOMIC_RELAXED, __HIP_MEMORY_SCOPE_AGENT);
            for (int n = 0; n < own; ++n) {
                const int sl = (i0 == n) ? 0 : (i1 == n) ? 1 : (i2 == n) ? 2 : -1;
                const unsigned long long mask = __ballot(sl >= 0);
                const unsigned base = __shfl(mybase, n);
                if (sl >= 0) LIST[(size_t)bh * MBL_PER_BH + mbl_off(n) + base + (unsigned)__builtin_popcountll(mask & ((1ull << lane) - 1ull))] = (unsigned)q | ((unsigned)sl << 13);
            }
        }
        if (BOTH(13)) xcd_barrier(bar);
    }
    if (IN(14)) for (int rep = 0; rep < REPS[14]; ++rep) {
        const bf16* P1 = (const bf16*)(ws + WS_PROJ1); bf16* MIX = (bf16*)(ws + WS_U);
        const float* BT = (const float*)(ws + WS_BIAS);
        const unsigned* mcnt = (const unsigned*)(ws + WS_CTL) + CW_MBCNT; const unsigned* LIST = (const unsigned*)(ws + WS_MBLIST);
        LAS int* pre = (LAS int*)(L + UT_OFF); LAS int* cntL = pre + 513;
        __syncthreads();
        { const int c = (int)__hip_atomic_load(mcnt + tid * 16, __ATOMIC_RELAXED, __HIP_MEMORY_SCOPE_AGENT); cntL[tid] = c; pre[tid + 1] = (c + 255) >> 8; if (tid == 0) pre[0] = 0; }
        __syncthreads();
        if (tid < 64) {
            int v[8], sum = 0;
#pragma unroll
            for (int j = 0; j < 8; ++j) { v[j] = pre[1 + tid * 8 + j]; sum += v[j]; }
            int inc = sum;
#pragma unroll
            for (int o = 1; o < 64; o <<= 1) { const int x = __shfl_up(inc, o); if (tid >= o) inc += x; }
            int run = inc - sum;
#pragma unroll
            for (int j = 0; j < 8; ++j) { run += v[j]; pre[1 + tid * 8 + j] = run; }
        }
        __syncthreads();
        const int nchunks = pre[512], per = (nchunks + G - 1) / G;
        int hcur = -1;
        MobaArgs mb; mb.PARTO = (bf16*)(ws + WS_PARTO); mb.PARTML = (f32x2*)(ws + WS_PARTML);
        int icur = -1;
        for (int rc = 0; rc < REP_CH; ++rc)
        for (int u = vcu * per; u < (vcu + 1) * per && u < nchunks; ++u) {
            int lo = 0, hi_ = 512;
            while (hi_ - lo > 1) { const int mid = (lo + hi_) >> 1; if (pre[mid] <= u) lo = mid; else hi_ = mid; }
            const int i = __builtin_amdgcn_readfirstlane(lo), c = u - __builtin_amdgcn_readfirstlane(pre[lo]), bh = i >> 5, n = i & 31, b = bh >> 3, h = bh & 7, cn = __builtin_amdgcn_readfirstlane(cntL[i]);
            const size_t r0 = (size_t)b * T_;
            if (i != icur) {
                __syncthreads();
                moba_resident_load(L, P1 + (r0 + (size_t)n * 256) * 3072 + 512 + h * 64, P1 + (r0 + (size_t)n * 256) * 3072 + 1024 + h * 64, tid);
                if (h != hcur) { LAS float* tb = (LAS float*)(L + RB_OFF); for (int j = tid; j < 64 + 8192; j += NWAVES * 64) tb[j] = (j >= 64) ? BT[h * 8192 + (j - 64)] : 0.f; hcur = h; }
                icur = i;
                __syncthreads();
            }
            if ((c * 256 + 32 * wave) < cn) {
                const int e = c * 256 + 32 * wave + (lane & 31); const bool valid = e < cn; const unsigned ent = LIST[(size_t)bh * MBL_PER_BH + mbl_off(n) + (valid ? e : cn - 1)];
                moba_resident_wave(L, P1 + r0 * 3072 + h * 64, n, (int)(ent & 8191u), (int)(ent >> 13), valid, bh * 8192, mb.PARTO, mb.PARTML, lane, wave);
            }
        }
        hcur = -1;
        for (int id = vcu; id < 512; id += G) {
            const int bh = id >> 5, qb = 31 - (id & 31), b = bh >> 3, h = bh & 7, q0u = qb * 256, q0w = q0u + 32 * wave; const size_t r0 = (size_t)b * T_;
            if (h != hcur) {
                __syncthreads();
                LAS float* tb = (LAS float*)(L + ABIAS_OFF);
                for (int j = tid; j < 64 + 512; j += NWAVES * 64) tb[j] = (j >= 64) ? BT[h * 8192 + (j - 64)] : 0.f;
                hcur = h;
                __syncthreads();
            }
            mb.q = 0; mb.slot = 3; mb.valid = true; mb.wvalid = true; mb.bhbase = bh * 8192;
            AttnPtrs a; a.Q = P1 + (r0 + q0w) * 3072 + h * 64; a.qs = 3072; a.K = P1 + r0 * 3072 + 512 + h * 64; a.ks = 3072; a.K2 = nullptr;
            a.V = P1 + r0 * 3072 + 1024 + h * 64; a.vs = 3072; a.O = MIX + (r0 + q0w) * 1024 + h * 64;
            attn_unit<AM_MOBAO>(L, a, q0u, q0w, 4 * qb, 4 * qb + 3, 0.125f * LOG2E, 0.f, mb, 0, nullptr, tid, lane, wave);
        }
        for (int id = vcu; id < 512; id += G) {
            const int bh = id >> 5, qb = 31 - (id & 31), b = bh >> 3, h = bh & 7, q0u = qb * 256, q0w = q0u + 32 * wave; const size_t r0 = (size_t)b * T_;
            AttnPtrs a; a.Q = P1 + (r0 + q0w) * 3072 + 1536 + h * 64; a.qs = 3072; a.K = P1 + r0 * 3072 + 2048 + h * 64; a.ks = 3072; a.K2 = nullptr;
            a.V = P1 + r0 * 3072 + 2560 + h * 64; a.vs = 3072; a.O = MIX + (r0 + q0w) * 1024 + 512 + h * 64;
            attn_unit<AM_SB>(L, a, q0u, q0w, 0, (q0u + 255) >> 6, 0.125f * LOG2E, 0.f, mb, 0, nullptr, tid, lane, wave);
        }
        __syncthreads();
        if (BOTH(14) && rep == REPS[14] - 1) xcd_barrier(bar);
    }
    if (IN(15)) for (int rep = 0; rep < REPS[15]; ++rep) {
        bf16* MIX = (bf16*)(ws + WS_U); const bf16* PARTO = (const bf16*)(ws + WS_PARTO); const f32x4* PML = (const f32x4*)(ws + WS_PARTML);
        const int h = lane >> 3, d8 = (lane & 7) * 8;
        if (rep == 0) for (int m0_ = gw; m0_ < NTOK; m0_ += 2 * NGW) {
            f32x4 ml01[2], ml23[2]; v4u vo[2], v0[2], v1[2], v2[2]; int bq[2];
#pragma unroll
            for (int u = 0; u < 2; ++u) { const int m = m0_ + u * NGW < NTOK ? m0_ + u * NGW : m0_; const int b = m >> 13, q = m & 8191; bq[u] = ((b * 8 + h) * 8192 + q);
                ml01[u] = PML[(size_t)bq[u] * 2]; ml23[u] = PML[(size_t)bq[u] * 2 + 1];
                vo[u] = *(const v4u*)(MIX + (size_t)m * 1024 + h * 64 + d8);
                const v4u* pp = (const v4u*)(PARTO + (size_t)bq[u] * 3 * 64 + d8); v0[u] = pp[0]; v1[u] = pp[8]; v2[u] = pp[16]; }
#pragma unroll
            for (int u = 0; u < 2; ++u) { const int m = m0_ + u * NGW; if (m < NTOK) {
                const int q = m & 8191, nsel = (q >> 8) < 3 ? (q >> 8) : 3;
                const float m0 = nsel > 0 ? ml01[u].x : NEGBIG, m1 = nsel > 1 ? ml01[u].z : NEGBIG, m2 = nsel > 2 ? ml23[u].x : NEGBIG, mo = ml23[u].z;
                const float M = fmaxf(fmaxf(m0, m1), fmaxf(m2, mo));
                const float w0 = __builtin_amdgcn_exp2f(m0 - M), w1 = __builtin_amdgcn_exp2f(m1 - M), w2 = __builtin_amdgcn_exp2f(m2 - M), wo = __builtin_amdgcn_exp2f(mo - M);
                const float invL = 1.0f / (wo * ml23[u].w + (nsel > 0 ? w0 * ml01[u].y : 0.f) + (nsel > 1 ? w1 * ml01[u].w : 0.f) + (nsel > 2 ? w2 * ml23[u].y : 0.f));
                float acc[8]; const float co = wo * invL;
                { const v4u v = vo[u]; acc[0] = bflo(v.x) * co; acc[1] = bfhi(v.x) * co; acc[2] = bflo(v.y) * co; acc[3] = bfhi(v.y) * co; acc[4] = bflo(v.z) * co; acc[5] = bfhi(v.z) * co; acc[6] = bflo(v.w) * co; acc[7] = bfhi(v.w) * co; }
                if (nsel > 0) { const v4u v = v0[u]; const float c = w0 * invL; acc[0] += bflo(v.x) * c; acc[1] += bfhi(v.x) * c; acc[2] += bflo(v.y) * c; acc[3] += bfhi(v.y) * c; acc[4] += bflo(v.z) * c; acc[5] += bfhi(v.z) * c; acc[6] += bflo(v.w) * c; acc[7] += bfhi(v.w) * c; }
                if (nsel > 1) { const v4u v = v1[u]; const float c = w1 * invL; acc[0] += bflo(v.x) * c; acc[1] += bfhi(v.x) * c; acc[2] += bflo(v.y) * c; acc[3] += bfhi(v.y) * c; acc[4] += bflo(v.z) * c; acc[5] += bfhi(v.z) * c; acc[6] += bflo(v.w) * c; acc[7] += bfhi(v.w) * c; }
                if (nsel > 2) { const v4u v = v2[u]; const float c = w2 * invL; acc[0] += bflo(v.x) * c; acc[1] += bfhi(v.x) * c; acc[2] += bflo(v.y) * c; acc[3] += bfhi(v.y) * c; acc[4] += bflo(v.z) * c; acc[5] += bfhi(v.z) * c; acc[6] += bflo(v.w) * c; acc[7] += bfhi(v.w) * c; }
                *(v4u*)(MIX + (size_t)m * 1024 + h * 64 + d8) = (v4u){pk2(acc[0], acc[1]), pk2(acc[2], acc[3]), pk2(acc[4], acc[5]), pk2(acc[6], acc[7])}; } }
        }
        if (BOTH(15) && rep == REPS[15] - 1) xcd_barrier(bar);
    }
    if (IN(16)) {
        pg8::Gemm g{(const pg8::bf16_t*)(ws + WS_U), (const pg8::bf16_t*)(ws + WS_WOO), NTOK, 1024, 1024};
        pg8::StaticOrder S; S.init(NTOK, 1024, G, bx);
        EpiResid E{p.out, p.out};
        pg8::gemm_phase<EpiResid, pg8::StaticOrder, false, true>(L + RING_OFF, g, S, E);
        if (BOTH(16)) xcd_barrier(bar);
    }
    if (IN(17)) { moe_route(p, L, 1, p.out, gw, NGW, lane, wave); if (BOTH(17)) xcd_barrier(bar); }
    if (IN(19)) {
        int nt, nfull; moe_tables<true>(p, L, 1, tid, G, nt, nfull);
        unsigned* hcnt = (unsigned*)(ws + WS_CTL) + CW_HCNT + 1 * 160 * 16;
        const int total1 = nfull * 2, rem = total1 % G, q = ((int)bx + G - rem) % G;
        { pg8::Gemm g{(const pg8::bf16_t*)(ws + WS_U), (const pg8::bf16_t*)(ws + WS_MOEW + 48 * MiB), nt * 256, 32 * 512, 1024};
          MoeOrderG<2> S{total1, G, bx, L + MOE_T2E_OFF, (const LAS int*)(L + MOE_T2E_OFF + 256), (const LAS int*)(L + MOE_T2E_OFF + 512), (const int*)(ws + WS_EL), hcnt, L + MOE_T2E_OFF + 640};
          EpiSwiGLU E{(bf16*)(ws + WS_HH), (const f32x2*)(ws + WS_EW), L + MOE_T2E_OFF, (const LAS int*)(L + MOE_T2E_OFF + 256)};
          pg8::gemm_phase_g<EpiSwiGLU, MoeOrderG<2>, false, true>(L + RING_OFF, g, S, E); }
        __syncthreads();
        moe_tail_units(p, L, (const bf16*)(ws + WS_MOEW + 48 * MiB), hcnt, nfull, nt, q, G, tid, lane, wave);
        { pg8::Gemm g{(const pg8::bf16_t*)(ws + WS_HH), (const pg8::bf16_t*)(ws + WS_MOEW + 80 * MiB), nt * 256, 32 * 1024, 256};
          MoeOrderD<4> S{nt * 4, L + MOE_T2E_OFF, L + MOE_T2E_OFF + 640, hcnt, (unsigned*)(ws + WS_CTL) + CW_TICK + 1 * 64, (LAS unsigned*)(L + MOE_T2E_OFF + 804)};
          EpiStore E{(bf16*)(ws + WS_XG), 1024, 3};
          pg8::gemm_phase<EpiStore, MoeOrderD<4>, false, true>(L + RING_OFF, g, S, E); }
        if (BOTH(19)) xcd_barrier(bar);
    }
    if (IN(21)) { int nt, nfl; moe_tables<false>(p, L, 1, tid, G, nt, nfl); moe_combine<true>(p, L, p.out, p.in[3], gw, NGW, lane); }
#undef IN
#undef BOTH
}
extern "C" void kernel_launch(void* const* d_in, const int* in_sizes, int n_in, void* d_out, int out_size, void* d_ws, size_t ws_size, hipStream_t stream) {
    static int grid = 0;
    if (grid == 0) {
        int dev = 0, cus = 0;
        if (n_in != 21 || in_sizes[0] != NTOK * DM || out_size != NTOK * DM || ws_size < 282 * MiB) { fprintf(stderr, "kernel_launch: unexpected n_in %d / sizes / ws_size %zu; nothing launched\n", n_in, ws_size); grid = -1; return; }
        if (hipGetDevice(&dev) != hipSuccess || hipDeviceGetAttribute(&cus, hipDeviceAttributeMultiprocessorCount, dev) != hipSuccess) { grid = -1; return; }
        if (hipFuncSetAttribute((const void*)mega, hipFuncAttributeMaxDynamicSharedMemorySize, LDS_BYTES) != hipSuccess) { fprintf(stderr, "kernel_launch: hipFuncSetAttribute failed\n"); grid = -1; return; }
        (void)hipGetLastError();
        grid = cus;
    }
    if (grid < 0) return;
    (void)hipMemsetAsync((char*)d_ws + WS_CTL, 0, CTL_ZERO_BYTES, stream);
    Params p{};
    for (int i = 0; i < 21; ++i) p.in[i] = (const float*)d_in[i];
    p.out = (float*)d_out; p.ws = (unsigned char*)d_ws; p.ph_lo = 0; p.ph_hi = 22; p.li = 0;
    hipLaunchKernelGGL(mega, dim3(grid), dim3(NWAVES * 64), LDS_BYTES, stream, p);
}
```

```cpp
#include <hip/hip_runtime.h>
#include <stdint.h>
#include <math.h>
#include <cstdio>

constexpr int NB = 2, T_ = 8192, DM = 1024, NTOK = NB * T_;
constexpr float RMS_EPS = 1e-6f;
#define GAS __attribute__((address_space(1)))
#define LAS __attribute__((address_space(3)))
namespace pg8 {
#define PG8_LAS __attribute__((address_space(3)))
typedef unsigned short bf16_t;
typedef short bf16x8 __attribute__((ext_vector_type(8)));
typedef float f32x4 __attribute__((ext_vector_type(4)));
typedef unsigned u32x4 __attribute__((ext_vector_type(4)));
constexpr int BM = 256, BK = 64, HALF = 128, HTB = HALF * BK * 2  , STAGE_BYTES = 8 * HTB, NXCD = 8, WGM = 8;

__host__ __device__ __forceinline__ int lds_byte(int r, int c) { const int st = (r >> 4) * 2 + (c >> 5), rr = r & 15, cc = c & 31, ob = rr * 64 + cc * 2; return st * 1024 + (ob ^ (((ob >> 9) & 1) << 5)); }
__host__ __device__ __forceinline__ void stage_rc(int b, int& R, int& C) { const int st = b / 1024, sb = b % 1024, swz = sb ^ (((sb >> 9) & 1) << 5); R = (st >> 1) * 16 + swz / 64; C = (st & 1) * 32 + (swz % 64) / 2; }
__host__ __device__ __forceinline__ int perm32(int rho) { const int n = rho >> 4, i = rho & 15; return 8 * (i >> 2) + 4 * n + (i & 3); }

struct Unit { int pm, pn; };
struct Gemm { const bf16_t* A; const bf16_t* Bt; int M, N, K; };

struct StaticOrder {
    int nM, nN, nwg, G, c;
    __host__ __device__ void init(int M, int N, int G_, int c_) { nM = M / BM; nN = N / BM; nwg = nM * nN; G = G_; c = c_; }
    __host__ __device__ bool next(int i, Unit& u) const {
        const long L = (long)i * G + c; if (L >= nwg) return false;
        int wgid = (int)L; { const int q = nwg / NXCD, r = nwg % NXCD, xcd = wgid % NXCD, off = wgid / NXCD; wgid = (xcd < r ? xcd * (q + 1) : r * (q + 1) + (xcd - r) * q) + off; }
        const int nig = WGM * nN, gid = wgid / nig, fm = gid * WGM, gsz = (nM - fm) < WGM ? (nM - fm) : WGM;
        u.pm = fm + ((wgid % nig) % gsz); u.pn = (wgid % nig) / gsz; return true;
    }
    __device__ __forceinline__ void a_ready(const Unit&) const {}
    __device__ __forceinline__ void done(const Unit&) const {}
};

__device__ __forceinline__ unsigned cvt_pk_bf16(float lo, float hi) { unsigned r; asm volatile("v_cvt_pk_bf16_f32 %0, %1, %2" : "=v"(r) : "v"(lo), "v"(hi)); return r; }
template <class Epi, class Sched, bool ALIGN_EPI = false, bool SP2 = false>
__device__ __forceinline__ void gemm_phase(PG8_LAS unsigned char* lds, const Gemm g, const Sched& S, const Epi& E) {
    const int tid = threadIdx.x, wid = __builtin_amdgcn_readfirstlane(tid >> 6), lane = tid & 63, wr = wid >> 2, wc = wid & 3, fr = lane & 15, fq = lane >> 4;
    const int K = g.K, nt = K / BK;
    unsigned voffA[2], voffB[2];
#pragma unroll
    for (int i = 0; i < 2; ++i) { int R, C; stage_rc(tid * 16 + i * 8192, R, C); const int Rb = Epi::PERM ? ((R & ~31) + perm32(R & 31)) : R;
        voffA[i] = (unsigned)(R * K + C) * 2u; voffB[i] = (unsigned)(Rb * K + C) * 2u; }
    const size_t kstep = (size_t)(BK * 2);
    const size_t hstep = (size_t)HALF * K * 2;
    const size_t tstep = 2 * hstep;
    const unsigned ldsw = (unsigned)wid * 1024u;
    const int aoff = lds_byte(wr * 64 + fr, fq * 8), boff = lds_byte(wc * 32 + fr, fq * 8);
#define PG8_SA(b, h) (((b) * 2 + (h)) * HTB)
#define PG8_SB(b, h) ((4 + (b) * 2 + (h)) * HTB)
#define PG8_STAGE(bufoff, gbase, voff) do { _Pragma("unroll") for (int _i = 0; _i < 2; ++_i) \
        __builtin_amdgcn_global_load_lds((const unsigned*)((const char*)(gbase) + (voff)[_i]), (PG8_LAS unsigned*)(lds + (bufoff) + ldsw + _i * 8192), 16, 0, 0); } while (0)
#define PG8_LDA(dst, b, h) do { _Pragma("unroll") for (int m = 0; m < 4; ++m) _Pragma("unroll") for (int k = 0; k < 2; ++k) dst[m][k] = *(const PG8_LAS bf16x8*)(lds + PG8_SA(b, h) + aoff + m * 2048 + k * 1024); } while (0)
#define PG8_LDB(dst, b, h) do { _Pragma("unroll") for (int n = 0; n < 2; ++n) _Pragma("unroll") for (int k = 0; k < 2; ++k) dst[n][k] = *(const PG8_LAS bf16x8*)(lds + PG8_SB(b, h) + boff + n * 2048 + k * 1024); } while (0)
#define PG8_MMA(ai, bj, At, Bt) do { __builtin_amdgcn_s_setprio(1); _Pragma("unroll") for (int m = 0; m < 4; ++m) _Pragma("unroll") for (int n = 0; n < 2; ++n) _Pragma("unroll") for (int k = 0; k < 2; ++k) \
        acc[ai][bj][m][n] = __builtin_amdgcn_mfma_f32_16x16x32_bf16(Bt[n][k], At[m][k], acc[ai][bj][m][n], 0, 0, 0); __builtin_amdgcn_s_setprio(0); } while (0)
#define PG8_WAIT_V(n) asm volatile("s_waitcnt vmcnt(" #n ")" ::: "memory")
#define PG8_WAIT_L(n) asm volatile("s_waitcnt lgkmcnt(" #n ")" ::: "memory")
#define PG8_BAR __builtin_amdgcn_s_barrier()
#define PG8_SCHED __builtin_amdgcn_sched_barrier(0)
    Unit cur, nxt; int ui = 0;
    if (!S.next(0, cur)) return;
    f32x4 acc[2][2][4][2];
#pragma unroll
    for (int a = 0; a < 2; ++a)
#pragma unroll
        for (int b = 0; b < 2; ++b)
#pragma unroll
            for (int m = 0; m < 4; ++m)
#pragma unroll
                for (int n = 0; n < 2; ++n) acc[a][b][m][n] = (f32x4){0.f, 0.f, 0.f, 0.f};
    bf16x8 At[4][2], B0[2][2], B1[2][2];
    const char* cA = (const char*)g.A + (size_t)cur.pm * tstep; const char* cB = (const char*)g.Bt + (size_t)cur.pn * tstep;
    S.a_ready(cur);
    if constexpr (SP2) {
        PG8_STAGE(PG8_SB(0, 0), cB, voffB); PG8_STAGE(PG8_SB(0, 1), cB + hstep, voffB); PG8_STAGE(PG8_SA(0, 0), cA, voffA); PG8_STAGE(PG8_SA(0, 1), cA + hstep, voffA);
        if (wr == 1) PG8_BAR;
        PG8_WAIT_V(2); PG8_BAR;
        PG8_STAGE(PG8_SB(1, 0), cB + kstep, voffB); PG8_STAGE(PG8_SA(1, 0), cA + kstep, voffA); PG8_STAGE(PG8_SB(1, 1), cB + hstep + kstep, voffB);
        PG8_WAIT_V(6); PG8_BAR;
    } else {
        PG8_STAGE(PG8_SB(0, 0), cB, voffB); PG8_STAGE(PG8_SA(0, 0), cA, voffA); PG8_STAGE(PG8_SB(0, 1), cB + hstep, voffB); PG8_STAGE(PG8_SA(0, 1), cA + hstep, voffA);
        if (wr == 1) PG8_BAR;
        PG8_WAIT_V(4); PG8_BAR;
        PG8_STAGE(PG8_SB(1, 0), cB + kstep, voffB); PG8_STAGE(PG8_SA(1, 0), cA + kstep, voffA); PG8_STAGE(PG8_SB(1, 1), cB + hstep + kstep, voffB);
        PG8_WAIT_V(6); PG8_BAR;
    }
    for (;;) {
        const bool has_next = S.next(ui + 1, nxt);
        const char* nA = has_next ? (const char*)g.A + (size_t)nxt.pm * tstep : cA; const char* nB = has_next ? (const char*)g.Bt + (size_t)nxt.pn * tstep : cB;
        for (int t = 0; t < nt; t += 2) {
            const bool last = (t == nt - 2);
            const char* a1 = cA + (size_t)(t + 1) * kstep;
            const char* a2 = last ? nA : cA + (size_t)(t + 2) * kstep; const char* b2 = last ? nB : cB + (size_t)(t + 2) * kstep;
            const char* a3 = a2 + kstep; const char* b3 = b2 + kstep;
            if (last && has_next) S.a_ready(nxt);
            if constexpr (SP2) {
            PG8_LDB(B0, 0, 0); PG8_LDB(B1, 0, 1); PG8_SCHED; PG8_LDA(At, 0, 0); PG8_STAGE(PG8_SA(1, 1), a1 + hstep, voffA);
            PG8_WAIT_V(8); PG8_WAIT_L(0); PG8_BAR; PG8_MMA(0, 0, At, B0); PG8_MMA(0, 1, At, B1); PG8_BAR; PG8_SCHED;
            PG8_LDA(At, 0, 1); PG8_STAGE(PG8_SB(0, 0), b2, voffB); PG8_STAGE(PG8_SB(0, 1), b2 + hstep, voffB); PG8_STAGE(PG8_SA(0, 0), a2, voffA);
            PG8_WAIT_V(8); PG8_WAIT_L(0); PG8_BAR; PG8_MMA(1, 0, At, B0); PG8_MMA(1, 1, At, B1); PG8_BAR; PG8_SCHED;
            PG8_LDB(B0, 1, 0); PG8_LDB(B1, 1, 1); PG8_SCHED; PG8_LDA(At, 1, 0); PG8_STAGE(PG8_SA(0, 1), a2 + hstep, voffA);
            PG8_WAIT_V(8); PG8_WAIT_L(0); PG8_BAR; PG8_MMA(0, 0, At, B0); PG8_MMA(0, 1, At, B1); PG8_BAR; PG8_SCHED;
            PG8_LDA(At, 1, 1); PG8_STAGE(PG8_SB(1, 0), b3, voffB); PG8_STAGE(PG8_SB(1, 1), b3 + hstep, voffB); PG8_STAGE(PG8_SA(1, 0), a3, voffA);
            PG8_WAIT_V(8); PG8_WAIT_L(0); PG8_BAR; PG8_MMA(1, 0, At, B0); PG8_MMA(1, 1, At, B1); PG8_BAR; PG8_SCHED;
            } else {
            PG8_LDB(B0, 0, 0); PG8_SCHED; PG8_LDA(At, 0, 0); PG8_STAGE(PG8_SA(1, 1), a1 + hstep, voffA);
            PG8_WAIT_L(8); PG8_BAR; PG8_WAIT_L(0); PG8_MMA(0, 0, At, B0); PG8_BAR; PG8_SCHED;
            PG8_LDB(B1, 0, 1); PG8_STAGE(PG8_SB(0, 0), b2, voffB);
            PG8_BAR; PG8_WAIT_L(0); PG8_MMA(0, 1, At, B1); PG8_BAR;
            PG8_LDA(At, 0, 1); PG8_STAGE(PG8_SA(0, 0), a2, voffA);
            PG8_BAR; PG8_WAIT_L(0); PG8_MMA(1, 0, At, B0); PG8_BAR; PG8_SCHED;
            PG8_STAGE(PG8_SB(0, 1), b2 + hstep, voffB);
            PG8_WAIT_V(6); PG8_BAR; PG8_MMA(1, 1, At, B1); PG8_BAR;
            PG8_LDB(B0, 1, 0); PG8_SCHED; PG8_LDA(At, 1, 0); PG8_STAGE(PG8_SA(0, 1), a2 + hstep, voffA);
            PG8_WAIT_L(8); PG8_BAR; PG8_WAIT_L(0); PG8_MMA(0, 0, At, B0); PG8_BAR; PG8_SCHED;
            PG8_LDB(B1, 1, 1); PG8_STAGE(PG8_SB(1, 0), b3, voffB);
            PG8_BAR; PG8_WAIT_L(0); PG8_MMA(0, 1, At, B1); PG8_BAR;
            PG8_LDA(At, 1, 1); PG8_STAGE(PG8_SA(1, 0), a3, voffA);
            PG8_BAR; PG8_WAIT_L(0); PG8_MMA(1, 0, At, B0); PG8_BAR; PG8_SCHED;
            PG8_STAGE(PG8_SB(1, 1), b3 + hstep, voffB);
            PG8_WAIT_V(6); PG8_BAR; PG8_MMA(1, 1, At, B1); PG8_BAR;
            }
        }
        if constexpr (ALIGN_EPI) { if (wr == 0) PG8_BAR; }
        if constexpr (!Epi::AFTER_DRAIN) { E(acc, cur, wr, wc, fr, fq); S.done(cur); }
        if (!has_next) break;
#pragma unroll
        for (int a = 0; a < 2; ++a)
#pragma unroll
            for (int b = 0; b < 2; ++b)
#pragma unroll
                for (int m = 0; m < 4; ++m)
#pragma unroll
                    for (int n = 0; n < 2; ++n) acc[a][b][m][n] = (f32x4){0.f, 0.f, 0.f, 0.f};
        cur = nxt; cA = nA; cB = nB; ++ui;
        if constexpr (ALIGN_EPI) { if (wr == 1) PG8_BAR; }
    }
    PG8_WAIT_V(0);
    if constexpr (!ALIGN_EPI) { if (wr == 0) PG8_BAR; }
    PG8_BAR;
    if constexpr (Epi::AFTER_DRAIN) { E.fused(acc, cur, wr, wc, fr, fq, lds, wid, lane); S.done(cur); }
#undef PG8_SA
#undef PG8_SB
#undef PG8_STAGE
#undef PG8_LDA
#undef PG8_LDB
#undef PG8_MMA
#undef PG8_WAIT_V
#undef PG8_WAIT_L
#undef PG8_BAR
#undef PG8_SCHED
}

template <class Epi, class Sched, bool ALIGN_EPI = false, bool SP2 = false>
__device__ __forceinline__ void gemm_phase_g(PG8_LAS unsigned char* lds, const Gemm g, const Sched& S, const Epi& E) {
    const int tid = threadIdx.x, wid = __builtin_amdgcn_readfirstlane(tid >> 6), lane = tid & 63, wr = wid >> 2, wc = wid & 3, fr = lane & 15, fq = lane >> 4;
    const int K = g.K, nt = K / BK;
    unsigned voffA[2], voffB[2]; int RA[2], CA[2]; (void)voffA;
#pragma unroll
    for (int i = 0; i < 2; ++i) { int R, C; stage_rc(tid * 16 + i * 8192, R, C); const int Rb = Epi::PERM ? ((R & ~31) + perm32(R & 31)) : R;
        voffA[i] = (unsigned)(R * K + C) * 2u; voffB[i] = (unsigned)(Rb * K + C) * 2u; RA[i] = R; CA[i] = C; }
    const size_t kstep = (size_t)(BK * 2);
    const size_t hstep = (size_t)HALF * K * 2;
    const size_t tstep = 2 * hstep;
    const unsigned ldsw = (unsigned)wid * 1024u;
    const int aoff = lds_byte(wr * 64 + fr, fq * 8), boff = lds_byte(wc * 32 + fr, fq * 8);
#define PG8_SA(b, h) (((b) * 2 + (h)) * HTB)
#define PG8_SB(b, h) ((4 + (b) * 2 + (h)) * HTB)
#define PG8_STAGE(bufoff, gbase, voff) do { _Pragma("unroll") for (int _i = 0; _i < 2; ++_i) \
        __builtin_amdgcn_global_load_lds((const unsigned*)((const char*)(gbase) + (voff)[_i]), (PG8_LAS unsigned*)(lds + (bufoff) + ldsw + _i * 8192), 16, 0, 0); } while (0)
#define PG8_LDA(dst, b, h) do { _Pragma("unroll") for (int m = 0; m < 4; ++m) _Pragma("unroll") for (int k = 0; k < 2; ++k) dst[m][k] = *(const PG8_LAS bf16x8*)(lds + PG8_SA(b, h) + aoff + m * 2048 + k * 1024); } while (0)
#define PG8_LDB(dst, b, h) do { _Pragma("unroll") for (int n = 0; n < 2; ++n) _Pragma("unroll") for (int k = 0; k < 2; ++k) dst[n][k] = *(const PG8_LAS bf16x8*)(lds + PG8_SB(b, h) + boff + n * 2048 + k * 1024); } while (0)
#define PG8_MMA(ai, bj, At, Bt) do { __builtin_amdgcn_s_setprio(1); _Pragma("unroll") for (int m = 0; m < 4; ++m) _Pragma("unroll") for (int n = 0; n < 2; ++n) _Pragma("unroll") for (int k = 0; k < 2; ++k) \
        acc[ai][bj][m][n] = __builtin_amdgcn_mfma_f32_16x16x32_bf16(Bt[n][k], At[m][k], acc[ai][bj][m][n], 0, 0, 0); __builtin_amdgcn_s_setprio(0); } while (0)
#define PG8_WAIT_V(n) asm volatile("s_waitcnt vmcnt(" #n ")" ::: "memory")
#define PG8_WAIT_L(n) asm volatile("s_waitcnt lgkmcnt(" #n ")" ::: "memory")
#define PG8_BAR __builtin_amdgcn_s_barrier()
#define PG8_SCHED __builtin_amdgcn_sched_barrier(0)
    Unit cur, nxt; int ui = 0;
    if (!S.next(0, cur)) return;
    f32x4 acc[2][2][4][2];
#pragma unroll
    for (int a = 0; a < 2; ++a)
#pragma unroll
        for (int b = 0; b < 2; ++b)
#pragma unroll
            for (int m = 0; m < 4; ++m)
#pragma unroll
                for (int n = 0; n < 2; ++n) acc[a][b][m][n] = (f32x4){0.f, 0.f, 0.f, 0.f};
    bf16x8 At[4][2], B0[2][2], B1[2][2];
    const char* cA = (const char*)g.A; const char* cB = (const char*)g.Bt + (size_t)cur.pn * tstep;
    unsigned gC[2][2], gN[2][2];
#pragma unroll
    for (int h = 0; h < 2; ++h)
#pragma unroll
        for (int i = 0; i < 2; ++i) gC[h][i] = S.goff(cur, h, RA[i], CA[i]);
    S.a_ready(cur);
    if constexpr (SP2) {
        PG8_STAGE(PG8_SB(0, 0), cB, voffB); PG8_STAGE(PG8_SB(0, 1), cB + hstep, voffB); PG8_STAGE(PG8_SA(0, 0), cA, gC[0]); PG8_STAGE(PG8_SA(0, 1), cA, gC[1]);
        if (wr == 1) PG8_BAR;
        PG8_WAIT_V(2); PG8_BAR;
        PG8_STAGE(PG8_SB(1, 0), cB + kstep, voffB); PG8_STAGE(PG8_SA(1, 0), cA + kstep, gC[0]); PG8_STAGE(PG8_SB(1, 1), cB + hstep + kstep, voffB);
        PG8_WAIT_V(6); PG8_BAR;
    } else {
        PG8_STAGE(PG8_SB(0, 0), cB, voffB); PG8_STAGE(PG8_SA(0, 0), cA, gC[0]); PG8_STAGE(PG8_SB(0, 1), cB + hstep, voffB); PG8_STAGE(PG8_SA(0, 1), cA, gC[1]);
        if (wr == 1) PG8_BAR;
        PG8_WAIT_V(4); PG8_BAR;
        PG8_STAGE(PG8_SB(1, 0), cB + kstep, voffB); PG8_STAGE(PG8_SA(1, 0), cA + kstep, gC[0]); PG8_STAGE(PG8_SB(1, 1), cB + hstep + kstep, voffB);
        PG8_WAIT_V(6); PG8_BAR;
    }
    for (;;) {
        const bool has_next = S.next(ui + 1, nxt);
        const char* nA = cA; const char* nB = has_next ? (const char*)g.Bt + (size_t)nxt.pn * tstep : cB;
#pragma unroll
        for (int h = 0; h < 2; ++h)
#pragma unroll
            for (int i = 0; i < 2; ++i) gN[h][i] = has_next ? S.goff(nxt, h, RA[i], CA[i]) : gC[h][i];
        for (int t = 0; t < nt; t += 2) {
            const bool last = (t == nt - 2);
            const char* a1 = cA + (size_t)(t + 1) * kstep;
            const char* a2 = last ? nA : cA + (size_t)(t + 2) * kstep; const char* b2 = last ? nB : cB + (size_t)(t + 2) * kstep;
            const char* a3 = a2 + kstep; const char* b3 = b2 + kstep;
            unsigned g0[2], g1[2]; g0[0] = last ? gN[0][0] : gC[0][0]; g0[1] = last ? gN[0][1] : gC[0][1]; g1[0] = last ? gN[1][0] : gC[1][0]; g1[1] = last ? gN[1][1] : gC[1][1];
            if (last && has_next) S.a_ready(nxt);
            if constexpr (SP2) {
            PG8_LDB(B0, 0, 0); PG8_LDB(B1, 0, 1); PG8_SCHED; PG8_LDA(At, 0, 0); PG8_STAGE(PG8_SA(1, 1), a1, gC[1]);
            PG8_WAIT_V(8); PG8_WAIT_L(0); PG8_BAR; PG8_MMA(0, 0, At, B0); PG8_MMA(0, 1, At, B1); PG8_BAR; PG8_SCHED;
            PG8_LDA(At, 0, 1); PG8_STAGE(PG8_SB(0, 0), b2, voffB); PG8_STAGE(PG8_SB(0, 1), b2 + hstep, voffB); PG8_STAGE(PG8_SA(0, 0), a2, g0);
            PG8_WAIT_V(8); PG8_WAIT_L(0); PG8_BAR; PG8_MMA(1, 0, At, B0); PG8_MMA(1, 1, At, B1); PG8_BAR; PG8_SCHED;
            PG8_LDB(B0, 1, 0); PG8_LDB(B1, 1, 1); PG8_SCHED; PG8_LDA(At, 1, 0); PG8_STAGE(PG8_SA(0, 1), a2, g1);
            PG8_WAIT_V(8); PG8_WAIT_L(0); PG8_BAR; PG8_MMA(0, 0, At, B0); PG8_MMA(0, 1, At, B1); PG8_BAR; PG8_SCHED;
            PG8_LDA(At, 1, 1); PG8_STAGE(PG8_SB(1, 0), b3, voffB); PG8_STAGE(PG8_SB(1, 1), b3 + hstep, voffB); PG8_STAGE(PG8_SA(1, 0), a3, g0);
            PG8_WAIT_V(8); PG8_WAIT_L(0); PG8_BAR; PG8_MMA(1, 0, At, B0); PG8_MMA(1, 1, At, B1); PG8_BAR; PG8_SCHED;
            } else {
            PG8_LDB(B0, 0, 0); PG8_SCHED; PG8_LDA(At, 0, 0); PG8_STAGE(PG8_SA(1, 1), a1, gC[1]);
            PG8_WAIT_L(8); PG8_BAR; PG8_WAIT_L(0); PG8_MMA(0, 0, At, B0); PG8_BAR; PG8_SCHED;
            PG8_LDB(B1, 0, 1); PG8_STAGE(PG8_SB(0, 0), b2, voffB);
            PG8_BAR; PG8_WAIT_L(0); PG8_MMA(0, 1, At, B1); PG8_BAR;
            PG8_LDA(At, 0, 1); PG8_STAGE(PG8_SA(0, 0), a2, g0);
            PG8_BAR; PG8_WAIT_L(0); PG8_MMA(1, 0, At, B0); PG8_BAR; PG8_SCHED;
            PG8_STAGE(PG8_SB(0, 1), b2 + hstep, voffB);
            PG8_WAIT_V(6); PG8_BAR; PG8_MMA(1, 1, At, B1); PG8_BAR;
            PG8_LDB(B0, 1, 0); PG8_SCHED; PG8_LDA(At, 1, 0); PG8_STAGE(PG8_SA(0, 1), a2, g1);
            PG8_WAIT_L(8); PG8_BAR; PG8_WAIT_L(0); PG8_MMA(0, 0, At, B0); PG8_BAR; PG8_SCHED;
            PG8_LDB(B1, 1, 1); PG8_STAGE(PG8_SB(1, 0), b3, voffB);
            PG8_BAR; PG8_WAIT_L(0); PG8_MMA(0, 1, At, B1); PG8_BAR;
            PG8_LDA(At, 1, 1); PG8_STAGE(PG8_SA(1, 0), a3, g0);
            PG8_BAR; PG8_WAIT_L(0); PG8_MMA(1, 0, At, B0); PG8_BAR; PG8_SCHED;
            PG8_STAGE(PG8_SB(1, 1), b3 + hstep, voffB);
            PG8_WAIT_V(6); PG8_BAR; PG8_MMA(1, 1, At, B1); PG8_BAR;
            }
        }
        if constexpr (ALIGN_EPI) { if (wr == 0) PG8_BAR; }
        if constexpr (!Epi::AFTER_DRAIN) { E(acc, cur, wr, wc, fr, fq); S.done(cur); }
        if (!has_next) break;
#pragma unroll
        for (int a = 0; a < 2; ++a)
#pragma unroll
            for (int b = 0; b < 2; ++b)
#pragma unroll
                for (int m = 0; m < 4; ++m)
#pragma unroll
                    for (int n = 0; n < 2; ++n) acc[a][b][m][n] = (f32x4){0.f, 0.f, 0.f, 0.f};
        cur = nxt; cA = nA; cB = nB; ++ui;
#pragma unroll
        for (int h = 0; h < 2; ++h)
#pragma unroll
            for (int i = 0; i < 2; ++i) gC[h][i] = gN[h][i];
        if constexpr (ALIGN_EPI) { if (wr == 1) PG8_BAR; }
    }
    PG8_WAIT_V(0);
    if constexpr (!ALIGN_EPI) { if (wr == 0) PG8_BAR; }
    PG8_BAR;
    if constexpr (Epi::AFTER_DRAIN) { E.fused(acc, cur, wr, wc, fr, fq, lds, wid, lane); S.done(cur); }
#undef PG8_SA
#undef PG8_SB
#undef PG8_STAGE
#undef PG8_LDA
#undef PG8_LDB
#undef PG8_MMA
#undef PG8_WAIT_V
#undef PG8_WAIT_L
#undef PG8_BAR
#undef PG8_SCHED
}
}
#define XB_TMO      128
#define XB_XCNT(j)  (256  + 64 * (j))
#define XB_XSUB(j)  (1280 + 64 * (j))
#define XB_XGEN(j)  (2304 + 64 * (j))
#define XB_TOP      3328
#define XB_TOPGEN   3392
#define XCD_BAR_WORDS 3456
#define XB_SPIN_CAP (1u << 18)

__device__ __forceinline__ unsigned xb_ld(unsigned* p)              { return __hip_atomic_load(p, __ATOMIC_RELAXED, __HIP_MEMORY_SCOPE_AGENT); }
__device__ __forceinline__ unsigned xb_add(unsigned* p, unsigned v) { return __hip_atomic_fetch_add(p, v, __ATOMIC_RELAXED, __HIP_MEMORY_SCOPE_AGENT); }
__device__ __forceinline__ unsigned xb_xcc_id() { return (unsigned)__builtin_amdgcn_s_getreg((3 << 11) | 20) & 0xFu; }
#define XB_SPIN(cond, bar) do { unsigned _sp = 0; while (cond) { __builtin_amdgcn_s_sleep(1); \
    if ((++_sp & 255u) == 0u) { if (xb_ld(&(bar)[XB_TMO])) break; if (_sp > XB_SPIN_CAP) { atomicAdd(&(bar)[XB_TMO], 1u); break; } } } } while (0)

struct XcdBarrier {
    unsigned* bar; unsigned x;
    volatile LAS unsigned* st;
};

__device__ __forceinline__ XcdBarrier xcd_barrier_post(unsigned* bar, volatile LAS unsigned* st) {
    XcdBarrier b; b.bar = bar; b.x = xb_xcc_id(); b.st = st;
    if (threadIdx.x == 0) (void)xb_add(&bar[XB_XCNT(b.x)], 1u);
    return b;
}
__device__ __forceinline__ void xcd_barrier_complete(unsigned* bar, unsigned x, unsigned& nloc, unsigned& nx) {
    const unsigned G = gridDim.x * gridDim.y * gridDim.z;
    unsigned sum, cnt, mine, sp = 0u;
    for (;;) {
        sum = 0u; cnt = 0u; mine = 0u;
#pragma unroll
        for (unsigned j = 0; j < 16; ++j) { const unsigned c = xb_ld(&bar[XB_XCNT(j)]); sum += c; cnt += (c > 0u) ? 1u : 0u; mine = (j == x) ? c : mine; }
        if (sum == G) break;
        __builtin_amdgcn_s_sleep(1);
        if ((++sp & 255u) == 0u) { if (xb_ld(&bar[XB_TMO])) break; if (sp > XB_SPIN_CAP) { atomicAdd(&bar[XB_TMO], 1u); break; } }
    }
    nloc = mine > 0u ? mine : 1u; nx = cnt > 0u ? cnt : 1u;
}

__device__ __forceinline__ void xcd_barrier(const XcdBarrier& b) {
    asm volatile("s_waitcnt vmcnt(0)" ::: "memory");
    __syncthreads();
    if (threadIdx.x == 0) {
        unsigned* bar = b.bar;
        __builtin_amdgcn_s_waitcnt(0);
        unsigned nloc = b.st[0], nx = b.st[1];
        if (nloc == 0u) { xcd_barrier_complete(bar, b.x, nloc, nx); b.st[0] = nloc; b.st[1] = nx; }
        const unsigned old = xb_add(&bar[XB_XSUB(b.x)], 1u);
        const unsigned gen = old / nloc;
        if (old + 1u == (gen + 1u) * nloc) {
            __builtin_amdgcn_fence(__ATOMIC_RELEASE, "agent");
            asm volatile("s_waitcnt vmcnt(0)" ::: "memory");
            const unsigned og = xb_add(&bar[XB_TOP], 1u);
            const unsigned tg = og / nx;
            if (og + 1u == (tg + 1u) * nx) xb_add(&bar[XB_TOPGEN], 1u);
            else XB_SPIN(xb_ld(&bar[XB_TOPGEN]) == tg, bar);
            __builtin_amdgcn_fence(__ATOMIC_ACQUIRE, "agent");
            xb_add(&bar[XB_XGEN(b.x)], 1u);
            asm volatile("s_waitcnt vmcnt(0)" ::: "memory");
        } else {
            XB_SPIN(xb_ld(&bar[XB_XGEN(b.x)]) == gen, bar);
            __builtin_amdgcn_fence(__ATOMIC_ACQUIRE, "agent");
            asm volatile("s_waitcnt vmcnt(0)" ::: "memory");
        }
    }
    __syncthreads();
}

typedef unsigned short bf16;
typedef unsigned v4u __attribute__((ext_vector_type(4)));
typedef unsigned v2u __attribute__((ext_vector_type(2)));
typedef float f32x4 __attribute__((ext_vector_type(4)));
typedef float f32x2 __attribute__((ext_vector_type(2)));
typedef float f32x16 __attribute__((ext_vector_type(16)));
typedef short bf16x8 __attribute__((ext_vector_type(8)));
typedef short s16x4 __attribute__((ext_vector_type(4)));
#define LDS_WAIT() asm volatile("s_waitcnt lgkmcnt(0)" ::: "memory")
#define VM_WAIT() asm volatile("s_waitcnt vmcnt(0)" ::: "memory")
__device__ __forceinline__ unsigned f2bf(float f) { unsigned u = __builtin_bit_cast(unsigned, f); return (u + 0x7fffu + ((u >> 16) & 1u)) >> 16; }
__device__ __forceinline__ unsigned pk2(float lo, float hi) { return f2bf(lo) | (f2bf(hi) << 16); }
__device__ __forceinline__ float bf2f(unsigned short b) { return __builtin_bit_cast(float, (unsigned)b << 16); }
__device__ __forceinline__ float bflo(unsigned w) { return __builtin_bit_cast(float, w << 16); }
__device__ __forceinline__ float bfhi(unsigned w) { return __builtin_bit_cast(float, w & 0xffff0000u); }

constexpr int NWAVES = 8;
constexpr float LOG2E = 1.4426950408889634f;
constexpr size_t MiB = 1u << 20;
constexpr size_t WS_CTL = 0, CTL_ZERO_BYTES = 1 * MiB;
constexpr size_t WS_BIAS = 1 * MiB;
constexpr size_t WS_KMEAN = 1 * MiB + 256 * 1024;
constexpr size_t WS_ROPE = 1 * MiB + 512 * 1024;
constexpr size_t WS_TOKINFO = 2 * MiB + 512 * 1024;
constexpr size_t WS_ROWW = 2 * MiB + 768 * 1024;
constexpr size_t WS_WRT = 3 * MiB;
constexpr size_t WS_WINE = 4 * MiB;
constexpr size_t WS_WQB = 6 * MiB + 512 * 1024;
constexpr size_t WS_WKVB = 7 * MiB;
constexpr size_t WS_WOE = 8 * MiB;
constexpr size_t WS_WINO = 10 * MiB;
constexpr size_t WS_WOO = 16 * MiB;
constexpr size_t WS_MOEW = 18 * MiB;
constexpr size_t WS_U = 114 * MiB;
constexpr size_t WS_PROJ0 = 146 * MiB;
constexpr size_t WS_CQN = 186 * MiB;
constexpr size_t WS_CKVN = 194 * MiB;
constexpr size_t WS_KR = 198 * MiB;
constexpr size_t WS_Q = 200 * MiB;
constexpr size_t WS_KVB = 224 * MiB;
constexpr size_t WS_XG = 146 * MiB;
constexpr size_t WS_HH = 226 * MiB;
constexpr size_t WS_PROJ1 = 146 * MiB;
constexpr size_t WS_MBLIST = 256 * MiB;
constexpr size_t WS_PARTO = 18 * MiB;
constexpr size_t WS_PARTML = 242 * MiB;
constexpr size_t WS_EL = 246 * MiB;
constexpr size_t WS_EW = 250 * MiB;
constexpr size_t WS_END = 272 * MiB;
constexpr int CW_BAR = 4096;
constexpr int CW_ECNT = 65536;
constexpr int CW_MBCNT = 131072;
constexpr int CW_HCNT = 147456;
constexpr int CW_TICK = 200000;
constexpr int CW_TMO = 16;
constexpr int RING_OFF = 0, RING_BYTES = 131072;
constexpr int MISC_OFF = RING_BYTES + 320;
constexpr int LDS_BYTES = 147456;

struct Params { const float* in[21]; float* out; unsigned char* ws; int ph_lo, ph_hi, li, pad; };

__device__ __forceinline__ void transpose_item(const float* W, int ldw, int k0, int n0, bf16* WTrow0, int ldk, LAS float* scr, int lane) {
#pragma unroll 8
    for (int i = 0; i < 32; ++i) { const int kk = 2 * i + (lane >> 5); scr[kk * 33 + (lane & 31)] = W[(size_t)(k0 + kk) * ldw + n0 + (lane & 31)]; }
    LDS_WAIT(); asm volatile("" ::: "memory");
    const int c = lane & 7;
#pragma unroll
    for (int j = 0; j < 4; ++j) { const int n = (lane >> 3) + 8 * j; const LAS float* s = scr + (8 * c) * 33 + n;
        v4u o; o.x = pk2(s[0 * 33], s[1 * 33]); o.y = pk2(s[2 * 33], s[3 * 33]); o.z = pk2(s[4 * 33], s[5 * 33]); o.w = pk2(s[6 * 33], s[7 * 33]);
        *(v4u*)(WTrow0 + (size_t)n * ldk + k0 + 8 * c) = o; }
    LDS_WAIT(); asm volatile("" ::: "memory");
}
__device__ __forceinline__ float wsum(float v) {
#pragma unroll
    for (int o = 1; o < 64; o <<= 1) v += __shfl_xor(v, o);
    return v;
}
__device__ __forceinline__ void rms_row_to_bf16(const float* xrow, const float* gain, bf16* orow, int lane) {
    const f32x4* xr = (const f32x4*)xrow + lane; const f32x4* gr = (const f32x4*)gain + lane;
    f32x4 v[4]; float s = 0.f;
#pragma unroll
    for (int j = 0; j < 4; ++j) { v[j] = xr[64 * j]; s += (v[j].x * v[j].x + v[j].y * v[j].y) + (v[j].z * v[j].z + v[j].w * v[j].w); }
    const float r = 1.0f / sqrtf(wsum(s) * (1.f / 1024.f) + RMS_EPS);
    unsigned long long* o8 = (unsigned long long*)orow + lane;
#pragma unroll
    for (int j = 0; j < 4; ++j) { const f32x4 g = gr[64 * j];
        o8[64 * j] = (unsigned long long)pk2(v[j].x * r * g.x, v[j].y * r * g.y) | ((unsigned long long)pk2(v[j].z * r * g.z, v[j].w * r * g.w) << 32); }
}

__device__ __forceinline__ void rms_rows2_to_bf16(const float* x0, const float* x1, const float* gain, bf16* o0, bf16* o1, int lane) {
    const f32x4* xa = (const f32x4*)x0 + lane; const f32x4* xb = (const f32x4*)x1 + lane; const f32x4* gr = (const f32x4*)gain + lane;
    f32x4 va[4], vb[4]; float sa = 0.f, sb = 0.f;
#pragma unroll
    for (int j = 0; j < 4; ++j) { va[j] = xa[64 * j]; vb[j] = xb[64 * j]; }
#pragma unroll
    for (int j = 0; j < 4; ++j) { sa += (va[j].x * va[j].x + va[j].y * va[j].y) + (va[j].z * va[j].z + va[j].w * va[j].w); sb += (vb[j].x * vb[j].x + vb[j].y * vb[j].y) + (vb[j].z * vb[j].z + vb[j].w * vb[j].w); }
#pragma unroll
    for (int o = 1; o < 64; o <<= 1) { sa += __shfl_xor(sa, o); sb += __shfl_xor(sb, o); }
    const float ra = 1.0f / sqrtf(sa * (1.f / 1024.f) + RMS_EPS), rb = 1.0f / sqrtf(sb * (1.f / 1024.f) + RMS_EPS);
    unsigned long long* pa = (unsigned long long*)o0 + lane; unsigned long long* pb = (unsigned long long*)o1 + lane;
#pragma unroll
    for (int j = 0; j < 4; ++j) { const f32x4 g = gr[64 * j];
        pa[64 * j] = (unsigned long long)pk2(va[j].x * ra * g.x, va[j].y * ra * g.y) | ((unsigned long long)pk2(va[j].z * ra * g.z, va[j].w * ra * g.w) << 32);
        pb[64 * j] = (unsigned long long)pk2(vb[j].x * rb * g.x, vb[j].y * rb * g.y) | ((unsigned long long)pk2(vb[j].z * rb * g.z, vb[j].w * rb * g.w) << 32); }
}
struct EpiStore {
    static constexpr bool PERM = true, AFTER_DRAIN = false;
    bf16* O; int ldc; int pnmask;
    __device__ __forceinline__ void operator()(const pg8::f32x4 (&acc)[2][2][4][2], const pg8::Unit& u, int wr, int wc, int fr, int fq) const {
        const int row0 = u.pm * 256 + wr * 64 + fr, col0 = (u.pn & pnmask) * 256 + wc * 32 + 8 * fq;
#pragma unroll
        for (int ai = 0; ai < 2; ++ai)
#pragma unroll
            for (int m = 0; m < 4; ++m) { bf16* rowp = O + (size_t)(row0 + ai * 128 + m * 16) * ldc + col0;
#pragma unroll
                for (int bj = 0; bj < 2; ++bj) { const pg8::f32x4 v0 = acc[ai][bj][m][0], v1 = acc[ai][bj][m][1];
                    v4u w; w.x = pg8::cvt_pk_bf16(v0[0], v0[1]); w.y = pg8::cvt_pk_bf16(v0[2], v0[3]); w.z = pg8::cvt_pk_bf16(v1[0], v1[1]); w.w = pg8::cvt_pk_bf16(v1[2], v1[3]);
                    *(v4u*)(rowp + bj * 128) = w; } }
    }
};

struct EpiQRope {
    static constexpr bool PERM = false, AFTER_DRAIN = false;
    bf16* O; const f32x2* rope;
    __device__ __forceinline__ void operator()(const pg8::f32x4 (&acc)[2][2][4][2], const pg8::Unit& u, int wr, int wc, int fr, int fq) const {
        const int row0 = u.pm * 256 + wr * 64 + fr;
#pragma unroll
        for (int ai = 0; ai < 2; ++ai)
#pragma unroll
            for (int m = 0; m < 4; ++m) { const int row = row0 + ai * 128 + m * 16, t = row & 8191; asm volatile("" ::: "memory");
#pragma unroll
                for (int bj = 0; bj < 2; ++bj) { const int colg = u.pn * 256 + bj * 128 + wc * 32;
                    pg8::f32x4 v0 = acc[ai][bj][m][0], v1 = acc[ai][bj][m][1];
                    if (((colg >> 5) % 3) == 2) {
                        const f32x4* rp = (const f32x4*)(rope + (size_t)t * 16 + 4 * fq); const f32x4 a = rp[0], b = rp[1];
                        const pg8::f32x4 x1 = v0, x2 = v1;
                        v0[0] = x1[0] * a.x - x2[0] * a.y; v1[0] = x2[0] * a.x + x1[0] * a.y;
                        v0[1] = x1[1] * a.z - x2[1] * a.w; v1[1] = x2[1] * a.z + x1[1] * a.w;
                        v0[2] = x1[2] * b.x - x2[2] * b.y; v1[2] = x2[2] * b.x + x1[2] * b.y;
                        v0[3] = x1[3] * b.z - x2[3] * b.w; v1[3] = x2[3] * b.z + x1[3] * b.w;
                    }
                    bf16* op = O + (size_t)row * 768 + colg + 4 * fq;
                    v2u w0, w1; w0.x = pg8::cvt_pk_bf16(v0[0], v0[1]); w0.y = pg8::cvt_pk_bf16(v0[2], v0[3]); w1.x = pg8::cvt_pk_bf16(v1[0], v1[1]); w1.y = pg8::cvt_pk_bf16(v1[2], v1[3]);
                    *(v2u*)op = w0; *(v2u*)(op + 16) = w1; } }
    }
};
struct EpiResid {
    static constexpr bool PERM = true, AFTER_DRAIN = false;
    const float* X; float* OUT;
    __device__ __forceinline__ void operator()(const pg8::f32x4 (&acc)[2][2][4][2], const pg8::Unit& u, int wr, int wc, int fr, int fq) const {
        const int row0 = u.pm * 256 + wr * 64 + fr, col0 = u.pn * 256 + wc * 32 + 8 * fq;
#pragma unroll
        for (int ai = 0; ai < 2; ++ai)
#pragma unroll
            for (int m = 0; m < 4; ++m) { const size_t off = (size_t)(row0 + ai * 128 + m * 16) * 1024 + col0;
#pragma unroll
                for (int bj = 0; bj < 2; ++bj) { const f32x4* xp = (const f32x4*)(X + off + bj * 128); f32x4* op = (f32x4*)(OUT + off + bj * 128);
                    const f32x4 x0 = xp[0], x1 = xp[1]; const pg8::f32x4 v0 = acc[ai][bj][m][0], v1 = acc[ai][bj][m][1];
                    op[0] = (f32x4){x0.x + v0[0], x0.y + v0[1], x0.z + v0[2], x0.w + v0[3]};
                    op[1] = (f32x4){x1.x + v1[0], x1.y + v1[1], x1.z + v1[2], x1.w + v1[3]}; } }
    }
};

struct EpiSwiGLU {
    static constexpr bool PERM = true, AFTER_DRAIN = false;
    bf16* HH; const f32x2* EW; const LAS unsigned char* t2e; const LAS int* seg;
    __device__ __forceinline__ void operator()(const pg8::f32x4 (&acc)[2][2][4][2], const pg8::Unit& u, int wr, int wc, int fr, int fq) const {
        const int row0 = u.pm * 256 + wr * 64 + fr, j = u.pn & 1, col0 = j * 128 + wc * 32 + 8 * fq;
        const int e_ = __builtin_amdgcn_readfirstlane((int)t2e[u.pm]); const f32x2* roww = EW + (size_t)e_ * 16384 - __builtin_amdgcn_readfirstlane(seg[e_]);
#pragma unroll
        for (int ai = 0; ai < 2; ++ai)
#pragma unroll
            for (int m = 0; m < 4; ++m) { const int row = row0 + ai * 128 + m * 16; const f32x2 wr2 = roww[row]; const float w = wr2.x, rr = wr2.y;
                float hv[8];
#pragma unroll
                for (int n = 0; n < 2; ++n)
#pragma unroll
                    for (int k = 0; k < 4; ++k) { const float g = acc[ai][0][m][n][k] * rr, up = acc[ai][1][m][n][k] * rr;
                        hv[4 * n + k] = g * __builtin_amdgcn_rcpf(1.0f + __builtin_amdgcn_exp2f(-g * LOG2E)) * up * w; }
                v4u o; o.x = pg8::cvt_pk_bf16(hv[0], hv[1]); o.y = pg8::cvt_pk_bf16(hv[2], hv[3]); o.z = pg8::cvt_pk_bf16(hv[4], hv[5]); o.w = pg8::cvt_pk_bf16(hv[6], hv[7]);
                { bf16* hp = HH + (size_t)row * 256 + col0; asm volatile("global_store_dwordx4 %0, %1, off sc1" :: "v"(hp), "v"(o) : "memory"); } }
    }
};
template <int ntn> struct MoeOrder {
    int total, G, c; const LAS unsigned char* t2e;
    __device__ __forceinline__ bool next(int i, pg8::Unit& u) const {
        const int Lx = i * G + c; if (Lx >= total) return false;
        const int pm = Lx / ntn, j = Lx - pm * ntn; u.pm = pm; u.pn = __builtin_amdgcn_readfirstlane((int)t2e[pm]) * ntn + j; return true;
    }
    __device__ __forceinline__ void a_ready(const pg8::Unit&) const {}
    __device__ __forceinline__ void done(const pg8::Unit&) const {}
};

template <int ntn> struct MoeOrderG {
    int total, G, c; const LAS unsigned char* t2e; const LAS int* seg; const LAS int* cntL; const int* EL;
    __device__ __forceinline__ bool next(int i, pg8::Unit& u) const {
        const int Lx = i * G + c; if (Lx >= total) return false;
        const int pi = Lx / ntn, j = Lx - pi * ntn, pm = __builtin_amdgcn_readfirstlane((int)ord[pi]); u.pm = pm; u.pn = __builtin_amdgcn_readfirstlane((int)t2e[pm]) * ntn + j; return true;
    }
    __device__ __forceinline__ unsigned goff(const pg8::Unit& u, int h, int R, int C) const {
        const int e = __builtin_amdgcn_readfirstlane((int)t2e[u.pm]); const int cn = __builtin_amdgcn_readfirstlane(cntL[e]);
        int li = u.pm * 256 - __builtin_amdgcn_readfirstlane(seg[e]) + h * 128 + R; li = li < cn ? li : cn - 1;
        return (unsigned)EL[(size_t)e * 16384 + li] * 2048u + (unsigned)C * 2u;
    }
    __device__ __forceinline__ void a_ready(const pg8::Unit&) const {}
    unsigned* hcnt;
    const LAS unsigned char* ord;
    __device__ __forceinline__ void done(const pg8::Unit& u) const {
        asm volatile("s_waitcnt vmcnt(0)" ::: "memory");
        if ((threadIdx.x & 63) == 0) (void)__hip_atomic_fetch_add(hcnt + u.pm * 16, 6u, __ATOMIC_RELAXED, __HIP_MEMORY_SCOPE_AGENT);
    }
};
template <int ntn> struct MoeOrderD {
    int total; const LAS unsigned char* t2e; const LAS unsigned char* ord; const unsigned* hcnt; unsigned* tick; LAS unsigned* slot;
    __device__ __forceinline__ bool next(int i, pg8::Unit& u) const {
        (void)i;
        if (__builtin_amdgcn_readfirstlane((int)(threadIdx.x >> 6)) == 0) {
            unsigned tk = 0;
            if ((threadIdx.x & 63) == 0) tk = __hip_atomic_fetch_add(tick, 1u, __ATOMIC_RELAXED, __HIP_MEMORY_SCOPE_AGENT);
            tk = (unsigned)__builtin_amdgcn_readfirstlane((int)tk);
            if (tk < (unsigned)total) {
                const unsigned* w = hcnt + 16 * (int)ord[tk / ntn];
                for (unsigned polls = 0; polls < (1u << 20); ++polls) {
                    if ((unsigned)__builtin_amdgcn_readfirstlane((int)__hip_atomic_load(w, __ATOMIC_RELAXED, __HIP_MEMORY_SCOPE_AGENT)) >= 96u) break;
                    __builtin_amdgcn_s_sleep(2); }
                __builtin_amdgcn_fence(__ATOMIC_ACQUIRE, "agent");
            }
            if ((threadIdx.x & 63) == 0) *slot = tk;
            asm volatile("s_waitcnt vmcnt(0) lgkmcnt(0)" ::: "memory");
        }
        asm volatile("" ::: "memory"); __builtin_amdgcn_s_barrier(); asm volatile("" ::: "memory");
        const unsigned tk = (unsigned)__builtin_amdgcn_readfirstlane((int)*slot);
        if (tk >= (unsigned)total) return false;
        const int pm = __builtin_amdgcn_readfirstlane((int)ord[tk / ntn]), j = (int)(tk % ntn); u.pm = pm; u.pn = __builtin_amdgcn_readfirstlane((int)t2e[pm]) * ntn + j;
        return true;
    }
    __device__ __forceinline__ void a_ready(const pg8::Unit&) const {}
    __device__ __forceinline__ void done(const pg8::Unit&) const {}
};
constexpr int AM_MLA = 0, AM_SWA = 1, AM_MOBAC = 2, AM_SB = 3, AM_MOBAO = 4;
constexpr int AK_OFF = 0, AK_BUF = 13312;
constexpr int AV_OFF = 26624, AV_BUF = 8192;
constexpr int AW_OFF = 43008;
constexpr int AFLAG_OFF = 51200;
constexpr int ABIAS_OFF = 51456;
constexpr int UT_OFF = RING_BYTES + 1024;
constexpr int ATT_LDS_END = ABIAS_OFF + 256 + 32768;
static_assert(ATT_LDS_END <= RING_BYTES, "attention LDS");
constexpr float NEGBIG = -1.0e30f;
constexpr float ATT_THR = 8.0f;

__device__ __forceinline__ int crow(int r, int hi) { return (r & 3) + 8 * (r >> 2) + 4 * hi; }
typedef short v4i16_t __attribute__((ext_vector_type(4)));
__device__ __forceinline__ s16x4 vtr(const LAS unsigned char* p) { return __builtin_bit_cast(s16x4, __builtin_amdgcn_ds_read_tr16_b64_v4i16((LAS v4i16_t*)p)); }


template <int ND0, int RSK>
__device__ __forceinline__ void att_qk(const LAS unsigned char* Kc, int krd, const bf16x8 (&qf)[ND0], f32x16& p0, f32x16& p1, const f32x16& cinit) {
    p0 = cinit; p1 = cinit;
#pragma unroll
    for (int d0 = 0; d0 < ND0; ++d0) {
        const bf16x8 ka = *(const LAS bf16x8*)(Kc + krd + d0 * 32);
        const bf16x8 kb = *(const LAS bf16x8*)(Kc + krd + 32 * RSK + d0 * 32);
        p0 = __builtin_amdgcn_mfma_f32_32x32x16_bf16(ka, qf[d0], p0, 0, 0, 0);
        p1 = __builtin_amdgcn_mfma_f32_32x32x16_bf16(kb, qf[d0], p1, 0, 0, 0);
    }
}
template <int MODE>
__device__ __forceinline__ void att_smpv(f32x16& p0, f32x16& p1, f32x16 (&o)[2], float& mref, float& lsum, float& carry, const LAS unsigned char* Vc, int vrd,
                                         LAS float* wsf, const LAS float* btab, int qpos, int q0w, int t, int hi, int ql, float cscale, f32x16& negm, bool& first) {
    const int k0 = t * 64;
    const int dbase = qpos - k0 - 4 * hi;
    if constexpr (MODE != AM_SB) {
        if constexpr (MODE == AM_MLA) {
            if (k0 + 63 > q0w) {
#pragma unroll
                for (int r = 0; r < 16; ++r) { const int c0 = (r & 3) + 8 * (r >> 2);
                    p0[r] = (dbase - c0 >= 0) ? p0[r] : NEGBIG; p1[r] = (dbase - c0 - 32 >= 0) ? p1[r] : NEGBIG; }
            }
        } else {
#pragma unroll
            for (int r = 0; r < 16; ++r) {
                const int c0 = (r & 3) + 8 * (r >> 2);
                const int d0v = dbase - c0, d1v = dbase - c0 - 32;
                const float s0 = __builtin_fmaf(p0[r], cscale, btab[64 + d0v]), s1 = __builtin_fmaf(p1[r], cscale, btab[64 + d1v]);
                if constexpr (MODE == AM_MOBAC) { p0[r] = s0; p1[r] = s1; }
                else {
                    bool v0, v1;
                    if constexpr (MODE == AM_SWA) { v0 = (d0v >= 0) && (d0v < 128); v1 = (d1v >= 0) && (d1v < 128); }
                    else { v0 = (d0v >= 0); v1 = (d1v >= 0); }
                    p0[r] = v0 ? s0 : NEGBIG; p1[r] = v1 ? s1 : NEGBIG;
                }
            }
        }
        float rm = fmaxf(p0[0], p1[0]);
#pragma unroll
        for (int r = 1; r < 16; ++r) rm = fmaxf(fmaxf(rm, p0[r]), p1[r]);
        rm = fmaxf(rm, __shfl_xor(rm, 32));
        if constexpr (MODE == AM_MLA) {
            if (first || __any((int)(rm > ATT_THR))) {
                const float delta = (first || rm > ATT_THR) ? rm : 0.f;
                const float alpha = first ? 1.0f : __builtin_amdgcn_exp2f(-delta);
                mref += delta; lsum *= alpha;
#pragma unroll
                for (int r = 0; r < 16; ++r) { negm[r] = -mref; p0[r] -= delta; p1[r] -= delta; }
                if (!first) {
                    if (hi == 0) wsf[ql] = alpha;
#pragma unroll
                    for (int g4 = 0; g4 < 4; ++g4) { const f32x4 al = *(const LAS f32x4*)(wsf + 8 * g4 + 4 * hi);
                        o[0][4 * g4 + 0] *= al.x; o[0][4 * g4 + 1] *= al.y; o[0][4 * g4 + 2] *= al.z; o[0][4 * g4 + 3] *= al.w;
                        o[1][4 * g4 + 0] *= al.x; o[1][4 * g4 + 1] *= al.y; o[1][4 * g4 + 2] *= al.z; o[1][4 * g4 + 3] *= al.w; }
                }
                first = false;
            }
        } else
        if (__any((int)(rm - mref > ATT_THR))) {
            const float mnew = (rm - mref > ATT_THR) ? rm : mref;
            const float alpha = __builtin_amdgcn_exp2f(mref - mnew);
            mref = mnew; lsum *= alpha;
            if (hi == 0) wsf[ql] = alpha;
#pragma unroll
            for (int g4 = 0; g4 < 4; ++g4) { const f32x4 al = *(const LAS f32x4*)(wsf + 8 * g4 + 4 * hi);
                o[0][4 * g4 + 0] *= al.x; o[0][4 * g4 + 1] *= al.y; o[0][4 * g4 + 2] *= al.z; o[0][4 * g4 + 3] *= al.w;
                o[1][4 * g4 + 0] *= al.x; o[1][4 * g4 + 1] *= al.y; o[1][4 * g4 + 2] *= al.z; o[1][4 * g4 + 3] *= al.w; }
        }
        float ls = 0.f;
        if constexpr (MODE == AM_MLA) {
#pragma unroll
            for (int r = 0; r < 16; ++r) { p0[r] = __builtin_amdgcn_exp2f(p0[r]); p1[r] = __builtin_amdgcn_exp2f(p1[r]); ls += p0[r] + p1[r]; }
        } else {
#pragma unroll
            for (int r = 0; r < 16; ++r) { p0[r] = __builtin_amdgcn_exp2f(p0[r] - mref); p1[r] = __builtin_amdgcn_exp2f(p1[r] - mref); ls += p0[r] + p1[r]; }
        }
        lsum += ls;
    } else {
        float gt[8];
#pragma unroll
        for (int j = 0; j < 8; ++j) {
            float lsn[4], lsp[4];
#pragma unroll
            for (int i = 0; i < 4; ++i) {
                const int r = 4 * (j & 3) + i; const float acc = (j < 4) ? p0[r] : p1[r];
                const int dist = dbase - i - 8 * (j & 3) - 32 * (j >> 2);
                const float z = acc * cscale;
                const float l1 = __builtin_amdgcn_logf(1.0f + __builtin_amdgcn_exp2f(-fabsf(z)));
                const float a_ = fminf(z, 0.f) - l1;
                const bool valid = dist > 0;
                lsp[i] = valid ? a_ : NEGBIG; lsn[i] = valid ? (a_ - z) : 0.f;
            }
            const float s2 = lsn[3], s1 = s2 + lsn[2], s0 = s1 + lsn[1];
            gt[j] = s0 + lsn[0];
            const float e0 = lsp[0] + s0, e1 = lsp[1] + s1, e2 = lsp[2] + s2, e3 = lsp[3];
            if (j < 4) { p0[4 * j + 0] = e0; p0[4 * j + 1] = e1; p0[4 * j + 2] = e2; p0[4 * j + 3] = e3; }
            else { p1[4 * (j - 4) + 0] = e0; p1[4 * (j - 4) + 1] = e1; p1[4 * (j - 4) + 2] = e2; p1[4 * (j - 4) + 3] = e3; }
        }
        float ox[8];
#pragma unroll
        for (int j = 0; j < 8; ++j) ox[j] = __shfl_xor(gt[j], 32);
        float so = 0.f, sx = 0.f;
#pragma unroll
        for (int j = 7; j >= 0; --j) {
            const float sg = carry + so + sx + ((hi == 0) ? ox[j] : 0.f);
            if (j < 4) { p0[4 * j + 0] += sg; p0[4 * j + 1] += sg; p0[4 * j + 2] += sg; p0[4 * j + 3] += sg; }
            else { p1[4 * (j - 4) + 0] += sg; p1[4 * (j - 4) + 1] += sg; p1[4 * (j - 4) + 2] += sg; p1[4 * (j - 4) + 3] += sg; }
            so += gt[j]; sx += ox[j];
        }
        carry += so + sx;
#pragma unroll
        for (int r = 0; r < 16; ++r) { p0[r] = __builtin_amdgcn_exp2f(p0[r]); p1[r] = __builtin_amdgcn_exp2f(p1[r]); }
    }
    v4u pw[4];
    pw[0] = (v4u){pg8::cvt_pk_bf16(p0[0], p0[1]), pg8::cvt_pk_bf16(p0[2], p0[3]), pg8::cvt_pk_bf16(p0[4], p0[5]), pg8::cvt_pk_bf16(p0[6], p0[7])};
    pw[1] = (v4u){pg8::cvt_pk_bf16(p0[8], p0[9]), pg8::cvt_pk_bf16(p0[10], p0[11]), pg8::cvt_pk_bf16(p0[12], p0[13]), pg8::cvt_pk_bf16(p0[14], p0[15])};
    pw[2] = (v4u){pg8::cvt_pk_bf16(p1[0], p1[1]), pg8::cvt_pk_bf16(p1[2], p1[3]), pg8::cvt_pk_bf16(p1[4], p1[5]), pg8::cvt_pk_bf16(p1[6], p1[7])};
    pw[3] = (v4u){pg8::cvt_pk_bf16(p1[8], p1[9]), pg8::cvt_pk_bf16(p1[10], p1[11]), pg8::cvt_pk_bf16(p1[12], p1[13]), pg8::cvt_pk_bf16(p1[14], p1[15])};
#pragma unroll
    for (int s = 0; s < 4; ++s)
#pragma unroll
        for (int d0 = 0; d0 < 2; ++d0) {
            const s16x4 lo = vtr(Vc + vrd + d0 * 4096 + s * 1024), hi4 = vtr(Vc + vrd + d0 * 4096 + s * 1024 + 512);
            const bf16x8 vf = (bf16x8){lo[0], lo[1], lo[2], lo[3], hi4[0], hi4[1], hi4[2], hi4[3]};
            o[d0] = __builtin_amdgcn_mfma_f32_32x32x16_bf16(__builtin_bit_cast(bf16x8, pw[s]), vf, o[d0], 0, 0, 0);
        }
}

struct AttnPtrs {
    const bf16* Q; int qs;
    const bf16* K; int ks;
    const bf16* K2;
    const bf16* V; int vs;
    bf16* O;
};

struct MobaArgs { int q; int slot; bool valid; bool wvalid; int bhbase; bf16* PARTO; f32x2* PARTML; };
template <int MODE>
__device__ __forceinline__ void attn_unit(LAS unsigned char* L, const AttnPtrs& a, int q0u  , int q0w, int t_first, int t_last, float cscale,
                                          float sinkl2, const MobaArgs& mb, int boff, const f32x2* rope, int tid, int lane, int wave) {
    constexpr int DQK = (MODE == AM_MLA) ? 96 : 64, RSK = 2 * DQK + 16, ND0 = DQK / 16;
    const int ql = lane & 31, hi = lane >> 5;
    LAS unsigned char* Kb = L + AK_OFF; LAS unsigned char* Vb = L + AV_OFF;
    LAS float* wsf = (LAS float*)(L + AW_OFF + wave * 1024);
    const int qpos = (MODE == AM_MOBAC) ? mb.q : (q0w + ql);
    const bf16* qrow = (MODE == AM_MOBAC) ? (a.Q + (size_t)mb.q * a.qs) : (a.Q + (size_t)ql * a.qs);
    bf16x8 qf[ND0];
#pragma unroll
    for (int d0 = 0; d0 < ND0; ++d0) qf[d0] = *(const bf16x8*)(qrow + d0 * 16 + hi * 8);
    if constexpr (MODE == AM_MLA) {
        const f32x4* rp = (const f32x4*)(rope + (size_t)qpos * 16 + 8 * hi);
        const v4u w1 = __builtin_bit_cast(v4u, qf[4]), w2 = __builtin_bit_cast(v4u, qf[5]);
        float x1[8], x2[8], cs[16];
        x1[0] = bflo(w1.x); x1[1] = bfhi(w1.x); x1[2] = bflo(w1.y); x1[3] = bfhi(w1.y); x1[4] = bflo(w1.z); x1[5] = bfhi(w1.z); x1[6] = bflo(w1.w); x1[7] = bfhi(w1.w);
        x2[0] = bflo(w2.x); x2[1] = bfhi(w2.x); x2[2] = bflo(w2.y); x2[3] = bfhi(w2.y); x2[4] = bflo(w2.z); x2[5] = bfhi(w2.z); x2[6] = bflo(w2.w); x2[7] = bfhi(w2.w);
#pragma unroll
        for (int k = 0; k < 4; ++k) { const f32x4 v = rp[k]; cs[4 * k] = v.x; cs[4 * k + 1] = v.y; cs[4 * k + 2] = v.z; cs[4 * k + 3] = v.w; }
        float y1[8], y2[8];
#pragma unroll
        for (int j = 0; j < 8; ++j) { const float c = cs[2 * j] * cscale, sn = cs[2 * j + 1] * cscale; y1[j] = x1[j] * c - x2[j] * sn; y2[j] = x2[j] * c + x1[j] * sn; }
#pragma unroll
        for (int d0 = 0; d0 < 4; ++d0) { const v4u w = __builtin_bit_cast(v4u, qf[d0]);
            const v4u ws_ = (v4u){pk2(bflo(w.x) * cscale, bfhi(w.x) * cscale), pk2(bflo(w.y) * cscale, bfhi(w.y) * cscale), pk2(bflo(w.z) * cscale, bfhi(w.z) * cscale), pk2(bflo(w.w) * cscale, bfhi(w.w) * cscale)};
            qf[d0] = __builtin_bit_cast(bf16x8, ws_); }
        const v4u o1 = (v4u){pk2(y1[0], y1[1]), pk2(y1[2], y1[3]), pk2(y1[4], y1[5]), pk2(y1[6], y1[7])};
        const v4u o2 = (v4u){pk2(y2[0], y2[1]), pk2(y2[2], y2[3]), pk2(y2[4], y2[5]), pk2(y2[6], y2[7])};
        qf[4] = __builtin_bit_cast(bf16x8, o1); qf[5] = __builtin_bit_cast(bf16x8, o2);
    }
    const int skey = tid >> 3, sc = tid & 7;
    const bf16* kg = a.K + (size_t)skey * a.ks + sc * 8;
    const bf16* vg = a.V + (size_t)skey * a.vs + sc * 8;
    const bf16* k2g = nullptr; if constexpr (MODE == AM_MLA) k2g = a.K2 + (size_t)(tid >> 2) * 32 + (tid & 3) * 8;
    const int kw_off = skey * RSK + sc * 16, vw_off = (sc >> 2) * 4096 + skey * 64 + (sc & 3) * 16, k2w_off = (tid >> 2) * RSK + 128 + (tid & 3) * 16;
    v4u rk, rv, rk2;
#define ATT_LOAD(t) do { rk = *(const v4u*)(kg + (size_t)(t) * 64 * a.ks); rv = *(const v4u*)(vg + (size_t)(t) * 64 * a.vs); \
        if constexpr (MODE == AM_MLA) { if (tid < 256) rk2 = *(const v4u*)(k2g + (size_t)(t) * 64 * 32); } } while (0)
#define ATT_WRITE(kbuf, vbuf) do { *(LAS v4u*)(Kb + (kbuf) * AK_BUF + kw_off) = rk; *(LAS v4u*)(Vb + (vbuf) * AV_BUF + vw_off) = rv; \
        if constexpr (MODE == AM_MLA) { if (tid < 256) *(LAS v4u*)(Kb + (kbuf) * AK_BUF + k2w_off) = rk2; } } while (0)
    f32x16 o[2]; o[0] = f32x16{}; o[1] = f32x16{};
    float mref = (MODE == AM_MLA) ? 0.f : NEGBIG, lsum = 0.f, carry = 0.f;
    f32x16 negm = f32x16{}; bool first = true;
    const int krd = ql * RSK + hi * 16;
    const int vrd = ((lane >> 4) & 1) * 32 + (lane & 3) * 8 + (4 * hi + ((lane & 15) >> 2)) * 64;
    const LAS float* btab = (const LAS float*)(L + ABIAS_OFF) + boff;
    constexpr bool REV = (MODE == AM_SB);
    const int ntl = t_last - t_first + 1;
    constexpr bool SKEW = false;
    const bool skew = SKEW && (wave >= 4);
    f32x16 p0, p1;
#define ATT_TILE(i) (REV ? (t_last - (i)) : (t_first + (i)))
    ATT_LOAD(ATT_TILE(0));
    __syncthreads();
    ATT_WRITE(0, 0);
    __syncthreads();
    if (skew) { if (ntl > 1) ATT_LOAD(ATT_TILE(1)); __syncthreads(); }
    for (int it = 0; it < ntl; ++it) {
        const int t = ATT_TILE(it), cur = it & 1, k0 = t * 64;
        const bool more = (it + 1 < ntl);
        if (!skew && more) ATT_LOAD(ATT_TILE(it + 1));
        bool need;
        if constexpr (MODE == AM_MLA) need = (k0 <= q0w + 31);
        else if constexpr (MODE == AM_SWA) need = (k0 <= q0w + 31) && (k0 + 63 >= q0w - 127);
        else if constexpr (MODE == AM_MOBAC) need = mb.wvalid;
        else if constexpr (MODE == AM_MOBAO) need = (k0 <= q0w + 31);
        else need = (k0 < q0w + 31) && (__any((int)(carry > -160.f)) != 0);
        if (need) att_qk<ND0, RSK>(Kb + cur * AK_BUF, krd, qf, p0, p1, negm);
        if constexpr (SKEW) {
            if (skew && more) ATT_WRITE(cur ^ 1, cur ^ 1);
            __syncthreads();
            if (skew && it + 2 < ntl) ATT_LOAD(ATT_TILE(it + 2));
        }
        if (need) att_smpv<MODE>(p0, p1, o, mref, lsum, carry, Vb + cur * AV_BUF, vrd, wsf, btab, qpos, q0w, t, hi, ql, cscale, negm, first);
        if (!skew && more) ATT_WRITE(cur ^ 1, cur ^ 1);
        if constexpr (MODE == AM_SB) {
            volatile LAS unsigned* fl = (volatile LAS unsigned*)(L + AFLAG_OFF);
            const bool wdone = (k0 < q0w + 31) && (__any((int)(carry > -160.f)) == 0);
            if (lane == 0) fl[cur * 8 + wave] = wdone ? 1u : 0u;
            __syncthreads();
            unsigned alld = 1u;
#pragma unroll
            for (int w = 0; w < 8; ++w) alld &= fl[cur * 8 + w];
            if (alld) break;
        } else {
            __syncthreads();
        }
    }
    if (SKEW && !skew) __syncthreads();
#undef ATT_TILE
#undef ATT_LOAD
#undef ATT_WRITE
    LAS unsigned short* stg = (LAS unsigned short*)(L + wave * 4096);
    LAS int* wsi = (LAS int*)wsf;
    lsum += __shfl_xor(lsum, 32);
    float inv[16];
    if constexpr (MODE == AM_MOBAC || MODE == AM_MOBAO) {
        const int di = (MODE == AM_MOBAO) ? ((mb.bhbase + qpos) * 4 + 3) : (mb.valid ? ((mb.bhbase + mb.q) * 4 + mb.slot) : -1);
        if (hi == 0) { wsi[ql] = (MODE == AM_MOBAO) ? 0 : (mb.valid ? ((mb.bhbase + mb.q) * 3 + mb.slot) : -1); if (di >= 0) mb.PARTML[di] = (f32x2){mref, lsum}; }
#pragma unroll
        for (int r = 0; r < 16; ++r) inv[r] = 1.0f;
    } else if constexpr (MODE != AM_SB) {
        if constexpr (MODE == AM_SWA) lsum += __builtin_amdgcn_exp2f(sinkl2 - mref);
        if (hi == 0) wsf[32 + ql] = lsum;
#pragma unroll
        for (int g4 = 0; g4 < 4; ++g4) { const f32x4 lv = *(const LAS f32x4*)(wsf + 32 + 8 * g4 + 4 * hi);
            inv[4 * g4 + 0] = 1.0f / lv.x; inv[4 * g4 + 1] = 1.0f / lv.y; inv[4 * g4 + 2] = 1.0f / lv.z; inv[4 * g4 + 3] = 1.0f / lv.w; }
    } else {
#pragma unroll
        for (int r = 0; r < 16; ++r) inv[r] = 1.0f;
    }
#pragma unroll
    for (int r = 0; r < 16; ++r) { const int row = crow(r, hi);
        stg[row * 64 + ql] = (unsigned short)f2bf(o[0][r] * inv[r]); stg[row * 64 + 32 + ql] = (unsigned short)f2bf(o[1][r] * inv[r]); }
#pragma unroll
    for (int i = 0; i < 4; ++i) { const int c = lane + 64 * i, row = c >> 3, part = c & 7;
        const v4u v = *(const LAS v4u*)(stg + row * 64 + part * 8);
        if constexpr (MODE == AM_MOBAC) { const int d = wsi[row]; if (d >= 0) *(v4u*)(mb.PARTO + (size_t)d * 64 + part * 8) = v; }
        else *(v4u*)(a.O + (size_t)row * 1024 + part * 8) = v; }
}

constexpr int RK_OFF = 0, RK_TILE = 9216;
constexpr int RV_OFF = 36864, RV_TILE = 8192;
constexpr int RW_OFF = 69632;
constexpr int RB_OFF = 86016;
static_assert(RB_OFF + 256 + 32768 <= RING_BYTES, "resident MoBA LDS");

__device__ __forceinline__ void moba_resident_load(LAS unsigned char* L, const bf16* Kblk, const bf16* Vblk, int tid) {
    const int skey = tid >> 3, sc = tid & 7;
    v4u rk[4], rv[4];
#pragma unroll
    for (int t = 0; t < 4; ++t) { rk[t] = *(const v4u*)(Kblk + (size_t)(t * 64 + skey) * 3072 + sc * 8); rv[t] = *(const v4u*)(Vblk + (size_t)(t * 64 + skey) * 3072 + sc * 8); }
#pragma unroll
    for (int t = 0; t < 4; ++t) { *(LAS v4u*)(L + RK_OFF + t * RK_TILE + skey * 144 + sc * 16) = rk[t]; *(LAS v4u*)(L + RV_OFF + t * RV_TILE + (sc >> 2) * 4096 + skey * 64 + (sc & 3) * 16) = rv[t]; }
}
__device__ __forceinline__ void moba_resident_wave(LAS unsigned char* L, const bf16* Qb  , int n, int q, int slot, bool valid, int bhbase,
                                                   bf16* PARTO, f32x2* PARTML, int lane, int wave) {
    const int ql = lane & 31, hi = lane >> 5;
    LAS float* wsf = (LAS float*)(L + RW_OFF + wave * 2048);
    LAS int* wsi = (LAS int*)(L + RW_OFF + wave * 2048 + 1024);
    const LAS float* btab = (const LAS float*)(L + RB_OFF);
    bf16x8 qf[4];
#pragma unroll
    for (int d0 = 0; d0 < 4; ++d0) qf[d0] = *(const bf16x8*)(Qb + (size_t)q * 3072 + d0 * 16 + hi * 8);
    f32x16 o[2]; o[0] = f32x16{}; o[1] = f32x16{};
    float mref = NEGBIG, lsum = 0.f, carry = 0.f; f32x16 negm = f32x16{}; bool first = true;
    const int krd = ql * 144 + hi * 16;
    const int vrd = ((lane >> 4) & 1) * 32 + (lane & 3) * 8 + (4 * hi + ((lane & 15) >> 2)) * 64;
    f32x16 p0, p1;
#pragma unroll 1
    for (int t = 0; t < 4; ++t) {
        att_qk<4, 144>(L + RK_OFF + t * RK_TILE, krd, qf, p0, p1, negm);
        att_smpv<AM_MOBAC>(p0, p1, o, mref, lsum, carry, L + RV_OFF + t * RV_TILE, vrd, wsf, btab, q, 0, 4 * n + t, hi, ql, 0.125f * LOG2E, negm, first);
    }
    lsum += __shfl_xor(lsum, 32);
    const int di = valid ? ((bhbase + q) * 4 + slot) : -1;
    if (hi == 0) { wsi[ql] = valid ? ((bhbase + q) * 3 + slot) : -1; if (di >= 0) PARTML[di] = (f32x2){mref, lsum}; }
    LAS unsigned short* stg = (LAS unsigned short*)wsf;
#pragma unroll
    for (int g4 = 0; g4 < 4; ++g4) {
#pragma unroll
        for (int k = 0; k < 4; ++k) { const int r = 4 * g4 + k, lrow = 4 * hi + k;
            stg[lrow * 64 + ql] = (unsigned short)f2bf(o[0][r]); stg[lrow * 64 + 32 + ql] = (unsigned short)f2bf(o[1][r]); }
        const int lrow = lane >> 3, part = lane & 7, d = wsi[8 * g4 + lrow];
        const v4u v = *(const LAS v4u*)(stg + lrow * 64 + part * 8);
        if (d >= 0) *(v4u*)(PARTO + (size_t)d * 64 + part * 8) = v;
    }
}
#ifndef REP_CH
#define REP_CH 1
#endif
#ifndef REPS_INIT
#define REPS_INIT {1,1,1,1,1,1,1,1,1,1,1,1,1,1,1,1,1,1,1,1,1,1}
#endif
__device__ constexpr int REPS[22] = REPS_INIT;
__device__ __forceinline__ void p0_prologue(const Params& p, LAS unsigned char* L, int gw, int NGW, int lane, int wave, int gtid, int NGT) {
    LAS float* scr = (LAS float*)(L + wave * 16384);
    unsigned char* ws = p.ws;
    constexpr int I0 = 592, I1 = 96, I2 = 64, I3 = 512, I4 = 1536, I5 = 512, IM = 24576;
    constexpr int NIT = I0 + I1 + I2 + I3 + I4 + I5; (void)IM;
    for (int it = gw; it < NIT; it += NGW) {
        int r = it;
        if (r < I0) { const int kb = r / 37, nb = r % 37; transpose_item(p.in[5], 1184, 64 * kb, 32 * nb, (bf16*)(ws + WS_WINE) + (size_t)(32 * nb) * 1024, 1024, scr, lane); continue; } r -= I0;
        if (r < I1) { const int kb = r / 24, nb = r % 24; transpose_item(p.in[8], 768, 64 * kb, 32 * nb, (bf16*)(ws + WS_WQB) + (size_t)(32 * nb) * 256, 256, scr, lane); continue; } r -= I1;
        if (r < I2) { const int kb = r / 32, nb = r % 32; transpose_item(p.in[9], 1024, 64 * kb, 32 * nb, (bf16*)(ws + WS_WKVB) + (size_t)(32 * nb) * 128, 128, scr, lane); continue; } r -= I2;
        if (r < I3) { const int kb = r / 32, nb = r % 32; transpose_item(p.in[11], 1024, 64 * kb, 32 * nb, (bf16*)(ws + WS_WOE) + (size_t)(32 * nb) * 1024, 1024, scr, lane); continue; } r -= I3;
        if (r < I4) { const int kb = r / 96, nb = r % 96; transpose_item(p.in[12], 3072, 64 * kb, 32 * nb, (bf16*)(ws + WS_WINO) + (size_t)(32 * nb) * 1024, 1024, scr, lane); continue; } r -= I4;
        { const int kb = r / 32, nb = r % 32; transpose_item(p.in[13], 1024, 64 * kb, 32 * nb, (bf16*)(ws + WS_WOO) + (size_t)(32 * nb) * 1024, 1024, scr, lane); }
    }
    { v4u* z = (v4u*)((bf16*)(ws + WS_WINE) + (size_t)1184 * 1024); for (int i = gtid; i < 96 * 1024 / 8; i += NGT) z[i] = (v4u){0u, 0u, 0u, 0u}; }
    for (int m = gw; m < NTOK / 2; m += NGW) rms_rows2_to_bf16(p.in[0] + (size_t)m * 1024, p.in[0] + (size_t)(m + NTOK / 2) * 1024, p.in[1], (bf16*)(ws + WS_U) + (size_t)m * 1024, (bf16*)(ws + WS_U) + (size_t)(m + NTOK / 2) * 1024, lane);
    { float* bt = (float*)(ws + WS_BIAS); const float* rel = p.in[4];
      for (int i = gtid; i < 8 * 8192; i += NGT) { const int h = i >> 13, n = i & 8191; int b;
          if (n < 16) b = n; else { b = 16 + (int)(log((double)n / 16.0) / log(128.0) * 16.0); if (b > 31) b = 31; }
          bt[i] = rel[b * 8 + h] * LOG2E; } }
    { float* wrt = (float*)(ws + WS_WRT);
      for (int i = gtid; i < 2 * 48 * 1024; i += NGT) { const int d = i & 1023, j = (i >> 10) % 48, l = i / (48 * 1024);
          const float g = p.in[2][l * 1024 + d];
          const float w = (j < 32) ? g * p.in[16][((size_t)l * 1024 + d) * 32 + j] : (j < 36) ? g * p.in[14][((size_t)l * 1024 + d) * 4 + (j - 32)] : 0.f;
          wrt[i] = w; const unsigned hb = f2bf(w);
          const int cch = d >> 5, kq_ = (d >> 3) & 3, e_ = d & 7, jt = j >> 4, col_ = j & 15;
          const size_t fi = ((((size_t)l * 32 + cch) * 3 + jt) * 64 + (kq_ * 16 + col_)) * 8 + e_;
          ((bf16*)(ws + WS_WRT + 512 * 1024))[fi] = (bf16)hb; ((bf16*)(ws + WS_WRT + 768 * 1024))[fi] = (bf16)f2bf(w - bf2f((unsigned short)hb)); } }
    { f32x2* rt = (f32x2*)(ws + WS_ROPE);
      for (int i = gtid; i < 8192 * 16; i += NGT) { const int t = i >> 4, ii = i & 15;
          const float freq = (float)pow(10000.0, -(double)(2 * ii) / 32.0); const float ang = (float)t * freq;
          f32x2 cs; cs.x = (float)cos((double)ang); cs.y = (float)sin((double)ang); rt[i] = cs; } }
}


__device__ __forceinline__ void moe_item(const Params& p, int layer, int it, const float*& W, int& ldw, int& k0, int& n0, bf16*& dst, int& ldk) {
    const int r = layer * 32 * 384 + it, le = r / 384, rr = r % 384, which = rr >> 7, item = rr & 127, e = le & 31;
    unsigned char* lbase = p.ws + WS_MOEW + (size_t)(le >> 5) * 48 * MiB;
    if (which < 2) { W = p.in[18 + which] + (size_t)le * 1024 * 256; ldw = 256; const int kb = item / 8, nb = item % 8; k0 = 64 * kb; n0 = 32 * nb;
        dst = (bf16*)lbase + ((size_t)e * 512 + (n0 >> 7) * 256 + which * 128 + (n0 & 127)) * 1024; ldk = 1024; }
    else { W = p.in[20] + (size_t)le * 256 * 1024; ldw = 1024; const int kb = item / 32, nb = item % 32; k0 = 64 * kb; n0 = 32 * nb;
        dst = (bf16*)(lbase + 32 * MiB) + ((size_t)e * 1024 + 32 * nb) * 256; ldk = 256; }
}
__device__ __forceinline__ void moe_convert(const Params& p, LAS unsigned char* L, int layer, int widx, int nworkers, int lane, int wave) {
    LAS float* scr = (LAS float*)(L + wave * 16384);
    int it = widx;
    if (it >= 32 * 384) return;
    const float* W; int ldw, k0, n0, ldk; bf16* dst;
    moe_item(p, layer, it, W, ldw, k0, n0, dst, ldk);
    float tv[32];
#pragma unroll
    for (int i = 0; i < 32; ++i) tv[i] = W[(size_t)(k0 + 2 * i + (lane >> 5)) * ldw + n0 + (lane & 31)];
    for (;;) {
        const int itn = it + nworkers; const bool more = itn < 32 * 384;
        const float* Wn = W; int ldwn = ldw, k0n = k0, n0n = n0, ldkn = ldk; bf16* dstn = dst;
        if (more) moe_item(p, layer, itn, Wn, ldwn, k0n, n0n, dstn, ldkn);
#pragma unroll
        for (int i = 0; i < 32; ++i) scr[(2 * i + (lane >> 5)) * 33 + (lane & 31)] = tv[i];
        if (more) {
#pragma unroll
            for (int i = 0; i < 32; ++i) tv[i] = Wn[(size_t)(k0n + 2 * i + (lane >> 5)) * ldwn + n0n + (lane & 31)];
        }
        LDS_WAIT(); asm volatile("" ::: "memory");
        const int c = lane & 7;
#pragma unroll
        for (int j = 0; j < 4; ++j) { const int n = (lane >> 3) + 8 * j; const LAS float* s = scr + (8 * c) * 33 + n;
            v4u o; o.x = pk2(s[0 * 33], s[1 * 33]); o.y = pk2(s[2 * 33], s[3 * 33]); o.z = pk2(s[4 * 33], s[5 * 33]); o.w = pk2(s[6 * 33], s[7 * 33]);
            *(v4u*)(dst + (size_t)n * ldk + k0 + 8 * c) = o; }
        LDS_WAIT(); asm volatile("" ::: "memory");
        if (!more) break;
        it = itn; W = Wn; ldw = ldwn; k0 = k0n; n0 = n0n; dst = dstn; ldk = ldkn;
    }
}
constexpr int MOE_T2E_OFF = RING_BYTES + 1024;
template <bool ORD>
__device__ __forceinline__ void moe_tables(const Params& p, LAS unsigned char* L, int layer, int tid, int G, int& ntiles, int& nfull) {
    LAS int* seg = (LAS int*)(L + MOE_T2E_OFF + 256); LAS unsigned char* t2e = L + MOE_T2E_OFF; LAS int* cntL = (LAS int*)(L + MOE_T2E_OFF + 512);
    LAS unsigned char* ord = L + MOE_T2E_OFF + 640; LAS int* nf = (LAS int*)(L + MOE_T2E_OFF + 800);
    const unsigned* cnt = (const unsigned*)(p.ws + WS_CTL) + CW_ECNT + layer * 32 * 64;
    __syncthreads();
    if (tid < 64) {
        const int c = (tid < 32) ? (int)__hip_atomic_load(cnt + tid * 64, __ATOMIC_RELAXED, __HIP_MEMORY_SCOPE_AGENT) : 0;
        const int nt = (c + 255) >> 8; const int r = c - (nt - 1) * 256; const int part = (nt > 0 && r < 256) ? 1 : 0;
        int tl_ = 0;
        if constexpr (ORD) {
            int ncomp = nt - part;
#pragma unroll
            for (int o = 1; o < 64; o <<= 1) ncomp += __shfl_xor(ncomp, o);
            const int slots = ((ncomp * 2 + G - 1) / G) * G / 2 - ncomp;
            int rank = 0;
            const int key = part ? r : -1;
#pragma unroll
            for (int e2 = 0; e2 < 32; ++e2) { const int k2 = __builtin_amdgcn_readlane(key, e2); rank += (k2 > key || (k2 == key && e2 < tid)) ? 1 : 0; }
            tl_ = (part && rank >= slots) ? 1 : 0;
        }
        const int tl = tl_; const int nfe = nt - tl;
        int inc = nt, incf = nfe, inct = tl;
#pragma unroll
        for (int o = 1; o < 32; o <<= 1) { const int v = __shfl_up(inc, o), vf = __shfl_up(incf, o), vt = __shfl_up(inct, o); if ((tid & 63) >= o) { inc += v; incf += vf; inct += vt; } }
        const int nfa = __shfl(incf, 31);
        if (tid < 32) { cntL[tid] = c; seg[tid] = (inc - nt) * 256; for (int t = inc - nt; t < inc; ++t) t2e[t] = (unsigned char)tid;
            for (int t = 0; t < nfe; ++t) ord[incf - nfe + t] = (unsigned char)(inc - nt + t);
            if (tl) ord[nfa + inct - 1] = (unsigned char)(inc - 1); }
        if (tid == 31) { seg[32] = inc * 256; nf[0] = nfa; }
    }
    __syncthreads();
    ntiles = seg[32] >> 8; nfull = nf[0];
}
__device__ __forceinline__ void moe_tail_units(const Params& p, LAS unsigned char* L, const bf16* GU, unsigned* hcnt, int nfull, int ntiles, int q, int G, int tid, int lane, int wave) {
    unsigned char* ws = p.ws;
    const LAS int* seg = (const LAS int*)(L + MOE_T2E_OFF + 256); const LAS unsigned char* t2e = L + MOE_T2E_OFF; const LAS int* cntL = (const LAS int*)(L + MOE_T2E_OFF + 512);
    const LAS unsigned char* ord = L + MOE_T2E_OFF + 640;
    const bf16* UB = (const bf16*)(ws + WS_U); const int* EL = (const int*)(ws + WS_EL); const f32x2* EW = (const f32x2*)(ws + WS_EW); bf16* HH = (bf16*)(ws + WS_HH);
    constexpr int RS = 528;
    const int mb = wave & 3, cg = wave >> 2, fm = lane & 15, kq = lane >> 4;
    int base = 0;
    for (int ti = nfull; ti < ntiles; ++ti) {
        const int pm = (int)ord[ti], e = (int)t2e[pm], cn = cntL[e], off = pm * 256 - seg[e], rows = cn - off, nun = ((rows + 63) >> 6) * 8;
        const unsigned pub = 96u / (unsigned)nun;
        for (int un = (q - base + G) % G; un < nun; un += G) {
            const int rg = un >> 3, s = un & 7, f0 = s * 32, ro = off + rg * 64;
            const bf16* src[8];
#pragma unroll
            for (int i = 0; i < 8; ++i) { const int r = (wave & 3) * 16 + 2 * i + (lane >> 5);
                if (wave < 4) { int li = ro + r; li = li < cn ? li : cn - 1; src[i] = UB + (size_t)EL[(size_t)e * 16384 + li] * 1024 + (lane & 31) * 8; }
                else { const int f = f0 + (r & 31); src[i] = GU + ((size_t)e * 512 + (f >> 7) * 256 + (f & 127) + (r >> 5) * 128) * 1024 + (lane & 31) * 8; } }
            pg8::f32x4 accg = (pg8::f32x4){0.f, 0.f, 0.f, 0.f}, accu = (pg8::f32x4){0.f, 0.f, 0.f, 0.f};
            const bool active = (ro + mb * 16 < cn);
            v4u rr[8];
#pragma unroll
            for (int i = 0; i < 8; ++i) rr[i] = *(const v4u*)(src[i]);
#pragma unroll 1
            for (int ch = 0; ch < 4; ++ch) {
                __syncthreads();
#pragma unroll
                for (int i = 0; i < 8; ++i) *(LAS v4u*)(L + (wave * 16 + 2 * i + (lane >> 5)) * RS + (lane & 31) * 16) = rr[i];
                __syncthreads();
                if (ch < 3) {
#pragma unroll
                    for (int i = 0; i < 8; ++i) rr[i] = *(const v4u*)(src[i] + (ch + 1) * 256);
                }
                if (active) {
#pragma unroll
                    for (int kk = 0; kk < 8; ++kk) {
                        const pg8::bf16x8 af = *(const LAS pg8::bf16x8*)(L + (mb * 16 + fm) * RS + kk * 64 + kq * 16);
                        const pg8::bf16x8 bg = *(const LAS pg8::bf16x8*)(L + (64 + cg * 16 + fm) * RS + kk * 64 + kq * 16);
                        const pg8::bf16x8 bu = *(const LAS pg8::bf16x8*)(L + (96 + cg * 16 + fm) * RS + kk * 64 + kq * 16);
                        accg = __builtin_amdgcn_mfma_f32_16x16x32_bf16(af, bg, accg, 0, 0, 0);
                        accu = __builtin_amdgcn_mfma_f32_16x16x32_bf16(af, bu, accu, 0, 0, 0);
                    }
                }
            }
            if (active) {
#pragma unroll
                for (int i = 0; i < 4; ++i) { const int lr = rg * 64 + mb * 16 + 4 * kq + i, li = off + lr;
                    if (li < cn) { const f32x2 w2 = EW[(size_t)e * 16384 + li]; const float g = accg[i] * w2.y, up = accu[i] * w2.y;
                        const float hv = g * __builtin_amdgcn_rcpf(1.0f + __builtin_amdgcn_exp2f(-g * LOG2E)) * up * w2.x;
                        const unsigned hb = (unsigned)f2bf(hv); bf16* hp = HH + (size_t)(pm * 256 + lr) * 256 + f0 + cg * 16 + fm;
                        asm volatile("global_store_short %0, %1, off sc1" :: "v"(hp), "v"(hb) : "memory"); } }
            }
            asm volatile("s_waitcnt vmcnt(0)" ::: "memory");
            __syncthreads();
            if (tid == 0) (void)__hip_atomic_fetch_add(hcnt + pm * 16, pub, __ATOMIC_RELAXED, __HIP_MEMORY_SCOPE_AGENT);
        }
        base = (base + nun) % G;
    }
}
__device__ __forceinline__ void moe_route(const Params& p, LAS unsigned char* L, int layer, const float* H, int gw, int NGW, int lane, int wave) {
    unsigned char* ws = p.ws;
    const float* b_group = p.in[15] + layer * 4; const float* b_router = p.in[17] + layer * 32; const float* gain = p.in[2] + layer * 1024;
    unsigned* cnt = (unsigned*)(ws + WS_CTL) + CW_ECNT + layer * 32 * 64;
    bf16* UB = (bf16*)(ws + WS_U);
    const int g4 = wave & 3, half = wave >> 2;
    LAS float* lg = (LAS float*)(L + g4 * 4096);
    LAS float* pl = (LAS float*)(L + 16384 + g4 * 4096);
    LAS unsigned* lc = (LAS unsigned*)(L + 32768);
    const int tok = lane & 15, kq = lane >> 4, tid = wave * 64 + lane;
    const int G_ = NGW / NWAVES, vcu_ = gw / NWAVES;
    for (int base = 0; base < NTOK / 16; base += 4 * G_) {
        const int grp = base + g4 * G_ + vcu_;
        const bool active = (grp < NTOK / 16);
        if (tid < 32) lc[tid] = 0u;
        int e0 = 0, e1 = 0; unsigned r0 = 0u, r1 = 0u; float wA = 0.f, wB = 0.f, rtok = 0.f; const int m0 = grp * 16;
        pg8::f32x4 acc0 = {0.f, 0.f, 0.f, 0.f}, acc1 = acc0, acc2 = acc0; float ss = 0.f;
        if (active) {
            const int kb = 512 * half + 8 * kq;
            const float* hrow = H + (size_t)(m0 + tok) * 1024 + kb;
            const float* grow = gain + kb;
            bf16* urow = UB + (size_t)(m0 + tok) * 1024 + kb;
            const bf16* wh = (const bf16*)(ws + WS_WRT + 512 * 1024) + ((size_t)layer * 32 + 16 * half) * 1536 + lane * 8;
            const bf16* wl = (const bf16*)(ws + WS_WRT + 768 * 1024) + ((size_t)layer * 32 + 16 * half) * 1536 + lane * 8;
            f32x4 ra0[2], ra1[2], rq0[2], rq1[2]; bf16x8 rbh0[2], rbl0[2], rbh1[2], rbl1[2], rbh2[2], rbl2[2];
#define RT_LD(S, C) do { ra0[S] = *(const f32x4*)(hrow + 32 * (C)); ra1[S] = *(const f32x4*)(hrow + 32 * (C) + 4); rq0[S] = *(const f32x4*)(grow + 32 * (C)); rq1[S] = *(const f32x4*)(grow + 32 * (C) + 4); \
                rbh0[S] = *(const bf16x8*)(wh + 1536 * (C)); rbl0[S] = *(const bf16x8*)(wl + 1536 * (C)); rbh1[S] = *(const bf16x8*)(wh + 1536 * (C) + 512); rbl1[S] = *(const bf16x8*)(wl + 1536 * (C) + 512); \
                rbh2[S] = *(const bf16x8*)(wh + 1536 * (C) + 1024); rbl2[S] = *(const bf16x8*)(wl + 1536 * (C) + 1024); } while (0)
#define RT_DO(S, C) do { const f32x4 a0 = ra0[S], a1 = ra1[S], q0 = rq0[S], q1 = rq1[S]; \
                ss += ((a0.x * a0.x + a0.y * a0.y) + (a0.z * a0.z + a0.w * a0.w)) + ((a1.x * a1.x + a1.y * a1.y) + (a1.z * a1.z + a1.w * a1.w)); \
                { v4u ub; ub.x = pg8::cvt_pk_bf16(a0.x * q0.x, a0.y * q0.y); ub.y = pg8::cvt_pk_bf16(a0.z * q0.z, a0.w * q0.w); ub.z = pg8::cvt_pk_bf16(a1.x * q1.x, a1.y * q1.y); ub.w = pg8::cvt_pk_bf16(a1.z * q1.z, a1.w * q1.w); \
                  *(v4u*)(urow + 32 * (C)) = ub; } \
                v4u hi4, lo4; \
                hi4.x = pg8::cvt_pk_bf16(a0.x, a0.y); hi4.y = pg8::cvt_pk_bf16(a0.z, a0.w); hi4.z = pg8::cvt_pk_bf16(a1.x, a1.y); hi4.w = pg8::cvt_pk_bf16(a1.z, a1.w); \
                lo4.x = pg8::cvt_pk_bf16(a0.x - bflo(hi4.x), a0.y - bfhi(hi4.x)); lo4.y = pg8::cvt_pk_bf16(a0.z - bflo(hi4.y), a0.w - bfhi(hi4.y)); \
                lo4.z = pg8::cvt_pk_bf16(a1.x - bflo(hi4.z), a1.y - bfhi(hi4.z)); lo4.w = pg8::cvt_pk_bf16(a1.z - bflo(hi4.w), a1.w - bfhi(hi4.w)); \
                const bf16x8 ah = __builtin_bit_cast(bf16x8, hi4), al = __builtin_bit_cast(bf16x8, lo4); \
                acc0 = __builtin_amdgcn_mfma_f32_16x16x32_bf16(ah, rbh0[S], acc0, 0, 0, 0); acc1 = __builtin_amdgcn_mfma_f32_16x16x32_bf16(ah, rbh1[S], acc1, 0, 0, 0); acc2 = __builtin_amdgcn_mfma_f32_16x16x32_bf16(ah, rbh2[S], acc2, 0, 0, 0); \
                acc0 = __builtin_amdgcn_mfma_f32_16x16x32_bf16(ah, rbl0[S], acc0, 0, 0, 0); acc1 = __builtin_amdgcn_mfma_f32_16x16x32_bf16(ah, rbl1[S], acc1, 0, 0, 0); acc2 = __builtin_amdgcn_mfma_f32_16x16x32_bf16(ah, rbl2[S], acc2, 0, 0, 0); \
                acc0 = __builtin_amdgcn_mfma_f32_16x16x32_bf16(al, rbh0[S], acc0, 0, 0, 0); acc1 = __builtin_amdgcn_mfma_f32_16x16x32_bf16(al, rbh1[S], acc1, 0, 0, 0); acc2 = __builtin_amdgcn_mfma_f32_16x16x32_bf16(al, rbh2[S], acc2, 0, 0, 0); } while (0)
            RT_LD(0, 0);
#pragma unroll 1
            for (int c = 0; c < 16; c += 2) {
                RT_LD(1, c + 1);
                RT_DO(0, c);
                if (c + 2 < 16) RT_LD(0, c + 2);
                RT_DO(1, c + 1);
            }
#undef RT_LD
#undef RT_DO
            ss += __shfl_xor(ss, 16); ss += __shfl_xor(ss, 32);
            if (half == 1) {
#pragma unroll
                for (int i = 0; i < 4; ++i) { const int tk = 4 * kq + i; pl[tk * 48 + tok] = acc0[i]; pl[tk * 48 + 16 + tok] = acc1[i]; pl[tk * 48 + 32 + tok] = acc2[i]; }
                if (lane < 16) pl[768 + lane] = ss;
            }
        }
        __syncthreads();
        if (active && half == 0) {
            ss += pl[768 + tok];
            const float r = 1.0f / sqrtf(ss * (1.f / 1024.f) + RMS_EPS);
            rtok = r;
            const int col = lane & 15;
            const float bia0 = b_router[col], bia1 = b_router[16 + col], bia2 = (col < 4) ? b_group[col] : 0.f;
#pragma unroll
            for (int i = 0; i < 4; ++i) { const int tk = 4 * kq + i; const float rt = __shfl(r, tk);
                lg[tk * 48 + col] = (acc0[i] + pl[tk * 48 + col]) * rt + bia0; lg[tk * 48 + 16 + col] = (acc1[i] + pl[tk * 48 + 16 + col]) * rt + bia1; lg[tk * 48 + 32 + col] = (acc2[i] + pl[tk * 48 + 32 + col]) * rt + bia2; }
            LDS_WAIT(); asm volatile("" ::: "memory");
            if (lane < 16) {
                const LAS float* l = lg + lane * 48;
                int gs = 0; float gm = l[32];
#pragma unroll
                for (int j = 1; j < 4; ++j) { const float v = l[32 + j]; if (v > gm) { gm = v; gs = j; } }
                float gsum = 0.f;
#pragma unroll
                for (int j = 0; j < 4; ++j) gsum += expf(l[32 + j] - gm);
                const float ggate = 1.0f / gsum;
                const LAS float* el = l + gs * 8;
                float v0 = el[0]; int a0 = 0;
#pragma unroll
                for (int j = 1; j < 8; ++j) { const float v = el[j]; if (v > v0) { v0 = v; a0 = j; } }
                float v1 = -INFINITY; int a1 = 0;
#pragma unroll
                for (int j = 0; j < 8; ++j) { const float v = el[j]; if (j != a0 && v > v1) { v1 = v; a1 = j; } }
                const float p1 = expf(v1 - v0), ps = 1.0f + p1;
                e0 = gs * 8 + a0; e1 = gs * 8 + a1; wA = ggate / ps; wB = ggate * p1 / ps;
                r0 = __hip_atomic_fetch_add(lc + e0, 1u, __ATOMIC_RELAXED, __HIP_MEMORY_SCOPE_WORKGROUP);
                r1 = __hip_atomic_fetch_add(lc + e1, 1u, __ATOMIC_RELAXED, __HIP_MEMORY_SCOPE_WORKGROUP);
            }
        }
        __syncthreads();
        if (tid < 32) { const unsigned c = lc[tid]; lc[32 + tid] = c ? __hip_atomic_fetch_add(cnt + tid * 64, c, __ATOMIC_RELAXED, __HIP_MEMORY_SCOPE_AGENT) : 0u; }
        __syncthreads();
        if (active && half == 0 && lane < 16) {
            const unsigned pos0 = lc[32 + e0] + r0, pos1 = lc[32 + e1] + r1;
            v4u ti; ti.x = ((unsigned)e0 << 16) | pos0; ti.y = ((unsigned)e1 << 16) | pos1; ti.z = __builtin_bit_cast(unsigned, wA); ti.w = __builtin_bit_cast(unsigned, wB);
            *((v4u*)(ws + WS_TOKINFO) + m0 + lane) = ti;
            { int* EL = (int*)(ws + WS_EL); f32x2* EW = (f32x2*)(ws + WS_EW); EL[e0 * 16384 + pos0] = m0 + lane; EL[e1 * 16384 + pos1] = m0 + lane; EW[e0 * 16384 + pos0] = (f32x2){wA, rtok}; EW[e1 * 16384 + pos1] = (f32x2){wB, rtok}; }
        }
        __syncthreads();
    }
}
template <bool FINAL>
__device__ __forceinline__ void moe_combine(const Params& p, LAS unsigned char* L, float* H, const float* gain, int gw, int NGW, int lane) {
    unsigned char* ws = p.ws; const LAS int* seg = (const LAS int*)(L + MOE_T2E_OFF + 256);
    const bf16* YE = (const bf16*)(ws + WS_XG); bf16* U = (bf16*)(ws + WS_U);
    const f32x4* gr = (const f32x4*)gain + lane;
    for (int m0 = gw; m0 < NTOK / 2; m0 += NGW) {
        const int mA = m0, mB = m0 + NTOK / 2;
        const v2u tA = *((const v2u*)(ws + WS_TOKINFO) + 2 * mA), tB = *((const v2u*)(ws + WS_TOKINFO) + 2 * mB);
        const int rA0 = seg[tA.x >> 16] + (int)(tA.x & 0xffffu), rA1 = seg[tA.y >> 16] + (int)(tA.y & 0xffffu);
        const int rB0 = seg[tB.x >> 16] + (int)(tB.x & 0xffffu), rB1 = seg[tB.y >> 16] + (int)(tB.y & 0xffffu);
        f32x4* hA = (f32x4*)(H + (size_t)mA * 1024) + lane; f32x4* hB = (f32x4*)(H + (size_t)mB * 1024) + lane;
        const v2u* yA0 = (const v2u*)(YE + (size_t)rA0 * 1024) + lane; const v2u* yA1 = (const v2u*)(YE + (size_t)rA1 * 1024) + lane;
        const v2u* yB0 = (const v2u*)(YE + (size_t)rB0 * 1024) + lane; const v2u* yB1 = (const v2u*)(YE + (size_t)rB1 * 1024) + lane;
        f32x4 va[4], vb[4]; v2u a0[4], a1[4], b0[4], b1[4];
#pragma unroll
        for (int j = 0; j < 4; ++j) { va[j] = hA[64 * j]; vb[j] = hB[64 * j]; a0[j] = yA0[64 * j]; a1[j] = yA1[64 * j]; b0[j] = yB0[64 * j]; b1[j] = yB1[64 * j]; }
        float sa = 0.f, sb = 0.f;
#pragma unroll
        for (int j = 0; j < 4; ++j) {
            va[j].x += bflo(a0[j].x) + bflo(a1[j].x); va[j].y += bfhi(a0[j].x) + bfhi(a1[j].x); va[j].z += bflo(a0[j].y) + bflo(a1[j].y); va[j].w += bfhi(a0[j].y) + bfhi(a1[j].y);
            vb[j].x += bflo(b0[j].x) + bflo(b1[j].x); vb[j].y += bfhi(b0[j].x) + bfhi(b1[j].x); vb[j].z += bflo(b0[j].y) + bflo(b1[j].y); vb[j].w += bfhi(b0[j].y) + bfhi(b1[j].y);
            sa += (va[j].x * va[j].x + va[j].y * va[j].y) + (va[j].z * va[j].z + va[j].w * va[j].w);
            sb += (vb[j].x * vb[j].x + vb[j].y * vb[j].y) + (vb[j].z * vb[j].z + vb[j].w * vb[j].w); }
#pragma unroll
        for (int o = 1; o < 64; o <<= 1) { sa += __shfl_xor(sa, o); sb += __shfl_xor(sb, o); }
        const float ra = 1.0f / sqrtf(sa * (1.f / 1024.f) + RMS_EPS), rb = 1.0f / sqrtf(sb * (1.f / 1024.f) + RMS_EPS);
        if (FINAL) {
#pragma unroll
            for (int j = 0; j < 4; ++j) { const f32x4 g = gr[64 * j];
                hA[64 * j] = (f32x4){va[j].x * ra * g.x, va[j].y * ra * g.y, va[j].z * ra * g.z, va[j].w * ra * g.w};
                hB[64 * j] = (f32x4){vb[j].x * rb * g.x, vb[j].y * rb * g.y, vb[j].z * rb * g.z, vb[j].w * rb * g.w}; }
        } else {
            unsigned long long* oA = (unsigned long long*)(U + (size_t)mA * 1024) + lane; unsigned long long* oB = (unsigned long long*)(U + (size_t)mB * 1024) + lane;
#pragma unroll
            for (int j = 0; j < 4; ++j) { const f32x4 g = gr[64 * j]; hA[64 * j] = va[j]; hB[64 * j] = vb[j];
                oA[64 * j] = (unsigned long long)pk2(va[j].x * ra * g.x, va[j].y * ra * g.y) | ((unsigned long long)pk2(va[j].z * ra * g.z, va[j].w * ra * g.w) << 32);
                oB[64 * j] = (unsigned long long)pk2(vb[j].x * rb * g.x, vb[j].y * rb * g.y) | ((unsigned long long)pk2(vb[j].z * rb * g.z, vb[j].w * rb * g.w) << 32); }
        }
    }
}
__device__ __forceinline__ int mbl_off(int n) { return 256 * (31 * n - (n * (n - 1)) / 2); }
constexpr int MBL_PER_BH = 256 * 496;
__global__ void __launch_bounds__(NWAVES * 64, 2) mega(Params p) {
    extern __shared__ __attribute__((aligned(16))) unsigned char lds[];
    LAS unsigned char* L = (LAS unsigned char*)lds;
    const int tid = threadIdx.x, lane = tid & 63, wave = __builtin_amdgcn_readfirstlane(tid >> 6);
    const int G = gridDim.x, bx = blockIdx.x;
    const int vcu = (G % 8 == 0) ? (bx % 8) * (G / 8) + bx / 8 : bx;
    unsigned char* ws = p.ws;
    volatile LAS unsigned* MISC = (volatile LAS unsigned*)(L + MISC_OFF);
    if (tid < 32) MISC[tid] = 0u;
    __syncthreads();
    XcdBarrier bar = xcd_barrier_post((unsigned*)(ws + WS_CTL) + CW_BAR + p.li * XCD_BAR_WORDS, MISC + 8);
    const int lo = p.ph_lo, hi = p.ph_hi;
#define IN(k) (lo <= (k) && (k) < hi)
#define BOTH(k) (IN(k) && IN((k) + 1))
    const int gw = vcu * NWAVES + wave, NGW = G * NWAVES, gtid = vcu * (NWAVES * 64) + tid, NGT = G * NWAVES * 64;

    if (IN(0)) for (int rep = 0; rep < REPS[0]; ++rep) { p0_prologue(p, L, gw, NGW, lane, wave, gtid, NGT); if (BOTH(0) && rep == REPS[0] - 1) xcd_barrier(bar); }

    if (IN(1)) for (int rep = 0; rep < REPS[1]; ++rep) {
        pg8::Gemm g{(const pg8::bf16_t*)(ws + WS_U), (const pg8::bf16_t*)(ws + WS_WINE), NTOK, 1280, 1024};
        pg8::StaticOrder S; S.init(NTOK, 1280, G, bx);
        EpiStore E{(bf16*)(ws + WS_PROJ0), 1280, -1};
        pg8::gemm_phase<EpiStore, pg8::StaticOrder, true, true>(L + RING_OFF, g, S, E);
        { const int total = (NTOK / 256) * 5, rem = total % G, nidle = rem ? G - rem : G;
          if (rep == 0 && bx >= (rem ? rem : 0)) { __syncthreads(); moe_convert(p, L, 0, (bx - rem) * NWAVES + wave, nidle * NWAVES, lane, wave); } }
        if (BOTH(1) && rep == REPS[1] - 1) xcd_barrier(bar);
    }

    if (IN(2)) for (int rep = 0; rep < REPS[2]; ++rep) {
        const bf16* P0 = (const bf16*)(ws + WS_PROJ0); bf16* CQN = (bf16*)(ws + WS_CQN); bf16* CKVN = (bf16*)(ws + WS_CKVN); bf16* KR = (bf16*)(ws + WS_KR);
        const f32x2* rope = (const f32x2*)(ws + WS_ROPE);
        const f32x4 gq = *((const f32x4*)p.in[6] + lane); const f32x2 gkv = *((const f32x2*)p.in[7] + lane);
        for (int m = gw; m < NTOK; m += NGW) {
            const bf16* pr = P0 + (size_t)m * 1280;
            const v2u w = *(const v2u*)(pr + lane * 4); const unsigned w1 = *(const unsigned*)(pr + 256 + lane * 2);
            const float c0 = bflo(w.x), c1 = bfhi(w.x), c2 = bflo(w.y), c3 = bfhi(w.y), k0 = bflo(w1), k1 = bfhi(w1);
            const float r = 1.0f / sqrtf(wsum((c0 * c0 + c1 * c1) + (c2 * c2 + c3 * c3)) * (1.f / 256.f) + RMS_EPS);
            const float r2 = 1.0f / sqrtf(wsum(k0 * k0 + k1 * k1) * (1.f / 128.f) + RMS_EPS);
            v2u o; o.x = pk2(c0 * r * gq.x, c1 * r * gq.y); o.y = pk2(c2 * r * gq.z, c3 * r * gq.w);
            *(v2u*)(CQN + (size_t)m * 256 + lane * 4) = o;
            *(unsigned*)(CKVN + (size_t)m * 128 + lane * 2) = pk2(k0 * r2 * gkv.x, k1 * r2 * gkv.y);
            if (lane < 16) { const float x1 = bf2f(pr[384 + lane]), x2 = bf2f(pr[400 + lane]); const f32x2 cs = rope[(size_t)(m & 8191) * 16 + lane];
                KR[(size_t)m * 32 + lane] = (bf16)f2bf(x1 * cs.x - x2 * cs.y); KR[(size_t)m * 32 + 16 + lane] = (bf16)f2bf(x2 * cs.x + x1 * cs.y); }
        }
        if (BOTH(2) && rep == REPS[2] - 1) xcd_barrier(bar);
    }

    if (IN(3)) for (int rep = 0; rep < REPS[3]; ++rep) {
        { pg8::Gemm g{(const pg8::bf16_t*)(ws + WS_CQN), (const pg8::bf16_t*)(ws + WS_WQB), NTOK, 768, 256};
          pg8::StaticOrder S; S.init(NTOK, 768, G, bx);
          EpiStore E{(bf16*)(ws + WS_Q), 768, -1};
          pg8::gemm_phase<EpiStore, pg8::StaticOrder, false, true>(L + RING_OFF, g, S, E); }
        { pg8::Gemm g{(const pg8::bf16_t*)(ws + WS_CKVN), (const pg8::bf16_t*)(ws + WS_WKVB), NTOK, 1024, 128};
          pg8::StaticOrder S; S.init(NTOK, 1024, G, bx);
          EpiStore E{(bf16*)(ws + WS_KVB), 1024, -1};
          pg8::gemm_phase<EpiStore, pg8::StaticOrder, false, true>(L + RING_OFF, g, S, E); }
        if (BOTH(3) && rep == REPS[3] - 1) xcd_barrier(bar);
    }

    if (IN(4)) for (int rep = 0; rep < REPS[4]; ++rep) {
        const bf16* Qb = (const bf16*)(ws + WS_Q); const bf16* KVB = (const bf16*)(ws + WS_KVB); const bf16* KR = (const bf16*)(ws + WS_KR); const bf16* P0 = (const bf16*)(ws + WS_PROJ0);
        bf16* MIX = (bf16*)(ws + WS_U); const MobaArgs mb0{};
        { const float* BT = (const float*)(ws + WS_BIAS); LAS float* tb = (LAS float*)(L + ABIAS_OFF);
          for (int i = tid; i < 8 * 320; i += NWAVES * 64) { const int h = i / 320, d = (i % 320) - 64; tb[i] = (d >= 0 && d < 128) ? BT[h * 8192 + d] : 0.f; } }
        __syncthreads();
        for (int pi = vcu; pi < 256; pi += G) {
            const int bh = pi >> 4, s = pi & 15, b = bh >> 3, h = bh & 7;
#pragma unroll 1
            for (int ui = 0; ui < 2; ++ui) {
                const int qb = ui ? s : 31 - s, q0u = qb * 256, q0w = q0u + 32 * wave; const size_t r0 = (size_t)b * T_;
                AttnPtrs a; a.Q = Qb + (r0 + q0w) * 768 + h * 96; a.qs = 768; a.K = KVB + r0 * 1024 + h * 128; a.ks = 1024; a.K2 = KR + r0 * 32;
                a.V = KVB + r0 * 1024 + h * 128 + 64; a.vs = 1024; a.O = MIX + (r0 + q0w) * 1024 + h * 64;
                attn_unit<AM_MLA>(L, a, q0u, q0w, 0, (q0u + 255) >> 6, 0.10206207261596575f * LOG2E, 0.f, mb0, 0, (const f32x2*)(ws + WS_ROPE), tid, lane, wave);
            }
        }
        for (int id = vcu; id < 512; id += G) {
            const int b = id >> 8, hkv = (id >> 7) & 1, qt = id & 127, q0u = qt * 64, hq = 4 * hkv + (wave >> 1), q0w = q0u + 32 * (wave & 1); const size_t r0 = (size_t)b * T_;
            AttnPtrs a; a.Q = P0 + (r0 + q0w) * 1280 + 416 + hq * 64; a.qs = 1280; a.K = P0 + r0 * 1280 + 928 + hkv * 64; a.ks = 1280; a.K2 = nullptr;
            a.V = P0 + r0 * 1280 + 1056 + hkv * 64; a.vs = 1280; a.O = MIX + (r0 + q0w) * 1024 + 512 + hq * 64;
            attn_unit<AM_SWA>(L, a, q0u, q0w, qt >= 2 ? qt - 2 : 0, qt, 0.125f * LOG2E, p.in[10][hq] * LOG2E, mb0, hq * 320, nullptr, tid, lane, wave);
        }
        __syncthreads();
        if (BOTH(4) && rep == REPS[4] - 1) xcd_barrier(bar);
    }

    if (IN(5)) for (int rep = 0; rep < REPS[5]; ++rep) {
        pg8::Gemm g{(const pg8::bf16_t*)(ws + WS_U), (const pg8::bf16_t*)(ws + WS_WOE), NTOK, 1024, 1024};
        pg8::StaticOrder S; S.init(NTOK, 1024, G, bx);
        EpiResid E{p.in[0], p.out};
        pg8::gemm_phase<EpiResid, pg8::StaticOrder, false, true>(L + RING_OFF, g, S, E);
        if (BOTH(5) && rep == REPS[5] - 1) xcd_barrier(bar);
    }

    if (IN(6)) { moe_route(p, L, 0, p.out, gw, NGW, lane, wave); if (BOTH(6)) xcd_barrier(bar); }
    if (IN(8)) {
        int nt, nfull; moe_tables<true>(p, L, 0, tid, G, nt, nfull);
        unsigned* hcnt = (unsigned*)(ws + WS_CTL) + CW_HCNT + 0 * 160 * 16;
        const int total1 = nfull * 2, rem = total1 % G, q = (vcu + G - rem) % G;
        { pg8::Gemm g{(const pg8::bf16_t*)(ws + WS_U), (const pg8::bf16_t*)(ws + WS_MOEW), nt * 256, 32 * 512, 1024};
          MoeOrderG<2> S{total1, G, vcu, L + MOE_T2E_OFF, (const LAS int*)(L + MOE_T2E_OFF + 256), (const LAS int*)(L + MOE_T2E_OFF + 512), (const int*)(ws + WS_EL), hcnt, L + MOE_T2E_OFF + 640};
          EpiSwiGLU E{(bf16*)(ws + WS_HH), (const f32x2*)(ws + WS_EW), L + MOE_T2E_OFF, (const LAS int*)(L + MOE_T2E_OFF + 256)};
          pg8::gemm_phase_g<EpiSwiGLU, MoeOrderG<2>, false, true>(L + RING_OFF, g, S, E); }
        __syncthreads();
        moe_tail_units(p, L, (const bf16*)(ws + WS_MOEW), hcnt, nfull, nt, q, G, tid, lane, wave);
        { const int ntu = (nt - nfull) * 16, nw = (ntu <= G - 64) ? G - ntu : G, r = (ntu <= G - 64) ? q - ntu : q;
          if (r >= 0) { __syncthreads(); moe_convert(p, L, 1, r * NWAVES + wave, nw * NWAVES, lane, wave); __syncthreads(); } }
        { pg8::Gemm g{(const pg8::bf16_t*)(ws + WS_HH), (const pg8::bf16_t*)(ws + WS_MOEW + 32 * MiB), nt * 256, 32 * 1024, 256};
          MoeOrderD<4> S{nt * 4, L + MOE_T2E_OFF, L + MOE_T2E_OFF + 640, hcnt, (unsigned*)(ws + WS_CTL) + CW_TICK + 0 * 64, (LAS unsigned*)(L + MOE_T2E_OFF + 804)};
          EpiStore E{(bf16*)(ws + WS_XG), 1024, 3};
          pg8::gemm_phase<EpiStore, MoeOrderD<4>, false, true>(L + RING_OFF, g, S, E); }
        if (BOTH(8)) xcd_barrier(bar);
    }
    if (IN(10)) { int nt, nfl; moe_tables<false>(p, L, 0, tid, G, nt, nfl); moe_combine<false>(p, L, p.out, p.in[1] + 1024, gw, NGW, lane); __syncthreads(); if (BOTH(10)) xcd_barrier(bar); }

    if (IN(11)) for (int rep = 0; rep < REPS[11]; ++rep) {
        pg8::Gemm g{(const pg8::bf16_t*)(ws + WS_U), (const pg8::bf16_t*)(ws + WS_WINO), NTOK, 3072, 1024};
        pg8::StaticOrder S; S.init(NTOK, 3072, G, bx);
        EpiStore E{(bf16*)(ws + WS_PROJ1), 3072, -1};
        pg8::gemm_phase<EpiStore, pg8::StaticOrder, true, true>(L + RING_OFF, g, S, E);
        if (BOTH(11) && rep == REPS[11] - 1) xcd_barrier(bar);
    }
    if (IN(12)) for (int rep = 0; rep < REPS[12]; ++rep) {
        const bf16* P1 = (const bf16*)(ws + WS_PROJ1); float* KM = (float*)(ws + WS_KMEAN);
        LAS float* part = (LAS float*)L;
        for (int id = vcu; id < 64; id += G) { const int b = id >> 5, n = id & 31;
            const bf16* kp = P1 + ((size_t)b * T_ + n * 256 + wave * 32) * 3072 + 512 + lane * 8;
            float acc[8] = {0.f, 0.f, 0.f, 0.f, 0.f, 0.f, 0.f, 0.f};
#pragma unroll 8
            for (int j = 0; j < 32; ++j) { const v4u w = *(const v4u*)(kp + (size_t)j * 3072);
                acc[0] += bflo(w.x); acc[1] += bfhi(w.x); acc[2] += bflo(w.y); acc[3] += bfhi(w.y); acc[4] += bflo(w.z); acc[5] += bfhi(w.z); acc[6] += bflo(w.w); acc[7] += bfhi(w.w); }
            __syncthreads();
#pragma unroll
            for (int j = 0; j < 8; ++j) part[wave * 512 + lane * 8 + j] = acc[j];
            __syncthreads();
            { const int c = tid;
              float s = 0.f;
#pragma unroll
              for (int w = 0; w < 8; ++w) s += part[w * 512 + c];
              KM[((size_t)(b * 8 + (c >> 6)) * 32 + n) * 64 + (c & 63)] = s * (1.0f / 256.f); }
        }
        __syncthreads();
        if (BOTH(12) && rep == REPS[12] - 1) xcd_barrier(bar);
    }
    if (IN(13)) {
        const bf16* P1 = (const bf16*)(ws + WS_PROJ1); const float* KM = (const float*)(ws + WS_KMEAN);
        unsigned* mcnt = (unsigned*)(ws + WS_CTL) + CW_MBCNT; unsigned* LIST = (unsigned*)(ws + WS_MBLIST);
        LAS float* kml = (LAS float*)L;
        LAS unsigned char* qst = L + 16384 + wave * 9216;
        int bhc = -1;
        for (int id = gw; id < 2048; id += NGW) {
            const int bh = id >> 7, qc = id & 127, b = bh >> 3, h = bh & 7, q = qc * 64 + lane, own = (qc * 64) >> 8;
            if (bh != bhc) { __syncthreads(); *(LAS f32x4*)(kml + (tid >> 4) * 68 + (tid & 15) * 4) = *(const f32x4*)(KM + (size_t)bh * 2048 + tid * 4); bhc = bh; __syncthreads(); }
            { const bf16* qb = P1 + ((size_t)b * T_ + qc * 64) * 3072 + h * 64; v4u t[8];
#pragma unroll
              for (int j = 0; j < 8; ++j) t[j] = *(const v4u*)(qb + (size_t)(8 * j + (lane >> 3)) * 3072 + (lane & 7) * 8);
#pragma unroll
              for (int j = 0; j < 8; ++j) *(LAS v4u*)(qst + (8 * j + (lane >> 3)) * 144 + (lane & 7) * 16) = t[j]; }
            const int ql = lane & 31, hf = lane >> 5;
            f32x16 sc[2]; sc[0] = f32x16{}; sc[1] = f32x16{};
#pragma unroll
            for (int ks = 0; ks < 4; ++ks) {
                const f32x4 x0 = *(const LAS f32x4*)(kml + ql * 68 + ks * 16 + hf * 8), x1 = *(const LAS f32x4*)(kml + ql * 68 + ks * 16 + hf * 8 + 4);
                const float xv[8] = {x0.x, x0.y, x0.z, x0.w, x1.x, x1.y, x1.z, x1.w};
                unsigned hb[8], lb[8];
#pragma unroll
                for (int j = 0; j < 8; ++j) { hb[j] = f2bf(xv[j]); lb[j] = f2bf(xv[j] - bf2f((unsigned short)hb[j])); }
                const bf16x8 ahi = __builtin_bit_cast(bf16x8, (v4u){hb[0] | (hb[1] << 16), hb[2] | (hb[3] << 16), hb[4] | (hb[5] << 16), hb[6] | (hb[7] << 16)});
                const bf16x8 alo = __builtin_bit_cast(bf16x8, (v4u){lb[0] | (lb[1] << 16), lb[2] | (lb[3] << 16), lb[4] | (lb[5] << 16), lb[6] | (lb[7] << 16)});
#pragma unroll
                for (int t = 0; t < 2; ++t) { const bf16x8 bq = *(const LAS bf16x8*)(qst + (t * 32 + ql) * 144 + ks * 32 + hf * 16);
                    sc[t] = __builtin_amdgcn_mfma_f32_32x32x16_bf16(ahi, bq, sc[t], 0, 0, 0);
                    sc[t] = __builtin_amdgcn_mfma_f32_32x32x16_bf16(alo, bq, sc[t], 0, 0, 0); }
            }
            float b0 = -INFINITY, b1 = -INFINITY, b2 = -INFINITY; int i0 = -1, i1 = -1, i2 = -1;
#pragma unroll
            for (int t = 0; t < 2; ++t) {
                float c0 = -INFINITY, c1 = -INFINITY, c2 = -INFINITY; int j0 = -1, j1 = -1, j2 = -1;
#pragma unroll
                for (int r = 0; r < 16; ++r) { const int n = crow(r, hf); const float g = sc[t][r];
                    if (n < own) {
                        if (g > c0) { c2 = c1; j2 = j1; c1 = c0; j1 = j0; c0 = g; j0 = n; }
                        else if (g > c1) { c2 = c1; j2 = j1; c1 = g; j1 = n; }
                        else if (g > c2) { c2 = g; j2 = n; } } }
                const float o0 = __shfl_xor(c0, 32), o1 = __shfl_xor(c1, 32), o2 = __shfl_xor(c2, 32); const int p0 = __shfl_xor(j0, 32), p1 = __shfl_xor(j1, 32), p2 = __shfl_xor(j2, 32);
#define MB_INS(G_, N_) do { const float g_ = (G_); const int n_ = (N_); \
                    if (n_ >= 0) { \
                        if (g_ > c0 || (g_ == c0 && n_ < j0)) { c2 = c1; j2 = j1; c1 = c0; j1 = j0; c0 = g_; j0 = n_; } \
                        else if (g_ > c1 || (g_ == c1 && n_ < j1)) { c2 = c1; j2 = j1; c1 = g_; j1 = n_; } \
                        else if (g_ > c2 || (g_ == c2 && n_ < j2)) { c2 = g_; j2 = n_; } } } while (0)
                MB_INS(o0, p0); MB_INS(o1, p1); MB_INS(o2, p2);
#undef MB_INS
                if (hf == t) { b0 = c0; b1 = c1; b2 = c2; i0 = j0; i1 = j1; i2 = j2; }
            }
            (void)b0; (void)b1; (void)b2;
            int mycnt = 0;
            for (int n = 0; n < own; ++n) { const unsigned long long mask = __ballot((i0 == n) || (i1 == n) || (i2 == n)); if (lane == n) mycnt = __builtin_popcountll(mask); }
            unsigned mybase = 0u;
            if (mycnt > 0) mybase = __hip_atomic_fetch_add(mcnt + (bh * 32 + lane) * 16, (unsigned)mycnt, __ATOMIC_RELAXED, __HIP_MEMORY_SCOPE_AGENT);
            for (int n = 0; n < own; ++n) {
                const int sl = (i0 == n) ? 0 : (i1 == n) ? 1 : (i2 == n) ? 2 : -1;
                const unsigned long long mask = __ballot(sl >= 0);
                const unsigned base = __shfl(mybase, n);
                if (sl >= 0) LIST[(size_t)bh * MBL_PER_BH + mbl_off(n) + base + (unsigned)__builtin_popcountll(mask & ((1ull << lane) - 1ull))] = (unsigned)q | ((unsigned)sl << 13);
            }
        }
        if (BOTH(13)) xcd_barrier(bar);
    }
    if (IN(14)) for (int rep = 0; rep < REPS[14]; ++rep) {
        const bf16* P1 = (const bf16*)(ws + WS_PROJ1); bf16* MIX = (bf16*)(ws + WS_U);
        const float* BT = (const float*)(ws + WS_BIAS);
        const unsigned* mcnt = (const unsigned*)(ws + WS_CTL) + CW_MBCNT; const unsigned* LIST = (const unsigned*)(ws + WS_MBLIST);
        LAS int* pre = (LAS int*)(L + UT_OFF); LAS int* cntL = pre + 513;
        __syncthreads();
        { const int c = (int)__hip_atomic_load(mcnt + tid * 16, __ATOMIC_RELAXED, __HIP_MEMORY_SCOPE_AGENT); cntL[tid] = c; pre[tid + 1] = (c + 255) >> 8; if (tid == 0) pre[0] = 0; }
        __syncthreads();
        if (tid < 64) {
            int v[8], sum = 0;
#pragma unroll
            for (int j = 0; j < 8; ++j) { v[j] = pre[1 + tid * 8 + j]; sum += v[j]; }
            int inc = sum;
#pragma unroll
            for (int o = 1; o < 64; o <<= 1) { const int x = __shfl_up(inc, o); if (tid >= o) inc += x; }
            int run = inc - sum;
#pragma unroll
            for (int j = 0; j < 8; ++j) { run += v[j]; pre[1 + tid * 8 + j] = run; }
        }
        __syncthreads();
        const int nchunks = pre[512], per = (nchunks + G - 1) / G;
        int hcur = -1;
        MobaArgs mb; mb.PARTO = (bf16*)(ws + WS_PARTO); mb.PARTML = (f32x2*)(ws + WS_PARTML);
        int icur = -1;
        for (int rc = 0; rc < REP_CH; ++rc)
        for (int u = vcu * per; u < (vcu + 1) * per && u < nchunks; ++u) {
            int lo = 0, hi_ = 512;
            while (hi_ - lo > 1) { const int mid = (lo + hi_) >> 1; if (pre[mid] <= u) lo = mid; else hi_ = mid; }
            const int i = __builtin_amdgcn_readfirstlane(lo), c = u - __builtin_amdgcn_readfirstlane(pre[lo]), bh = i >> 5, n = i & 31, b = bh >> 3, h = bh & 7, cn = __builtin_amdgcn_readfirstlane(cntL[i]);
            const size_t r0 = (size_t)b * T_;
            if (i != icur) {
                __syncthreads();
                moba_resident_load(L, P1 + (r0 + (size_t)n * 256) * 3072 + 512 + h * 64, P1 + (r0 + (size_t)n * 256) * 3072 + 1024 + h * 64, tid);
                if (h != hcur) { LAS float* tb = (LAS float*)(L + RB_OFF); for (int j = tid; j < 64 + 8192; j += NWAVES * 64) tb[j] = (j >= 64) ? BT[h * 8192 + (j - 64)] : 0.f; hcur = h; }
                icur = i;
                __syncthreads();
            }
            if ((c * 256 + 32 * wave) < cn) {
                const int e = c * 256 + 32 * wave + (lane & 31); const bool valid = e < cn; const unsigned ent = LIST[(size_t)bh * MBL_PER_BH + mbl_off(n) + (valid ? e : cn - 1)];
                moba_resident_wave(L, P1 + r0 * 3072 + h * 64, n, (int)(ent & 8191u), (int)(ent >> 13), valid, bh * 8192, mb.PARTO, mb.PARTML, lane, wave);
            }
        }
        hcur = -1;
        for (int id = vcu; id < 512; id += G) {
            const int bh = id >> 5, qb = 31 - (id & 31), b = bh >> 3, h = bh & 7, q0u = qb * 256, q0w = q0u + 32 * wave; const size_t r0 = (size_t)b * T_;
            if (h != hcur) {
                __syncthreads();
                LAS float* tb = (LAS float*)(L + ABIAS_OFF);
                for (int j = tid; j < 64 + 512; j += NWAVES * 64) tb[j] = (j >= 64) ? BT[h * 8192 + (j - 64)] : 0.f;
                hcur = h;
                __syncthreads();
            }
            mb.q = 0; mb.slot = 3; mb.valid = true; mb.wvalid = true; mb.bhbase = bh * 8192;
            AttnPtrs a; a.Q = P1 + (r0 + q0w) * 3072 + h * 64; a.qs = 3072; a.K = P1 + r0 * 3072 + 512 + h * 64; a.ks = 3072; a.K2 = nullptr;
            a.V = P1 + r0 * 3072 + 1024 + h * 64; a.vs = 3072; a.O = MIX + (r0 + q0w) * 1024 + h * 64;
            attn_unit<AM_MOBAO>(L, a, q0u, q0w, 4 * qb, 4 * qb + 3, 0.125f * LOG2E, 0.f, mb, 0, nullptr, tid, lane, wave);
        }
        for (int id = vcu; id < 512; id += G) {
            const int bh = id >> 5, qb = 31 - (id & 31), b = bh >> 3, h = bh & 7, q0u = qb * 256, q0w = q0u + 32 * wave; const size_t r0 = (size_t)b * T_;
            AttnPtrs a; a.Q = P1 + (r0 + q0w) * 3072 + 1536 + h * 64; a.qs = 3072; a.K = P1 + r0 * 3072 + 2048 + h * 64; a.ks = 3072; a.K2 = nullptr;
            a.V = P1 + r0 * 3072 + 2560 + h * 64; a.vs = 3072; a.O = MIX + (r0 + q0w) * 1024 + 512 + h * 64;
            attn_unit<AM_SB>(L, a, q0u, q0w, 0, (q0u + 255) >> 6, 0.125f * LOG2E, 0.f, mb, 0, nullptr, tid, lane, wave);
        }
        __syncthreads();
        if (BOTH(14) && rep == REPS[14] - 1) xcd_barrier(bar);
    }
    if (IN(15)) for (int rep = 0; rep < REPS[15]; ++rep) {
        bf16* MIX = (bf16*)(ws + WS_U); const bf16* PARTO = (const bf16*)(ws + WS_PARTO); const f32x4* PML = (const f32x4*)(ws + WS_PARTML);
        const int h = lane >> 3, d8 = (lane & 7) * 8;
        if (rep == 0) for (int m0_ = gw; m0_ < NTOK; m0_ += 2 * NGW) {
            f32x4 ml01[2], ml23[2]; v4u vo[2], v0[2], v1[2], v2[2]; int bq[2];
#pragma unroll
            for (int u = 0; u < 2; ++u) { const int m = m0_ + u * NGW < NTOK ? m0_ + u * NGW : m0_; const int b = m >> 13, q = m & 8191; bq[u] = ((b * 8 + h) * 8192 + q);
                ml01[u] = PML[(size_t)bq[u] * 2]; ml23[u] = PML[(size_t)bq[u] * 2 + 1];
                vo[u] = *(const v4u*)(MIX + (size_t)m * 1024 + h * 64 + d8);
                const v4u* pp = (const v4u*)(PARTO + (size_t)bq[u] * 3 * 64 + d8); v0[u] = pp[0]; v1[u] = pp[8]; v2[u] = pp[16]; }
#pragma unroll
            for (int u = 0; u < 2; ++u) { const int m = m0_ + u * NGW; if (m < NTOK) {
                const int q = m & 8191, nsel = (q >> 8) < 3 ? (q >> 8) : 3;
                const float m0 = nsel > 0 ? ml01[u].x : NEGBIG, m1 = nsel > 1 ? ml01[u].z : NEGBIG, m2 = nsel > 2 ? ml23[u].x : NEGBIG, mo = ml23[u].z;
                const float M = fmaxf(fmaxf(m0, m1), fmaxf(m2, mo));
                const float w0 = __builtin_amdgcn_exp2f(m0 - M), w1 = __builtin_amdgcn_exp2f(m1 - M), w2 = __builtin_amdgcn_exp2f(m2 - M), wo = __builtin_amdgcn_exp2f(mo - M);
                const float invL = 1.0f / (wo * ml23[u].w + (nsel > 0 ? w0 * ml01[u].y : 0.f) + (nsel > 1 ? w1 * ml01[u].w : 0.f) + (nsel > 2 ? w2 * ml23[u].y : 0.f));
                float acc[8]; const float co = wo * invL;
                { const v4u v = vo[u]; acc[0] = bflo(v.x) * co; acc[1] = bfhi(v.x) * co; acc[2] = bflo(v.y) * co; acc[3] = bfhi(v.y) * co; acc[4] = bflo(v.z) * co; acc[5] = bfhi(v.z) * co; acc[6] = bflo(v.w) * co; acc[7] = bfhi(v.w) * co; }
                if (nsel > 0) { const v4u v = v0[u]; const float c = w0 * invL; acc[0] += bflo(v.x) * c; acc[1] += bfhi(v.x) * c; acc[2] += bflo(v.y) * c; acc[3] += bfhi(v.y) * c; acc[4] += bflo(v.z) * c; acc[5] += bfhi(v.z) * c; acc[6] += bflo(v.w) * c; acc[7] += bfhi(v.w) * c; }
                if (nsel > 1) { const v4u v = v1[u]; const float c = w1 * invL; acc[0] += bflo(v.x) * c; acc[1] += bfhi(v.x) * c; acc[2] += bflo(v.y) * c; acc[3] += bfhi(v.y) * c; acc[4] += bflo(v.z) * c; acc[5] += bfhi(v.z) * c; acc[6] += bflo(v.w) * c; acc[7] += bfhi(v.w) * c; }
                if (nsel > 2) { const v4u v = v2[u]; const float c = w2 * invL; acc[0] += bflo(v.x) * c; acc[1] += bfhi(v.x) * c; acc[2] += bflo(v.y) * c; acc[3] += bfhi(v.y) * c; acc[4] += bflo(v.z) * c; acc[5] += bfhi(v.z) * c; acc[6] += bflo(v.w) * c; acc[7] += bfhi(v.w) * c; }
                *(v4u*)(MIX + (size_t)m * 1024 + h * 64 + d8) = (v4u){pk2(acc[0], acc[1]), pk2(acc[2], acc[3]), pk2(acc[4], acc[5]), pk2(acc[6], acc[7])}; } }
        }
        if (BOTH(15) && rep == REPS[15] - 1) xcd_barrier(bar);
    }
    if (IN(16)) {
        pg8::Gemm g{(const pg8::bf16_t*)(ws + WS_U), (const pg8::bf16_t*)(ws + WS_WOO), NTOK, 1024, 1024};
        pg8::StaticOrder S; S.init(NTOK, 1024, G, bx);
        EpiResid E{p.out, p.out};
        pg8::gemm_phase<EpiResid, pg8::StaticOrder, false, true>(L + RING_OFF, g, S, E);
        if (BOTH(16)) xcd_barrier(bar);
    }
    if (IN(17)) { moe_route(p, L, 1, p.out, gw, NGW, lane, wave); if (BOTH(17)) xcd_barrier(bar); }
    if (IN(19)) {
        int nt, nfull; moe_tables<true>(p, L, 1, tid, G, nt, nfull);
        unsigned* hcnt = (unsigned*)(ws + WS_CTL) + CW_HCNT + 1 * 160 * 16;
        const int total1 = nfull * 2, rem = total1 % G, q = (vcu + G - rem) % G;
        { pg8::Gemm g{(const pg8::bf16_t*)(ws + WS_U), (const pg8::bf16_t*)(ws + WS_MOEW + 48 * MiB), nt * 256, 32 * 512, 1024};
          MoeOrderG<2> S{total1, G, vcu, L + MOE_T2E_OFF, (const LAS int*)(L + MOE_T2E_OFF + 256), (const LAS int*)(L + MOE_T2E_OFF + 512), (const int*)(ws + WS_EL), hcnt, L + MOE_T2E_OFF + 640};
          EpiSwiGLU E{(bf16*)(ws + WS_HH), (const f32x2*)(ws + WS_EW), L + MOE_T2E_OFF, (const LAS int*)(L + MOE_T2E_OFF + 256)};
          pg8::gemm_phase_g<EpiSwiGLU, MoeOrderG<2>, false, true>(L + RING_OFF, g, S, E); }
        __syncthreads();
        moe_tail_units(p, L, (const bf16*)(ws + WS_MOEW + 48 * MiB), hcnt, nfull, nt, q, G, tid, lane, wave);
        { pg8::Gemm g{(const pg8::bf16_t*)(ws + WS_HH), (const pg8::bf16_t*)(ws + WS_MOEW + 80 * MiB), nt * 256, 32 * 1024, 256};
          MoeOrderD<4> S{nt * 4, L + MOE_T2E_OFF, L + MOE_T2E_OFF + 640, hcnt, (unsigned*)(ws + WS_CTL) + CW_TICK + 1 * 64, (LAS unsigned*)(L + MOE_T2E_OFF + 804)};
          EpiStore E{(bf16*)(ws + WS_XG), 1024, 3};
          pg8::gemm_phase<EpiStore, MoeOrderD<4>, false, true>(L + RING_OFF, g, S, E); }
        if (BOTH(19)) xcd_barrier(bar);
    }
    if (IN(21)) { int nt, nfl; moe_tables<false>(p, L, 1, tid, G, nt, nfl); moe_combine<true>(p, L, p.out, p.in[3], gw, NGW, lane); }
#undef IN
#undef BOTH
}
extern "C" void kernel_launch(void* const* d_in, const int* in_sizes, int n_in, void* d_out, int out_size, void* d_ws, size_t ws_size, hipStream_t stream) {
    static int grid = 0;
    if (grid == 0) {
        int dev = 0, cus = 0;
        if (n_in != 21 || in_sizes[0] != NTOK * DM || out_size != NTOK * DM || ws_size < 282 * MiB) { fprintf(stderr, "kernel_launch: unexpected n_in %d / sizes / ws_size %zu; nothing launched\n", n_in, ws_size); grid = -1; return; }
        if (hipGetDevice(&dev) != hipSuccess || hipDeviceGetAttribute(&cus, hipDeviceAttributeMultiprocessorCount, dev) != hipSuccess) { grid = -1; return; }
        if (hipFuncSetAttribute((const void*)mega, hipFuncAttributeMaxDynamicSharedMemorySize, LDS_BYTES) != hipSuccess) { fprintf(stderr, "kernel_launch: hipFuncSetAttribute failed\n"); grid = -1; return; }
        (void)hipGetLastError();
        grid = cus;
    }
    if (grid < 0) return;
    (void)hipMemsetAsync((char*)d_ws + WS_CTL, 0, CTL_ZERO_BYTES, stream);
    Params p{};
    for (int i = 0; i < 21; ++i) p.in[i] = (const float*)d_in[i];
    p.out = (float*)d_out; p.ws = (unsigned char*)d_ws; p.ph_lo = 0; p.ph_hi = 22; p.li = 0;
    hipLaunchKernelGGL(mega, dim3(grid), dim3(NWAVES * 64), LDS_BYTES, stream, p);
}
```

```cpp
#include <hip/hip_runtime.h>
#include <stdint.h>
#include <math.h>
#include <cstdio>

constexpr int NB = 2, T_ = 8192, DM = 1024, NTOK = NB * T_;
constexpr float RMS_EPS = 1e-6f;
#define GAS __attribute__((address_space(1)))
#define LAS __attribute__((address_space(3)))
__device__ __forceinline__ int otid() { int t = threadIdx.x; asm volatile("" : "+v"(t)); return t; }
namespace pg8 {
#define PG8_LAS __attribute__((address_space(3)))
typedef unsigned short bf16_t;
typedef short bf16x8 __attribute__((ext_vector_type(8)));
typedef float f32x4 __attribute__((ext_vector_type(4)));
typedef unsigned u32x4 __attribute__((ext_vector_type(4)));
constexpr int BM = 256, BK = 64, HALF = 128, HTB = HALF * BK * 2  , STAGE_BYTES = 8 * HTB, NXCD = 8, WGM = 8;

__host__ __device__ __forceinline__ int lds_byte(int r, int c) { const int st = (r >> 4) * 2 + (c >> 5), rr = r & 15, cc = c & 31, ob = rr * 64 + cc * 2; return st * 1024 + (ob ^ (((ob >> 9) & 1) << 5)); }
__host__ __device__ __forceinline__ void stage_rc(int b, int& R, int& C) { const int st = b / 1024, sb = b % 1024, swz = sb ^ (((sb >> 9) & 1) << 5); R = (st >> 1) * 16 + swz / 64; C = (st & 1) * 32 + (swz % 64) / 2; }
__host__ __device__ __forceinline__ int perm32(int rho) { const int n = rho >> 4, i = rho & 15; return 8 * (i >> 2) + 4 * n + (i & 3); }

struct Unit { int pm, pn; };
struct Gemm { const bf16_t* A; const bf16_t* Bt; int M, N, K; };

struct StaticOrder {
    int nM, nN, nwg, G, c;
    __host__ __device__ void init(int M, int N, int G_, int c_) { nM = M / BM; nN = N / BM; nwg = nM * nN; G = G_; c = c_; }
    __host__ __device__ __forceinline__ bool next(int i, Unit& u) const {
        const long L = (long)i * G + c; if (L >= nwg) return false;
        int wgid = (int)L; { const int q = nwg / NXCD, r = nwg % NXCD, xcd = wgid % NXCD, off = wgid / NXCD; wgid = (xcd < r ? xcd * (q + 1) : r * (q + 1) + (xcd - r) * q) + off; }
        const int nig = WGM * nN, gid = wgid / nig, fm = gid * WGM, gsz = (nM - fm) < WGM ? (nM - fm) : WGM;
        u.pm = fm + ((wgid % nig) % gsz); u.pn = (wgid % nig) / gsz; return true;
    }
    __device__ __forceinline__ void a_ready(const Unit&) const {}
    __device__ __forceinline__ void done(const Unit&) const {}
};

__device__ __forceinline__ unsigned cvt_pk_bf16(float lo, float hi) { unsigned r; asm volatile("v_cvt_pk_bf16_f32 %0, %1, %2" : "=v"(r) : "v"(lo), "v"(hi)); return r; }
template <class Epi, class Sched, bool ALIGN_EPI = false, bool SP2 = false>
__device__ __forceinline__ void gemm_phase(PG8_LAS unsigned char* lds, const Gemm g, const Sched& S, const Epi& E) {
    const int tid = otid(), wid = __builtin_amdgcn_readfirstlane(tid >> 6), lane = tid & 63, wr = wid >> 2, wc = wid & 3, fr = lane & 15, fq = lane >> 4;
    const int K = g.K, nt = K / BK;
    unsigned voffA[2], voffB[2];
#pragma unroll
    for (int i = 0; i < 2; ++i) { int R, C; stage_rc(tid * 16 + i * 8192, R, C); const int Rb = Epi::PERM ? ((R & ~31) + perm32(R & 31)) : R;
        voffA[i] = (unsigned)(R * K + C) * 2u; voffB[i] = (unsigned)(Rb * K + C) * 2u; }
    const size_t kstep = (size_t)(BK * 2);
    const size_t hstep = (size_t)HALF * K * 2;
    const size_t tstep = 2 * hstep;
    const unsigned ldsw = (unsigned)wid * 1024u;
    const int aoff = lds_byte(wr * 64 + fr, fq * 8), boff = lds_byte(wc * 32 + fr, fq * 8);
#define PG8_SA(b, h) (((b) * 2 + (h)) * HTB)
#define PG8_SB(b, h) ((4 + (b) * 2 + (h)) * HTB)
#define PG8_STAGE(bufoff, gbase, voff) do { _Pragma("unroll") for (int _i = 0; _i < 2; ++_i) \
        __builtin_amdgcn_global_load_lds((const unsigned*)((const char*)(gbase) + (voff)[_i]), (PG8_LAS unsigned*)(lds + (bufoff) + ldsw + _i * 8192), 16, 0, 0); } while (0)
#define PG8_LDA(dst, b, h) do { _Pragma("unroll") for (int m = 0; m < 4; ++m) _Pragma("unroll") for (int k = 0; k < 2; ++k) dst[m][k] = *(const PG8_LAS bf16x8*)(lds + PG8_SA(b, h) + aoff + m * 2048 + k * 1024); } while (0)
#define PG8_LDB(dst, b, h) do { _Pragma("unroll") for (int n = 0; n < 2; ++n) _Pragma("unroll") for (int k = 0; k < 2; ++k) dst[n][k] = *(const PG8_LAS bf16x8*)(lds + PG8_SB(b, h) + boff + n * 2048 + k * 1024); } while (0)
#define PG8_MMA(ai, bj, At, Bt) do { __builtin_amdgcn_s_setprio(1); _Pragma("unroll") for (int m = 0; m < 4; ++m) _Pragma("unroll") for (int n = 0; n < 2; ++n) _Pragma("unroll") for (int k = 0; k < 2; ++k) \
        acc[ai][bj][m][n] = __builtin_amdgcn_mfma_f32_16x16x32_bf16(Bt[n][k], At[m][k], acc[ai][bj][m][n], 0, 0, 0); __builtin_amdgcn_s_setprio(0); } while (0)
#define PG8_WAIT_V(n) asm volatile("s_waitcnt vmcnt(" #n ")" ::: "memory")
#define PG8_WAIT_L(n) asm volatile("s_waitcnt lgkmcnt(" #n ")" ::: "memory")
#define PG8_BAR __builtin_amdgcn_s_barrier()
#define PG8_SCHED __builtin_amdgcn_sched_barrier(0)
    Unit cur, nxt; int ui = 0;
    if (!S.next(0, cur)) return;
    f32x4 acc[2][2][4][2];
#pragma unroll
    for (int a = 0; a < 2; ++a)
#pragma unroll
        for (int b = 0; b < 2; ++b)
#pragma unroll
            for (int m = 0; m < 4; ++m)
#pragma unroll
                for (int n = 0; n < 2; ++n) acc[a][b][m][n] = (f32x4){0.f, 0.f, 0.f, 0.f};
    bf16x8 At[4][2], B0[2][2], B1[2][2];
    const char* cA = (const char*)g.A + (size_t)cur.pm * tstep; const char* cB = (const char*)g.Bt + (size_t)cur.pn * tstep;
    S.a_ready(cur);
    if constexpr (SP2) {
        PG8_STAGE(PG8_SB(0, 0), cB, voffB); PG8_STAGE(PG8_SB(0, 1), cB + hstep, voffB); PG8_STAGE(PG8_SA(0, 0), cA, voffA); PG8_STAGE(PG8_SA(0, 1), cA + hstep, voffA);
        if (wr == 1) PG8_BAR;
        PG8_WAIT_V(2); PG8_BAR;
        PG8_STAGE(PG8_SB(1, 0), cB + kstep, voffB); PG8_STAGE(PG8_SA(1, 0), cA + kstep, voffA); PG8_STAGE(PG8_SB(1, 1), cB + hstep + kstep, voffB);
        PG8_WAIT_V(6); PG8_BAR;
    } else {
        PG8_STAGE(PG8_SB(0, 0), cB, voffB); PG8_STAGE(PG8_SA(0, 0), cA, voffA); PG8_STAGE(PG8_SB(0, 1), cB + hstep, voffB); PG8_STAGE(PG8_SA(0, 1), cA + hstep, voffA);
        if (wr == 1) PG8_BAR;
        PG8_WAIT_V(4); PG8_BAR;
        PG8_STAGE(PG8_SB(1, 0), cB + kstep, voffB); PG8_STAGE(PG8_SA(1, 0), cA + kstep, voffA); PG8_STAGE(PG8_SB(1, 1), cB + hstep + kstep, voffB);
        PG8_WAIT_V(6); PG8_BAR;
    }
    for (;;) {
        const bool has_next = S.next(ui + 1, nxt);
        const char* nA = has_next ? (const char*)g.A + (size_t)nxt.pm * tstep : cA; const char* nB = has_next ? (const char*)g.Bt + (size_t)nxt.pn * tstep : cB;
        for (int t = 0; t < nt; t += 2) {
            const bool last = (t == nt - 2);
            const char* a1 = cA + (size_t)(t + 1) * kstep;
            const char* a2 = last ? nA : cA + (size_t)(t + 2) * kstep; const char* b2 = last ? nB : cB + (size_t)(t + 2) * kstep;
            const char* a3 = a2 + kstep; const char* b3 = b2 + kstep;
            if (last && has_next) S.a_ready(nxt);
            if constexpr (SP2) {
            PG8_LDB(B0, 0, 0); PG8_LDB(B1, 0, 1); PG8_SCHED; PG8_LDA(At, 0, 0); PG8_STAGE(PG8_SA(1, 1), a1 + hstep, voffA);
            PG8_WAIT_V(8); PG8_WAIT_L(0); PG8_BAR; PG8_MMA(0, 0, At, B0); PG8_MMA(0, 1, At, B1); PG8_BAR; PG8_SCHED;
            PG8_LDA(At, 0, 1); PG8_STAGE(PG8_SB(0, 0), b2, voffB); PG8_STAGE(PG8_SB(0, 1), b2 + hstep, voffB); PG8_STAGE(PG8_SA(0, 0), a2, voffA);
            PG8_WAIT_V(8); PG8_WAIT_L(0); PG8_BAR; PG8_MMA(1, 0, At, B0); PG8_MMA(1, 1, At, B1); PG8_BAR; PG8_SCHED;
            PG8_LDB(B0, 1, 0); PG8_LDB(B1, 1, 1); PG8_SCHED; PG8_LDA(At, 1, 0); PG8_STAGE(PG8_SA(0, 1), a2 + hstep, voffA);
            PG8_WAIT_V(8); PG8_WAIT_L(0); PG8_BAR; PG8_MMA(0, 0, At, B0); PG8_MMA(0, 1, At, B1); PG8_BAR; PG8_SCHED;
            PG8_LDA(At, 1, 1); PG8_STAGE(PG8_SB(1, 0), b3, voffB); PG8_STAGE(PG8_SB(1, 1), b3 + hstep, voffB); PG8_STAGE(PG8_SA(1, 0), a3, voffA);
            PG8_WAIT_V(8); PG8_WAIT_L(0); PG8_BAR; PG8_MMA(1, 0, At, B0); PG8_MMA(1, 1, At, B1); PG8_BAR; PG8_SCHED;
            } else {
            PG8_LDB(B0, 0, 0); PG8_SCHED; PG8_LDA(At, 0, 0); PG8_STAGE(PG8_SA(1, 1), a1 + hstep, voffA);
            PG8_WAIT_L(8); PG8_BAR; PG8_WAIT_L(0); PG8_MMA(0, 0, At, B0); PG8_BAR; PG8_SCHED;
            PG8_LDB(B1, 0, 1); PG8_STAGE(PG8_SB(0, 0), b2, voffB);
            PG8_BAR; PG8_WAIT_L(0); PG8_MMA(0, 1, At, B1); PG8_BAR;
            PG8_LDA(At, 0, 1); PG8_STAGE(PG8_SA(0, 0), a2, voffA);
            PG8_BAR; PG8_WAIT_L(0); PG8_MMA(1, 0, At, B0); PG8_BAR; PG8_SCHED;
            PG8_STAGE(PG8_SB(0, 1), b2 + hstep, voffB);
            PG8_WAIT_V(6); PG8_BAR; PG8_MMA(1, 1, At, B1); PG8_BAR;
            PG8_LDB(B0, 1, 0); PG8_SCHED; PG8_LDA(At, 1, 0); PG8_STAGE(PG8_SA(0, 1), a2 + hstep, voffA);
            PG8_WAIT_L(8); PG8_BAR; PG8_WAIT_L(0); PG8_MMA(0, 0, At, B0); PG8_BAR; PG8_SCHED;
            PG8_LDB(B1, 1, 1); PG8_STAGE(PG8_SB(1, 0), b3, voffB);
            PG8_BAR; PG8_WAIT_L(0); PG8_MMA(0, 1, At, B1); PG8_BAR;
            PG8_LDA(At, 1, 1); PG8_STAGE(PG8_SA(1, 0), a3, voffA);
            PG8_BAR; PG8_WAIT_L(0); PG8_MMA(1, 0, At, B0); PG8_BAR; PG8_SCHED;
            PG8_STAGE(PG8_SB(1, 1), b3 + hstep, voffB);
            PG8_WAIT_V(6); PG8_BAR; PG8_MMA(1, 1, At, B1); PG8_BAR;
            }
        }
        if constexpr (ALIGN_EPI) { if (wr == 0) PG8_BAR; }
        if constexpr (!Epi::AFTER_DRAIN) { E(acc, cur, wr, wc, fr, fq); S.done(cur); }
        if (!has_next) break;
#pragma unroll
        for (int a = 0; a < 2; ++a)
#pragma unroll
            for (int b = 0; b < 2; ++b)
#pragma unroll
                for (int m = 0; m < 4; ++m)
#pragma unroll
                    for (int n = 0; n < 2; ++n) acc[a][b][m][n] = (f32x4){0.f, 0.f, 0.f, 0.f};
        cur = nxt; cA = nA; cB = nB; ++ui;
        if constexpr (ALIGN_EPI) { if (wr == 1) PG8_BAR; }
    }
    PG8_WAIT_V(0);
    if constexpr (!ALIGN_EPI) { if (wr == 0) PG8_BAR; }
    PG8_BAR;
    if constexpr (Epi::AFTER_DRAIN) { E.fused(acc, cur, wr, wc, fr, fq, lds, wid, lane); S.done(cur); }
#undef PG8_SA
#undef PG8_SB
#undef PG8_STAGE
#undef PG8_LDA
#undef PG8_LDB
#undef PG8_MMA
#undef PG8_WAIT_V
#undef PG8_WAIT_L
#undef PG8_BAR
#undef PG8_SCHED
}

template <class Epi, class Sched, bool ALIGN_EPI = false, bool SP2 = false>
__device__ __forceinline__ void gemm_phase_g(PG8_LAS unsigned char* lds, const Gemm g, const Sched& S, const Epi& E) {
    const int tid = otid(), wid = __builtin_amdgcn_readfirstlane(tid >> 6), lane = tid & 63, wr = wid >> 2, wc = wid & 3, fr = lane & 15, fq = lane >> 4;
    const int K = g.K, nt = K / BK;
    unsigned voffA[2], voffB[2]; int RA[2], CA[2]; (void)voffA;
#pragma unroll
    for (int i = 0; i < 2; ++i) { int R, C; stage_rc(tid * 16 + i * 8192, R, C); const int Rb = Epi::PERM ? ((R & ~31) + perm32(R & 31)) : R;
        voffA[i] = (unsigned)(R * K + C) * 2u; voffB[i] = (unsigned)(Rb * K + C) * 2u; RA[i] = R; CA[i] = C; }
    const size_t kstep = (size_t)(BK * 2);
    const size_t hstep = (size_t)HALF * K * 2;
    const size_t tstep = 2 * hstep;
    const unsigned ldsw = (unsigned)wid * 1024u;
    const int aoff = lds_byte(wr * 64 + fr, fq * 8), boff = lds_byte(wc * 32 + fr, fq * 8);
#define PG8_SA(b, h) (((b) * 2 + (h)) * HTB)
#define PG8_SB(b, h) ((4 + (b) * 2 + (h)) * HTB)
#define PG8_STAGE(bufoff, gbase, voff) do { _Pragma("unroll") for (int _i = 0; _i < 2; ++_i) \
        __builtin_amdgcn_global_load_lds((const unsigned*)((const char*)(gbase) + (voff)[_i]), (PG8_LAS unsigned*)(lds + (bufoff) + ldsw + _i * 8192), 16, 0, 0); } while (0)
#define PG8_LDA(dst, b, h) do { _Pragma("unroll") for (int m = 0; m < 4; ++m) _Pragma("unroll") for (int k = 0; k < 2; ++k) dst[m][k] = *(const PG8_LAS bf16x8*)(lds + PG8_SA(b, h) + aoff + m * 2048 + k * 1024); } while (0)
#define PG8_LDB(dst, b, h) do { _Pragma("unroll") for (int n = 0; n < 2; ++n) _Pragma("unroll") for (int k = 0; k < 2; ++k) dst[n][k] = *(const PG8_LAS bf16x8*)(lds + PG8_SB(b, h) + boff + n * 2048 + k * 1024); } while (0)
#define PG8_MMA(ai, bj, At, Bt) do { __builtin_amdgcn_s_setprio(1); _Pragma("unroll") for (int m = 0; m < 4; ++m) _Pragma("unroll") for (int n = 0; n < 2; ++n) _Pragma("unroll") for (int k = 0; k < 2; ++k) \
        acc[ai][bj][m][n] = __builtin_amdgcn_mfma_f32_16x16x32_bf16(Bt[n][k], At[m][k], acc[ai][bj][m][n], 0, 0, 0); __builtin_amdgcn_s_setprio(0); } while (0)
#define PG8_WAIT_V(n) asm volatile("s_waitcnt vmcnt(" #n ")" ::: "memory")
#define PG8_WAIT_L(n) asm volatile("s_waitcnt lgkmcnt(" #n ")" ::: "memory")
#define PG8_BAR __builtin_amdgcn_s_barrier()
#define PG8_SCHED __builtin_amdgcn_sched_barrier(0)
    Unit cur, nxt; int ui = 0;
    if (!S.next(0, cur)) return;
    f32x4 acc[2][2][4][2];
#pragma unroll
    for (int a = 0; a < 2; ++a)
#pragma unroll
        for (int b = 0; b < 2; ++b)
#pragma unroll
            for (int m = 0; m < 4; ++m)
#pragma unroll
                for (int n = 0; n < 2; ++n) acc[a][b][m][n] = (f32x4){0.f, 0.f, 0.f, 0.f};
    bf16x8 At[4][2], B0[2][2], B1[2][2];
    const char* cA = (const char*)g.A; const char* cB = (const char*)g.Bt + (size_t)cur.pn * tstep;
    unsigned gC[2][2], gN[2][2];
#pragma unroll
    for (int h = 0; h < 2; ++h)
#pragma unroll
        for (int i = 0; i < 2; ++i) gC[h][i] = S.goff(cur, h, RA[i], CA[i]);
    S.a_ready(cur);
    if constexpr (SP2) {
        PG8_STAGE(PG8_SB(0, 0), cB, voffB); PG8_STAGE(PG8_SB(0, 1), cB + hstep, voffB); PG8_STAGE(PG8_SA(0, 0), cA, gC[0]); PG8_STAGE(PG8_SA(0, 1), cA, gC[1]);
        if (wr == 1) PG8_BAR;
        PG8_WAIT_V(2); PG8_BAR;
        PG8_STAGE(PG8_SB(1, 0), cB + kstep, voffB); PG8_STAGE(PG8_SA(1, 0), cA + kstep, gC[0]); PG8_STAGE(PG8_SB(1, 1), cB + hstep + kstep, voffB);
        PG8_WAIT_V(6); PG8_BAR;
    } else {
        PG8_STAGE(PG8_SB(0, 0), cB, voffB); PG8_STAGE(PG8_SA(0, 0), cA, gC[0]); PG8_STAGE(PG8_SB(0, 1), cB + hstep, voffB); PG8_STAGE(PG8_SA(0, 1), cA, gC[1]);
        if (wr == 1) PG8_BAR;
        PG8_WAIT_V(4); PG8_BAR;
        PG8_STAGE(PG8_SB(1, 0), cB + kstep, voffB); PG8_STAGE(PG8_SA(1, 0), cA + kstep, gC[0]); PG8_STAGE(PG8_SB(1, 1), cB + hstep + kstep, voffB);
        PG8_WAIT_V(6); PG8_BAR;
    }
    for (;;) {
        const bool has_next = S.next(ui + 1, nxt);
        const char* nA = cA; const char* nB = has_next ? (const char*)g.Bt + (size_t)nxt.pn * tstep : cB;
#pragma unroll
        for (int h = 0; h < 2; ++h)
#pragma unroll
            for (int i = 0; i < 2; ++i) gN[h][i] = has_next ? S.goff(nxt, h, RA[i], CA[i]) : gC[h][i];
        for (int t = 0; t < nt; t += 2) {
            const bool last = (t == nt - 2);
            const char* a1 = cA + (size_t)(t + 1) * kstep;
            const char* a2 = last ? nA : cA + (size_t)(t + 2) * kstep; const char* b2 = last ? nB : cB + (size_t)(t + 2) * kstep;
            const char* a3 = a2 + kstep; const char* b3 = b2 + kstep;
            unsigned g0[2], g1[2]; g0[0] = last ? gN[0][0] : gC[0][0]; g0[1] = last ? gN[0][1] : gC[0][1]; g1[0] = last ? gN[1][0] : gC[1][0]; g1[1] = last ? gN[1][1] : gC[1][1];
            if (last && has_next) S.a_ready(nxt);
            if constexpr (SP2) {
            PG8_LDB(B0, 0, 0); PG8_LDB(B1, 0, 1); PG8_SCHED; PG8_LDA(At, 0, 0); PG8_STAGE(PG8_SA(1, 1), a1, gC[1]);
            PG8_WAIT_V(8); PG8_WAIT_L(0); PG8_BAR; PG8_MMA(0, 0, At, B0); PG8_MMA(0, 1, At, B1); PG8_BAR; PG8_SCHED;
            PG8_LDA(At, 0, 1); PG8_STAGE(PG8_SB(0, 0), b2, voffB); PG8_STAGE(PG8_SB(0, 1), b2 + hstep, voffB); PG8_STAGE(PG8_SA(0, 0), a2, g0);
            PG8_WAIT_V(8); PG8_WAIT_L(0); PG8_BAR; PG8_MMA(1, 0, At, B0); PG8_MMA(1, 1, At, B1); PG8_BAR; PG8_SCHED;
            PG8_LDB(B0, 1, 0); PG8_LDB(B1, 1, 1); PG8_SCHED; PG8_LDA(At, 1, 0); PG8_STAGE(PG8_SA(0, 1), a2, g1);
            PG8_WAIT_V(8); PG8_WAIT_L(0); PG8_BAR; PG8_MMA(0, 0, At, B0); PG8_MMA(0, 1, At, B1); PG8_BAR; PG8_SCHED;
            PG8_LDA(At, 1, 1); PG8_STAGE(PG8_SB(1, 0), b3, voffB); PG8_STAGE(PG8_SB(1, 1), b3 + hstep, voffB); PG8_STAGE(PG8_SA(1, 0), a3, g0);
            PG8_WAIT_V(8); PG8_WAIT_L(0); PG8_BAR; PG8_MMA(1, 0, At, B0); PG8_MMA(1, 1, At, B1); PG8_BAR; PG8_SCHED;
            } else {
            PG8_LDB(B0, 0, 0); PG8_SCHED; PG8_LDA(At, 0, 0); PG8_STAGE(PG8_SA(1, 1), a1, gC[1]);
            PG8_WAIT_L(8); PG8_BAR; PG8_WAIT_L(0); PG8_MMA(0, 0, At, B0); PG8_BAR; PG8_SCHED;
            PG8_LDB(B1, 0, 1); PG8_STAGE(PG8_SB(0, 0), b2, voffB);
            PG8_BAR; PG8_WAIT_L(0); PG8_MMA(0, 1, At, B1); PG8_BAR;
            PG8_LDA(At, 0, 1); PG8_STAGE(PG8_SA(0, 0), a2, g0);
            PG8_BAR; PG8_WAIT_L(0); PG8_MMA(1, 0, At, B0); PG8_BAR; PG8_SCHED;
            PG8_STAGE(PG8_SB(0, 1), b2 + hstep, voffB);
            PG8_WAIT_V(6); PG8_BAR; PG8_MMA(1, 1, At, B1); PG8_BAR;
            PG8_LDB(B0, 1, 0); PG8_SCHED; PG8_LDA(At, 1, 0); PG8_STAGE(PG8_SA(0, 1), a2, g1);
            PG8_WAIT_L(8); PG8_BAR; PG8_WAIT_L(0); PG8_MMA(0, 0, At, B0); PG8_BAR; PG8_SCHED;
            PG8_LDB(B1, 1, 1); PG8_STAGE(PG8_SB(1, 0), b3, voffB);
            PG8_BAR; PG8_WAIT_L(0); PG8_MMA(0, 1, At, B1); PG8_BAR;
            PG8_LDA(At, 1, 1); PG8_STAGE(PG8_SA(1, 0), a3, g0);
            PG8_BAR; PG8_WAIT_L(0); PG8_MMA(1, 0, At, B0); PG8_BAR; PG8_SCHED;
            PG8_STAGE(PG8_SB(1, 1), b3 + hstep, voffB);
            PG8_WAIT_V(6); PG8_BAR; PG8_MMA(1, 1, At, B1); PG8_BAR;
            }
        }
        if constexpr (ALIGN_EPI) { if (wr == 0) PG8_BAR; }
        if constexpr (!Epi::AFTER_DRAIN) { E(acc, cur, wr, wc, fr, fq); S.done(cur); }
        if (!has_next) break;
#pragma unroll
        for (int a = 0; a < 2; ++a)
#pragma unroll
            for (int b = 0; b < 2; ++b)
#pragma unroll
                for (int m = 0; m < 4; ++m)
#pragma unroll
                    for (int n = 0; n < 2; ++n) acc[a][b][m][n] = (f32x4){0.f, 0.f, 0.f, 0.f};
        cur = nxt; cA = nA; cB = nB; ++ui;
#pragma unroll
        for (int h = 0; h < 2; ++h)
#pragma unroll
            for (int i = 0; i < 2; ++i) gC[h][i] = gN[h][i];
        if constexpr (ALIGN_EPI) { if (wr == 1) PG8_BAR; }
    }
    PG8_WAIT_V(0);
    if constexpr (!ALIGN_EPI) { if (wr == 0) PG8_BAR; }
    PG8_BAR;
    if constexpr (Epi::AFTER_DRAIN) { E.fused(acc, cur, wr, wc, fr, fq, lds, wid, lane); S.done(cur); }
#undef PG8_SA
#undef PG8_SB
#undef PG8_STAGE
#undef PG8_LDA
#undef PG8_LDB
#undef PG8_MMA
#undef PG8_WAIT_V
#undef PG8_WAIT_L
#undef PG8_BAR
#undef PG8_SCHED
}
}
#define XB_TMO      128
#define XB_XCNT(j)  (256  + 64 * (j))
#define XB_XSUB(j)  (1280 + 64 * (j))
#define XB_XGEN(j)  (2304 + 64 * (j))
#define XB_TOP      3328
#define XB_TOPGEN   3392
#define XCD_BAR_WORDS 3456
#define XB_SPIN_CAP (1u << 18)

__device__ __forceinline__ unsigned xb_ld(unsigned* p)              { return __hip_atomic_load(p, __ATOMIC_RELAXED, __HIP_MEMORY_SCOPE_AGENT); }
__device__ __forceinline__ unsigned xb_add(unsigned* p, unsigned v) { return __hip_atomic_fetch_add(p, v, __ATOMIC_RELAXED, __HIP_MEMORY_SCOPE_AGENT); }
__device__ __forceinline__ unsigned xb_xcc_id() { return (unsigned)__builtin_amdgcn_s_getreg((3 << 11) | 20) & 0xFu; }
#define XB_SPIN(cond, bar) do { unsigned _sp = 0; while (cond) { __builtin_amdgcn_s_sleep(1); \
    if ((++_sp & 255u) == 0u) { if (xb_ld(&(bar)[XB_TMO])) break; if (_sp > XB_SPIN_CAP) { atomicAdd(&(bar)[XB_TMO], 1u); break; } } } } while (0)

struct XcdBarrier {
    unsigned* bar; unsigned x;
    volatile LAS unsigned* st;
};

__device__ __forceinline__ XcdBarrier xcd_barrier_post(unsigned* bar, volatile LAS unsigned* st) {
    XcdBarrier b; b.bar = bar; b.x = xb_xcc_id(); b.st = st;
    if (threadIdx.x == 0) (void)xb_add(&bar[XB_XCNT(b.x)], 1u);
    return b;
}
__device__ __forceinline__ void xcd_barrier_complete(unsigned* bar, unsigned x, unsigned& nloc, unsigned& nx) {
    const unsigned G = gridDim.x * gridDim.y * gridDim.z;
    unsigned sum, cnt, mine, sp = 0u;
    for (;;) {
        sum = 0u; cnt = 0u; mine = 0u;
#pragma unroll
        for (unsigned j = 0; j < 16; ++j) { const unsigned c = xb_ld(&bar[XB_XCNT(j)]); sum += c; cnt += (c > 0u) ? 1u : 0u; mine = (j == x) ? c : mine; }
        if (sum == G) break;
        __builtin_amdgcn_s_sleep(1);
        if ((++sp & 255u) == 0u) { if (xb_ld(&bar[XB_TMO])) break; if (sp > XB_SPIN_CAP) { atomicAdd(&bar[XB_TMO], 1u); break; } }
    }
    nloc = mine > 0u ? mine : 1u; nx = cnt > 0u ? cnt : 1u;
}

__device__ __forceinline__ void xcd_barrier(const XcdBarrier& b) {
    asm volatile("s_waitcnt vmcnt(0)" ::: "memory");
    __syncthreads();
    if (threadIdx.x == 0) {
        unsigned* bar = b.bar;
        __builtin_amdgcn_s_waitcnt(0);
        unsigned nloc = b.st[0], nx = b.st[1];
        if (nloc == 0u) { xcd_barrier_complete(bar, b.x, nloc, nx); b.st[0] = nloc; b.st[1] = nx; }
        const unsigned old = xb_add(&bar[XB_XSUB(b.x)], 1u);
        const unsigned gen = old / nloc;
        if (old + 1u == (gen + 1u) * nloc) {
            __builtin_amdgcn_fence(__ATOMIC_RELEASE, "agent");
            asm volatile("s_waitcnt vmcnt(0)" ::: "memory");
            const unsigned og = xb_add(&bar[XB_TOP], 1u);
            const unsigned tg = og / nx;
            if (og + 1u == (tg + 1u) * nx) xb_add(&bar[XB_TOPGEN], 1u);
            else XB_SPIN(xb_ld(&bar[XB_TOPGEN]) == tg, bar);
            __builtin_amdgcn_fence(__ATOMIC_ACQUIRE, "agent");
            xb_add(&bar[XB_XGEN(b.x)], 1u);
            asm volatile("s_waitcnt vmcnt(0)" ::: "memory");
        } else {
            XB_SPIN(xb_ld(&bar[XB_XGEN(b.x)]) == gen, bar);
            __builtin_amdgcn_fence(__ATOMIC_ACQUIRE, "agent");
            asm volatile("s_waitcnt vmcnt(0)" ::: "memory");
        }
    }
    __syncthreads();
}

typedef unsigned short bf16;
typedef unsigned v4u __attribute__((ext_vector_type(4)));
typedef unsigned v2u __attribute__((ext_vector_type(2)));
typedef float f32x4 __attribute__((ext_vector_type(4)));
typedef float f32x2 __attribute__((ext_vector_type(2)));
typedef float f32x16 __attribute__((ext_vector_type(16)));
typedef short bf16x8 __attribute__((ext_vector_type(8)));
typedef short s16x4 __attribute__((ext_vector_type(4)));
#define LDS_WAIT() asm volatile("s_waitcnt lgkmcnt(0)" ::: "memory")
#define VM_WAIT() asm volatile("s_waitcnt vmcnt(0)" ::: "memory")
__device__ __forceinline__ unsigned f2bf(float f) { unsigned u = __builtin_bit_cast(unsigned, f); return (u + 0x7fffu + ((u >> 16) & 1u)) >> 16; }
__device__ __forceinline__ unsigned pk2(float lo, float hi) { return f2bf(lo) | (f2bf(hi) << 16); }
__device__ __forceinline__ float bf2f(unsigned short b) { return __builtin_bit_cast(float, (unsigned)b << 16); }
__device__ __forceinline__ float bflo(unsigned w) { return __builtin_bit_cast(float, w << 16); }
__device__ __forceinline__ float bfhi(unsigned w) { return __builtin_bit_cast(float, w & 0xffff0000u); }

constexpr int NWAVES = 8;
constexpr float LOG2E = 1.4426950408889634f;
constexpr size_t MiB = 1u << 20;
constexpr size_t WS_CTL = 0, CTL_ZERO_BYTES = 1 * MiB;
constexpr size_t WS_BIAS = 1 * MiB;
constexpr size_t WS_KMEAN = 1 * MiB + 256 * 1024;
constexpr size_t WS_ROPE = 1 * MiB + 512 * 1024;
constexpr size_t WS_TOKINFO = 2 * MiB + 512 * 1024;
constexpr size_t WS_ROWW = 2 * MiB + 768 * 1024;
constexpr size_t WS_WRT = 3 * MiB;
constexpr size_t WS_WINE = 4 * MiB;
constexpr size_t WS_WQB = 6 * MiB + 512 * 1024;
constexpr size_t WS_WKVB = 7 * MiB;
constexpr size_t WS_WOE = 8 * MiB;
constexpr size_t WS_WINO = 10 * MiB;
constexpr size_t WS_WOO = 16 * MiB;
constexpr size_t WS_MOEW = 18 * MiB;
constexpr size_t WS_U = 114 * MiB;
constexpr size_t WS_PROJ0 = 146 * MiB;
constexpr size_t WS_CQN = 186 * MiB;
constexpr size_t WS_CKVN = 194 * MiB;
constexpr size_t WS_KR = 198 * MiB;
constexpr size_t WS_Q = 200 * MiB;
constexpr size_t WS_KVB = 224 * MiB;
constexpr size_t WS_XG = 146 * MiB;
constexpr size_t WS_HH = 226 * MiB;
constexpr size_t WS_PROJ1 = 146 * MiB;
constexpr size_t WS_MBLIST = 256 * MiB;
constexpr size_t WS_PARTO = 18 * MiB;
constexpr size_t WS_PARTML = 242 * MiB;
constexpr size_t WS_EL = 246 * MiB;
constexpr size_t WS_EW = 250 * MiB;
constexpr size_t WS_END = 272 * MiB;
constexpr int CW_BAR = 4096;
constexpr int CW_ECNT = 65536;
constexpr int CW_MBCNT = 131072;
constexpr int CW_HCNT = 147456;
constexpr int CW_TICK = 200000;
constexpr int CW_TMO = 16;
constexpr int RING_OFF = 0, RING_BYTES = 131072;
constexpr int MISC_OFF = RING_BYTES + 320;
constexpr int LDS_BYTES = 147456;

struct Params { const float* in[21]; float* out; unsigned char* ws; int ph_lo, ph_hi, li, pad; };

__device__ __forceinline__ void transpose_item(const float* W, int ldw, int k0, int n0, bf16* WTrow0, int ldk, LAS float* scr, int lane) {
#pragma unroll 8
    for (int i = 0; i < 32; ++i) { const int kk = 2 * i + (lane >> 5); scr[kk * 33 + (lane & 31)] = W[(size_t)(k0 + kk) * ldw + n0 + (lane & 31)]; }
    LDS_WAIT(); asm volatile("" ::: "memory");
    const int c = lane & 7;
#pragma unroll
    for (int j = 0; j < 4; ++j) { const int n = (lane >> 3) + 8 * j; const LAS float* s = scr + (8 * c) * 33 + n;
        v4u o; o.x = pk2(s[0 * 33], s[1 * 33]); o.y = pk2(s[2 * 33], s[3 * 33]); o.z = pk2(s[4 * 33], s[5 * 33]); o.w = pk2(s[6 * 33], s[7 * 33]);
        *(v4u*)(WTrow0 + (size_t)n * ldk + k0 + 8 * c) = o; }
    LDS_WAIT(); asm volatile("" ::: "memory");
}
__device__ __forceinline__ float wsum(float v) {
#pragma unroll
    for (int o = 1; o < 64; o <<= 1) v += __shfl_xor(v, o);
    return v;
}
__device__ __forceinline__ void rms_row_to_bf16(const float* xrow, const float* gain, bf16* orow, int lane) {
    const f32x4* xr = (const f32x4*)xrow + lane; const f32x4* gr = (const f32x4*)gain + lane;
    f32x4 v[4]; float s = 0.f;
#pragma unroll
    for (int j = 0; j < 4; ++j) { v[j] = xr[64 * j]; s += (v[j].x * v[j].x + v[j].y * v[j].y) + (v[j].z * v[j].z + v[j].w * v[j].w); }
    const float r = 1.0f / sqrtf(wsum(s) * (1.f / 1024.f) + RMS_EPS);
    unsigned long long* o8 = (unsigned long long*)orow + lane;
#pragma unroll
    for (int j = 0; j < 4; ++j) { const f32x4 g = gr[64 * j];
        o8[64 * j] = (unsigned long long)pk2(v[j].x * r * g.x, v[j].y * r * g.y) | ((unsigned long long)pk2(v[j].z * r * g.z, v[j].w * r * g.w) << 32); }
}

__device__ __forceinline__ void rms_rows2_to_bf16(const float* x0, const float* x1, const float* gain, bf16* o0, bf16* o1, int lane) {
    const f32x4* xa = (const f32x4*)x0 + lane; const f32x4* xb = (const f32x4*)x1 + lane; const f32x4* gr = (const f32x4*)gain + lane;
    f32x4 va[4], vb[4]; float sa = 0.f, sb = 0.f;
#pragma unroll
    for (int j = 0; j < 4; ++j) { va[j] = xa[64 * j]; vb[j] = xb[64 * j]; }
#pragma unroll
    for (int j = 0; j < 4; ++j) { sa += (va[j].x * va[j].x + va[j].y * va[j].y) + (va[j].z * va[j].z + va[j].w * va[j].w); sb += (vb[j].x * vb[j].x + vb[j].y * vb[j].y) + (vb[j].z * vb[j].z + vb[j].w * vb[j].w); }
#pragma unroll
    for (int o = 1; o < 64; o <<= 1) { sa += __shfl_xor(sa, o); sb += __shfl_xor(sb, o); }
    const float ra = 1.0f / sqrtf(sa * (1.f / 1024.f) + RMS_EPS), rb = 1.0f / sqrtf(sb * (1.f / 1024.f) + RMS_EPS);
    unsigned long long* pa = (unsigned long long*)o0 + lane; unsigned long long* pb = (unsigned long long*)o1 + lane;
#pragma unroll
    for (int j = 0; j < 4; ++j) { const f32x4 g = gr[64 * j];
        pa[64 * j] = (unsigned long long)pk2(va[j].x * ra * g.x, va[j].y * ra * g.y) | ((unsigned long long)pk2(va[j].z * ra * g.z, va[j].w * ra * g.w) << 32);
        pb[64 * j] = (unsigned long long)pk2(vb[j].x * rb * g.x, vb[j].y * rb * g.y) | ((unsigned long long)pk2(vb[j].z * rb * g.z, vb[j].w * rb * g.w) << 32); }
}
struct EpiStore {
    static constexpr bool PERM = true, AFTER_DRAIN = false;
    bf16* O; int ldc; int pnmask;
    __device__ __forceinline__ void operator()(const pg8::f32x4 (&acc)[2][2][4][2], const pg8::Unit& u, int wr, int wc, int fr, int fq) const {
        const int row0 = u.pm * 256 + wr * 64 + fr, col0 = (u.pn & pnmask) * 256 + wc * 32 + 8 * fq;
#pragma unroll
        for (int ai = 0; ai < 2; ++ai)
#pragma unroll
            for (int m = 0; m < 4; ++m) { bf16* rowp = O + (size_t)(row0 + ai * 128 + m * 16) * ldc + col0;
#pragma unroll
                for (int bj = 0; bj < 2; ++bj) { const pg8::f32x4 v0 = acc[ai][bj][m][0], v1 = acc[ai][bj][m][1];
                    v4u w; w.x = pg8::cvt_pk_bf16(v0[0], v0[1]); w.y = pg8::cvt_pk_bf16(v0[2], v0[3]); w.z = pg8::cvt_pk_bf16(v1[0], v1[1]); w.w = pg8::cvt_pk_bf16(v1[2], v1[3]);
                    *(v4u*)(rowp + bj * 128) = w; } }
    }
};

struct EpiQRope {
    static constexpr bool PERM = false, AFTER_DRAIN = false;
    bf16* O; const f32x2* rope;
    __device__ __forceinline__ void operator()(const pg8::f32x4 (&acc)[2][2][4][2], const pg8::Unit& u, int wr, int wc, int fr, int fq) const {
        const int row0 = u.pm * 256 + wr * 64 + fr;
#pragma unroll
        for (int ai = 0; ai < 2; ++ai)
#pragma unroll
            for (int m = 0; m < 4; ++m) { const int row = row0 + ai * 128 + m * 16, t = row & 8191; asm volatile("" ::: "memory");
#pragma unroll
                for (int bj = 0; bj < 2; ++bj) { const int colg = u.pn * 256 + bj * 128 + wc * 32;
                    pg8::f32x4 v0 = acc[ai][bj][m][0], v1 = acc[ai][bj][m][1];
                    if (((colg >> 5) % 3) == 2) {
                        const f32x4* rp = (const f32x4*)(rope + (size_t)t * 16 + 4 * fq); const f32x4 a = rp[0], b = rp[1];
                        const pg8::f32x4 x1 = v0, x2 = v1;
                        v0[0] = x1[0] * a.x - x2[0] * a.y; v1[0] = x2[0] * a.x + x1[0] * a.y;
                        v0[1] = x1[1] * a.z - x2[1] * a.w; v1[1] = x2[1] * a.z + x1[1] * a.w;
                        v0[2] = x1[2] * b.x - x2[2] * b.y; v1[2] = x2[2] * b.x + x1[2] * b.y;
                        v0[3] = x1[3] * b.z - x2[3] * b.w; v1[3] = x2[3] * b.z + x1[3] * b.w;
                    }
                    bf16* op = O + (size_t)row * 768 + colg + 4 * fq;
                    v2u w0, w1; w0.x = pg8::cvt_pk_bf16(v0[0], v0[1]); w0.y = pg8::cvt_pk_bf16(v0[2], v0[3]); w1.x = pg8::cvt_pk_bf16(v1[0], v1[1]); w1.y = pg8::cvt_pk_bf16(v1[2], v1[3]);
                    *(v2u*)op = w0; *(v2u*)(op + 16) = w1; } }
    }
};
__device__ __forceinline__ size_t hro(size_t m) { return m * 2048 + ((m >> 3) & 1) * 1024; }
template <bool XB> struct EpiResid {
    static constexpr bool PERM = true, AFTER_DRAIN = false;
    const float* X; bf16* OUT;
    __device__ __forceinline__ void operator()(const pg8::f32x4 (&acc)[2][2][4][2], const pg8::Unit& u, int wr, int wc, int fr, int fq) const {
        const int row0 = u.pm * 256 + wr * 64 + fr, col0 = u.pn * 256 + wc * 32 + 8 * fq;
#pragma unroll
        for (int ai = 0; ai < 2; ++ai)
#pragma unroll
            for (int m = 0; m < 4; ++m) { const size_t row = (size_t)(row0 + ai * 128 + m * 16);
#pragma unroll
                for (int bj = 0; bj < 2; ++bj) { const int col = col0 + bj * 128;
                    f32x4 x0, x1;
                    if constexpr (XB) { const v4u w = *(const v4u*)((const bf16*)X + hro(row) + col);
                        x0 = (f32x4){bflo(w.x), bfhi(w.x), bflo(w.y), bfhi(w.y)}; x1 = (f32x4){bflo(w.z), bfhi(w.z), bflo(w.w), bfhi(w.w)}; }
                    else { const f32x4* xp = (const f32x4*)(X + row * 1024 + col); x0 = xp[0]; x1 = xp[1]; }
                    const pg8::f32x4 v0 = acc[ai][bj][m][0], v1 = acc[ai][bj][m][1];
                    v4u o; o.x = pg8::cvt_pk_bf16(x0.x + v0[0], x0.y + v0[1]); o.y = pg8::cvt_pk_bf16(x0.z + v0[2], x0.w + v0[3]);
                    o.z = pg8::cvt_pk_bf16(x1.x + v1[0], x1.y + v1[1]); o.w = pg8::cvt_pk_bf16(x1.z + v1[2], x1.w + v1[3]);
                    *(v4u*)(OUT + hro(row) + col) = o; } }
    }
};

struct EpiSwiGLU {
    static constexpr bool PERM = true, AFTER_DRAIN = false;
    bf16* HH; const f32x2* EW; const LAS unsigned char* t2e; const LAS int* seg;
    __device__ __forceinline__ void operator()(const pg8::f32x4 (&acc)[2][2][4][2], const pg8::Unit& u, int wr, int wc, int fr, int fq) const {
        const int row0 = u.pm * 256 + wr * 64 + fr, j = u.pn & 1, col0 = j * 128 + wc * 32 + 8 * fq;
        const int e_ = __builtin_amdgcn_readfirstlane((int)t2e[u.pm]); const f32x2* roww = EW + (size_t)e_ * 16384 - __builtin_amdgcn_readfirstlane(seg[e_]);
#pragma unroll
        for (int ai = 0; ai < 2; ++ai)
#pragma unroll
            for (int m = 0; m < 4; ++m) { const int row = row0 + ai * 128 + m * 16; const f32x2 wr2 = roww[row]; const float w = wr2.x, rr = wr2.y;
                float hv[8];
#pragma unroll
                for (int n = 0; n < 2; ++n)
#pragma unroll
                    for (int k = 0; k < 4; ++k) { const float g = acc[ai][0][m][n][k] * rr, up = acc[ai][1][m][n][k] * rr;
                        hv[4 * n + k] = g * __builtin_amdgcn_rcpf(1.0f + __builtin_amdgcn_exp2f(-g * LOG2E)) * up * w; }
                v4u o; o.x = pg8::cvt_pk_bf16(hv[0], hv[1]); o.y = pg8::cvt_pk_bf16(hv[2], hv[3]); o.z = pg8::cvt_pk_bf16(hv[4], hv[5]); o.w = pg8::cvt_pk_bf16(hv[6], hv[7]);
                { bf16* hp = HH + (size_t)row * 256 + col0; asm volatile("global_store_dwordx4 %0, %1, off sc1" :: "v"(hp), "v"(o) : "memory"); } }
    }
};
template <int ntn> struct MoeOrder {
    int total, G, c; const LAS unsigned char* t2e;
    __device__ __forceinline__ bool next(int i, pg8::Unit& u) const {
        const int Lx = i * G + c; if (Lx >= total) return false;
        const int pm = Lx / ntn, j = Lx - pm * ntn; u.pm = pm; u.pn = __builtin_amdgcn_readfirstlane((int)t2e[pm]) * ntn + j; return true;
    }
    __device__ __forceinline__ void a_ready(const pg8::Unit&) const {}
    __device__ __forceinline__ void done(const pg8::Unit&) const {}
};

template <int ntn> struct MoeOrderG {
    int total, G, c; const LAS unsigned char* t2e; const LAS int* seg; const LAS int* cntL; const int* EL;
    __device__ __forceinline__ bool next(int i, pg8::Unit& u) const {
        const int Lx = i * G + c; if (Lx >= total) return false;
        const int pi = Lx / ntn, j = Lx - pi * ntn, pm = __builtin_amdgcn_readfirstlane((int)ord[pi]); u.pm = pm; u.pn = __builtin_amdgcn_readfirstlane((int)t2e[pm]) * ntn + j; return true;
    }
    __device__ __forceinline__ unsigned goff(const pg8::Unit& u, int h, int R, int C) const {
        const int e = __builtin_amdgcn_readfirstlane((int)t2e[u.pm]); const int cn = __builtin_amdgcn_readfirstlane(cntL[e]);
        int li = u.pm * 256 - __builtin_amdgcn_readfirstlane(seg[e]) + h * 128 + R; li = li < cn ? li : cn - 1;
        { const unsigned tk = (unsigned)EL[(size_t)e * 16384 + li]; return tk * 4096u + ((tk >> 3) & 1u) * 2048u + (unsigned)C * 2u; }
    }
    __device__ __forceinline__ void a_ready(const pg8::Unit&) const {}
    unsigned* hcnt;
    const LAS unsigned char* ord;
    __device__ __forceinline__ void done(const pg8::Unit& u) const {
        asm volatile("s_waitcnt vmcnt(0)" ::: "memory");
        if ((threadIdx.x & 63) == 0) (void)__hip_atomic_fetch_add(hcnt + u.pm * 16, 6u, __ATOMIC_RELAXED, __HIP_MEMORY_SCOPE_AGENT);
    }
};
template <int ntn> struct MoeOrderD {
    int total; const LAS unsigned char* t2e; const LAS unsigned char* ord; const unsigned* hcnt; unsigned* tick; LAS unsigned* slot;
    __device__ __forceinline__ bool next(int i, pg8::Unit& u) const {
        (void)i;
        if (__builtin_amdgcn_readfirstlane((int)(threadIdx.x >> 6)) == 0) {
            unsigned tk = 0;
            if ((threadIdx.x & 63) == 0) tk = __hip_atomic_fetch_add(tick, 1u, __ATOMIC_RELAXED, __HIP_MEMORY_SCOPE_AGENT);
            tk = (unsigned)__builtin_amdgcn_readfirstlane((int)tk);
            if (tk < (unsigned)total) {
                const unsigned* w = hcnt + 16 * (int)ord[tk / ntn];
                for (unsigned polls = 0; polls < (1u << 20); ++polls) {
                    if ((unsigned)__builtin_amdgcn_readfirstlane((int)__hip_atomic_load(w, __ATOMIC_RELAXED, __HIP_MEMORY_SCOPE_AGENT)) >= 96u) break;
                    __builtin_amdgcn_s_sleep(2); }
                __builtin_amdgcn_fence(__ATOMIC_ACQUIRE, "agent");
            }
            if ((threadIdx.x & 63) == 0) *slot = tk;
            asm volatile("s_waitcnt vmcnt(0) lgkmcnt(0)" ::: "memory");
        }
        asm volatile("" ::: "memory"); __builtin_amdgcn_s_barrier(); asm volatile("" ::: "memory");
        const unsigned tk = (unsigned)__builtin_amdgcn_readfirstlane((int)*slot);
        if (tk >= (unsigned)total) return false;
        const int pm = __builtin_amdgcn_readfirstlane((int)ord[tk / ntn]), j = (int)(tk % ntn); u.pm = pm; u.pn = __builtin_amdgcn_readfirstlane((int)t2e[pm]) * ntn + j;
        return true;
    }
    __device__ __forceinline__ void a_ready(const pg8::Unit&) const {}
    __device__ __forceinline__ void done(const pg8::Unit&) const {}
};
constexpr int AM_MLA = 0, AM_SWA = 1, AM_MOBAC = 2, AM_SB = 3, AM_MOBAO = 4;
constexpr int AK_OFF = 0, AK_BUF = 13312;
constexpr int AV_OFF = 26624, AV_BUF = 8192;
constexpr int AW_OFF = 43008;
constexpr int AFLAG_OFF = 51200;
constexpr int ABIAS_OFF = 51456;
constexpr int UT_OFF = RING_BYTES + 1024;
constexpr int ATT_LDS_END = ABIAS_OFF + 256 + 32768;
static_assert(ATT_LDS_END <= RING_BYTES, "attention LDS");
constexpr float NEGBIG = -1.0e30f;
constexpr float ATT_THR = 8.0f;

__device__ __forceinline__ int crow(int r, int hi) { return (r & 3) + 8 * (r >> 2) + 4 * hi; }
typedef short v4i16_t __attribute__((ext_vector_type(4)));
__device__ __forceinline__ s16x4 vtr(const LAS unsigned char* p) { return __builtin_bit_cast(s16x4, __builtin_amdgcn_ds_read_tr16_b64_v4i16((LAS v4i16_t*)p)); }


template <int ND0, int RSK>
__device__ __forceinline__ void att_qk(const LAS unsigned char* Kc, int krd, const bf16x8 (&qf)[ND0], f32x16& p0, f32x16& p1, const f32x16& cinit) {
    p0 = cinit; p1 = cinit;
#pragma unroll
    for (int d0 = 0; d0 < ND0; ++d0) {
        const bf16x8 ka = *(const LAS bf16x8*)(Kc + krd + d0 * 32);
        const bf16x8 kb = *(const LAS bf16x8*)(Kc + krd + 32 * RSK + d0 * 32);
        p0 = __builtin_amdgcn_mfma_f32_32x32x16_bf16(ka, qf[d0], p0, 0, 0, 0);
        p1 = __builtin_amdgcn_mfma_f32_32x32x16_bf16(kb, qf[d0], p1, 0, 0, 0);
    }
}
template <int MODE>
__device__ __forceinline__ void att_smpv(f32x16& p0, f32x16& p1, f32x16 (&o)[2], float& mref, float& lsum, float& carry, const LAS unsigned char* Vc, int vrd,
                                         LAS float* wsf, const LAS float* btab, int qpos, int q0w, int t, int hi, int ql, float cscale, f32x16& negm, bool& first) {
    const int k0 = t * 64;
    const int dbase = qpos - k0 - 4 * hi;
    if constexpr (MODE != AM_SB) {
        if constexpr (MODE == AM_MLA) {
            if (k0 + 63 > q0w) {
#pragma unroll
                for (int r = 0; r < 16; ++r) { const int c0 = (r & 3) + 8 * (r >> 2);
                    p0[r] = (dbase - c0 >= 0) ? p0[r] : NEGBIG; p1[r] = (dbase - c0 - 32 >= 0) ? p1[r] : NEGBIG; }
            }
        } else {
#pragma unroll
            for (int r = 0; r < 16; ++r) {
                const int c0 = (r & 3) + 8 * (r >> 2);
                const int d0v = dbase - c0, d1v = dbase - c0 - 32;
                const float s0 = __builtin_fmaf(p0[r], cscale, btab[64 + d0v]), s1 = __builtin_fmaf(p1[r], cscale, btab[64 + d1v]);
                if constexpr (MODE == AM_MOBAC) { p0[r] = s0; p1[r] = s1; }
                else {
                    bool v0, v1;
                    if constexpr (MODE == AM_SWA) { v0 = (d0v >= 0) && (d0v < 128); v1 = (d1v >= 0) && (d1v < 128); }
                    else { v0 = (d0v >= 0); v1 = (d1v >= 0); }
                    p0[r] = v0 ? s0 : NEGBIG; p1[r] = v1 ? s1 : NEGBIG;
                }
            }
        }
        float rm = fmaxf(p0[0], p1[0]);
#pragma unroll
        for (int r = 1; r < 16; ++r) rm = fmaxf(fmaxf(rm, p0[r]), p1[r]);
        rm = fmaxf(rm, __shfl_xor(rm, 32));
        if constexpr (MODE == AM_MLA) {
            if (first || __any((int)(rm > ATT_THR))) {
                const float delta = (first || rm > ATT_THR) ? rm : 0.f;
                const float alpha = first ? 1.0f : __builtin_amdgcn_exp2f(-delta);
                mref += delta; lsum *= alpha;
#pragma unroll
                for (int r = 0; r < 16; ++r) { negm[r] = -mref; p0[r] -= delta; p1[r] -= delta; }
                if (!first) {
                    if (hi == 0) wsf[ql] = alpha;
#pragma unroll
                    for (int g4 = 0; g4 < 4; ++g4) { const f32x4 al = *(const LAS f32x4*)(wsf + 8 * g4 + 4 * hi);
                        o[0][4 * g4 + 0] *= al.x; o[0][4 * g4 + 1] *= al.y; o[0][4 * g4 + 2] *= al.z; o[0][4 * g4 + 3] *= al.w;
                        o[1][4 * g4 + 0] *= al.x; o[1][4 * g4 + 1] *= al.y; o[1][4 * g4 + 2] *= al.z; o[1][4 * g4 + 3] *= al.w; }
                }
                first = false;
            }
        } else
        if (__any((int)(rm - mref > ATT_THR))) {
            const float mnew = (rm - mref > ATT_THR) ? rm : mref;
            const float alpha = __builtin_amdgcn_exp2f(mref - mnew);
            mref = mnew; lsum *= alpha;
            if (hi == 0) wsf[ql] = alpha;
#pragma unroll
            for (int g4 = 0; g4 < 4; ++g4) { const f32x4 al = *(const LAS f32x4*)(wsf + 8 * g4 + 4 * hi);
                o[0][4 * g4 + 0] *= al.x; o[0][4 * g4 + 1] *= al.y; o[0][4 * g4 + 2] *= al.z; o[0][4 * g4 + 3] *= al.w;
                o[1][4 * g4 + 0] *= al.x; o[1][4 * g4 + 1] *= al.y; o[1][4 * g4 + 2] *= al.z; o[1][4 * g4 + 3] *= al.w; }
        }
        float ls = 0.f;
        if constexpr (MODE == AM_MLA) {
#pragma unroll
            for (int r = 0; r < 16; ++r) { p0[r] = __builtin_amdgcn_exp2f(p0[r]); p1[r] = __builtin_amdgcn_exp2f(p1[r]); ls += p0[r] + p1[r]; }
        } else {
#pragma unroll
            for (int r = 0; r < 16; ++r) { p0[r] = __builtin_amdgcn_exp2f(p0[r] - mref); p1[r] = __builtin_amdgcn_exp2f(p1[r] - mref); ls += p0[r] + p1[r]; }
        }
        lsum += ls;
    } else {
        float gt[8];
#pragma unroll
        for (int j = 0; j < 8; ++j) {
            float lsn[4], lsp[4];
#pragma unroll
            for (int i = 0; i < 4; ++i) {
                const int r = 4 * (j & 3) + i; const float acc = (j < 4) ? p0[r] : p1[r];
                const int dist = dbase - i - 8 * (j & 3) - 32 * (j >> 2);
                const float z = acc * cscale;
                const float l1 = __builtin_amdgcn_logf(1.0f + __builtin_amdgcn_exp2f(-fabsf(z)));
                const float a_ = fminf(z, 0.f) - l1;
                const bool valid = dist > 0;
                lsp[i] = valid ? a_ : NEGBIG; lsn[i] = valid ? (a_ - z) : 0.f;
            }
            const float s2 = lsn[3], s1 = s2 + lsn[2], s0 = s1 + lsn[1];
            gt[j] = s0 + lsn[0];
            const float e0 = lsp[0] + s0, e1 = lsp[1] + s1, e2 = lsp[2] + s2, e3 = lsp[3];
            if (j < 4) { p0[4 * j + 0] = e0; p0[4 * j + 1] = e1; p0[4 * j + 2] = e2; p0[4 * j + 3] = e3; }
            else { p1[4 * (j - 4) + 0] = e0; p1[4 * (j - 4) + 1] = e1; p1[4 * (j - 4) + 2] = e2; p1[4 * (j - 4) + 3] = e3; }
        }
        float ox[8];
#pragma unroll
        for (int j = 0; j < 8; ++j) ox[j] = __shfl_xor(gt[j], 32);
        float so = 0.f, sx = 0.f;
#pragma unroll
        for (int j = 7; j >= 0; --j) {
            const float sg = carry + so + sx + ((hi == 0) ? ox[j] : 0.f);
            if (j < 4) { p0[4 * j + 0] += sg; p0[4 * j + 1] += sg; p0[4 * j + 2] += sg; p0[4 * j + 3] += sg; }
            else { p1[4 * (j - 4) + 0] += sg; p1[4 * (j - 4) + 1] += sg; p1[4 * (j - 4) + 2] += sg; p1[4 * (j - 4) + 3] += sg; }
            so += gt[j]; sx += ox[j];
        }
        carry += so + sx;
#pragma unroll
        for (int r = 0; r < 16; ++r) { p0[r] = __builtin_amdgcn_exp2f(p0[r]); p1[r] = __builtin_amdgcn_exp2f(p1[r]); }
    }
    v4u pw[4];
    pw[0] = (v4u){pg8::cvt_pk_bf16(p0[0], p0[1]), pg8::cvt_pk_bf16(p0[2], p0[3]), pg8::cvt_pk_bf16(p0[4], p0[5]), pg8::cvt_pk_bf16(p0[6], p0[7])};
    pw[1] = (v4u){pg8::cvt_pk_bf16(p0[8], p0[9]), pg8::cvt_pk_bf16(p0[10], p0[11]), pg8::cvt_pk_bf16(p0[12], p0[13]), pg8::cvt_pk_bf16(p0[14], p0[15])};
    pw[2] = (v4u){pg8::cvt_pk_bf16(p1[0], p1[1]), pg8::cvt_pk_bf16(p1[2], p1[3]), pg8::cvt_pk_bf16(p1[4], p1[5]), pg8::cvt_pk_bf16(p1[6], p1[7])};
    pw[3] = (v4u){pg8::cvt_pk_bf16(p1[8], p1[9]), pg8::cvt_pk_bf16(p1[10], p1[11]), pg8::cvt_pk_bf16(p1[12], p1[13]), pg8::cvt_pk_bf16(p1[14], p1[15])};
#pragma unroll
    for (int s = 0; s < 4; ++s)
#pragma unroll
        for (int d0 = 0; d0 < 2; ++d0) {
            const s16x4 lo = vtr(Vc + vrd + d0 * 4096 + s * 1024), hi4 = vtr(Vc + vrd + d0 * 4096 + s * 1024 + 512);
            const bf16x8 vf = (bf16x8){lo[0], lo[1], lo[2], lo[3], hi4[0], hi4[1], hi4[2], hi4[3]};
            o[d0] = __builtin_amdgcn_mfma_f32_32x32x16_bf16(__builtin_bit_cast(bf16x8, pw[s]), vf, o[d0], 0, 0, 0);
        }
}

struct AttnPtrs {
    const bf16* Q; int qs;
    const bf16* K; int ks;
    const bf16* K2;
    const bf16* V; int vs;
    bf16* O;
};

struct MobaArgs { int q; int slot; bool valid; bool wvalid; int bhbase; bf16* PARTO; f32x2* PARTML; };
template <int MODE>
__device__ __forceinline__ void attn_unit(LAS unsigned char* L, const AttnPtrs& a, int q0u  , int q0w, int t_first, int t_last, float cscale,
                                          float sinkl2, const MobaArgs& mb, int boff, const f32x2* rope, int tid, int lane, int wave) {
    constexpr int DQK = (MODE == AM_MLA) ? 96 : 64, RSK = 2 * DQK + 16, ND0 = DQK / 16;
    const int ql = lane & 31, hi = lane >> 5;
    LAS unsigned char* Kb = L + AK_OFF; LAS unsigned char* Vb = L + AV_OFF;
    LAS float* wsf = (LAS float*)(L + AW_OFF + wave * 1024);
    const int qpos = (MODE == AM_MOBAC) ? mb.q : (q0w + ql);
    const bf16* qrow = (MODE == AM_MOBAC) ? (a.Q + (size_t)mb.q * a.qs) : (a.Q + (size_t)ql * a.qs);
    bf16x8 qf[ND0];
#pragma unroll
    for (int d0 = 0; d0 < ND0; ++d0) qf[d0] = *(const bf16x8*)(qrow + d0 * 16 + hi * 8);
    if constexpr (MODE == AM_MLA) {
        const f32x4* rp = (const f32x4*)(rope + (size_t)qpos * 16 + 8 * hi);
        const v4u w1 = __builtin_bit_cast(v4u, qf[4]), w2 = __builtin_bit_cast(v4u, qf[5]);
        float x1[8], x2[8], cs[16];
        x1[0] = bflo(w1.x); x1[1] = bfhi(w1.x); x1[2] = bflo(w1.y); x1[3] = bfhi(w1.y); x1[4] = bflo(w1.z); x1[5] = bfhi(w1.z); x1[6] = bflo(w1.w); x1[7] = bfhi(w1.w);
        x2[0] = bflo(w2.x); x2[1] = bfhi(w2.x); x2[2] = bflo(w2.y); x2[3] = bfhi(w2.y); x2[4] = bflo(w2.z); x2[5] = bfhi(w2.z); x2[6] = bflo(w2.w); x2[7] = bfhi(w2.w);
#pragma unroll
        for (int k = 0; k < 4; ++k) { const f32x4 v = rp[k]; cs[4 * k] = v.x; cs[4 * k + 1] = v.y; cs[4 * k + 2] = v.z; cs[4 * k + 3] = v.w; }
        float y1[8], y2[8];
#pragma unroll
        for (int j = 0; j < 8; ++j) { const float c = cs[2 * j] * cscale, sn = cs[2 * j + 1] * cscale; y1[j] = x1[j] * c - x2[j] * sn; y2[j] = x2[j] * c + x1[j] * sn; }
#pragma unroll
        for (int d0 = 0; d0 < 4; ++d0) { const v4u w = __builtin_bit_cast(v4u, qf[d0]);
            const v4u ws_ = (v4u){pk2(bflo(w.x) * cscale, bfhi(w.x) * cscale), pk2(bflo(w.y) * cscale, bfhi(w.y) * cscale), pk2(bflo(w.z) * cscale, bfhi(w.z) * cscale), pk2(bflo(w.w) * cscale, bfhi(w.w) * cscale)};
            qf[d0] = __builtin_bit_cast(bf16x8, ws_); }
        const v4u o1 = (v4u){pk2(y1[0], y1[1]), pk2(y1[2], y1[3]), pk2(y1[4], y1[5]), pk2(y1[6], y1[7])};
        const v4u o2 = (v4u){pk2(y2[0], y2[1]), pk2(y2[2], y2[3]), pk2(y2[4], y2[5]), pk2(y2[6], y2[7])};
        qf[4] = __builtin_bit_cast(bf16x8, o1); qf[5] = __builtin_bit_cast(bf16x8, o2);
    }
    const int skey = tid >> 3, sc = tid & 7;
    const bf16* kg = a.K + (size_t)skey * a.ks + sc * 8;
    const bf16* vg = a.V + (size_t)skey * a.vs + sc * 8;
    const bf16* k2g = nullptr; if constexpr (MODE == AM_MLA) k2g = a.K2 + (size_t)(tid >> 2) * 32 + (tid & 3) * 8;
    const int kw_off = skey * RSK + sc * 16, vw_off = (sc >> 2) * 4096 + skey * 64 + (sc & 3) * 16, k2w_off = (tid >> 2) * RSK + 128 + (tid & 3) * 16;
    v4u rk, rv, rk2;
#define ATT_LOAD(t) do { rk = *(const v4u*)(kg + (size_t)(t) * 64 * a.ks); rv = *(const v4u*)(vg + (size_t)(t) * 64 * a.vs); \
        if constexpr (MODE == AM_MLA) { if (tid < 256) rk2 = *(const v4u*)(k2g + (size_t)(t) * 64 * 32); } } while (0)
#define ATT_WRITE(kbuf, vbuf) do { *(LAS v4u*)(Kb + (kbuf) * AK_BUF + kw_off) = rk; *(LAS v4u*)(Vb + (vbuf) * AV_BUF + vw_off) = rv; \
        if constexpr (MODE == AM_MLA) { if (tid < 256) *(LAS v4u*)(Kb + (kbuf) * AK_BUF + k2w_off) = rk2; } } while (0)
    f32x16 o[2]; o[0] = f32x16{}; o[1] = f32x16{};
    float mref = (MODE == AM_MLA) ? 0.f : NEGBIG, lsum = 0.f, carry = 0.f;
    f32x16 negm = f32x16{}; bool first = true;
    const int krd = ql * RSK + hi * 16;
    const int vrd = ((lane >> 4) & 1) * 32 + (lane & 3) * 8 + (4 * hi + ((lane & 15) >> 2)) * 64;
    const LAS float* btab = (const LAS float*)(L + ABIAS_OFF) + boff;
    constexpr bool REV = (MODE == AM_SB);
    const int ntl = t_last - t_first + 1;
    f32x16 p0, p1;
#define ATT_TILE(i) (REV ? (t_last - (i)) : (t_first + (i)))
    if constexpr (MODE != AM_SB) {
    ATT_LOAD(ATT_TILE(0));
    __syncthreads();
    ATT_WRITE(0, 0);
    if (ntl > 1) ATT_LOAD(ATT_TILE(1));
    for (int it = 0; it < ntl; ++it) {
        const int t = ATT_TILE(it), cur = it & 1, k0 = t * 64;
        __syncthreads();
        if constexpr (MODE == AM_SB) {
            if (it > 0) { volatile LAS unsigned* fl = (volatile LAS unsigned*)(L + AFLAG_OFF);
                unsigned alld = 1u;
#pragma unroll
                for (int w = 0; w < 8; ++w) alld &= fl[(cur ^ 1) * 8 + w];
                if (alld) break; }
        }
        if (it + 1 < ntl) { ATT_WRITE(cur ^ 1, cur ^ 1); if (it + 2 < ntl) ATT_LOAD(ATT_TILE(it + 2)); }
        bool need;
        if constexpr (MODE == AM_MLA) need = (k0 <= q0w + 31);
        else if constexpr (MODE == AM_SWA) need = (k0 <= q0w + 31) && (k0 + 63 >= q0w - 127);
        else if constexpr (MODE == AM_MOBAC) need = mb.wvalid;
        else if constexpr (MODE == AM_MOBAO) need = (k0 <= q0w + 31);
        else need = (k0 < q0w + 31) && (__any((int)(carry > -160.f)) != 0);
        if (need) { att_qk<ND0, RSK>(Kb + cur * AK_BUF, krd, qf, p0, p1, negm);
            att_smpv<MODE>(p0, p1, o, mref, lsum, carry, Vb + cur * AV_BUF, vrd, wsf, btab, qpos, q0w, t, hi, ql, cscale, negm, first); }
        if constexpr (MODE == AM_SB) {
            volatile LAS unsigned* fl = (volatile LAS unsigned*)(L + AFLAG_OFF);
            const bool wdone = (k0 < q0w + 31) && (__any((int)(carry > -160.f)) == 0);
            if (lane == 0) fl[cur * 8 + wave] = wdone ? 1u : 0u;
        }
    }
    __syncthreads();
    } else {
    constexpr bool SKEW = false;
    const bool skew = SKEW && (wave >= 4);
    ATT_LOAD(ATT_TILE(0));
    __syncthreads();
    ATT_WRITE(0, 0);
    __syncthreads();
    if (skew) { if (ntl > 1) ATT_LOAD(ATT_TILE(1)); __syncthreads(); }
    for (int it = 0; it < ntl; ++it) {
        const int t = ATT_TILE(it), cur = it & 1, k0 = t * 64;
        const bool more = (it + 1 < ntl);
        if (!skew && more) ATT_LOAD(ATT_TILE(it + 1));
        bool need;
        if constexpr (MODE == AM_MLA) need = (k0 <= q0w + 31);
        else if constexpr (MODE == AM_SWA) need = (k0 <= q0w + 31) && (k0 + 63 >= q0w - 127);
        else if constexpr (MODE == AM_MOBAC) need = mb.wvalid;
        else if constexpr (MODE == AM_MOBAO) need = (k0 <= q0w + 31);
        else need = (k0 < q0w + 31) && (__any((int)(carry > -160.f)) != 0);
        if (need) att_qk<ND0, RSK>(Kb + cur * AK_BUF, krd, qf, p0, p1, negm);
        if constexpr (SKEW) {
            if (skew && more) ATT_WRITE(cur ^ 1, cur ^ 1);
            __syncthreads();
            if (skew && it + 2 < ntl) ATT_LOAD(ATT_TILE(it + 2));
        }
        if (need) att_smpv<MODE>(p0, p1, o, mref, lsum, carry, Vb + cur * AV_BUF, vrd, wsf, btab, qpos, q0w, t, hi, ql, cscale, negm, first);
        if (!skew && more) ATT_WRITE(cur ^ 1, cur ^ 1);
        if constexpr (MODE == AM_SB) {
            volatile LAS unsigned* fl = (volatile LAS unsigned*)(L + AFLAG_OFF);
            const bool wdone = (k0 < q0w + 31) && (__any((int)(carry > -160.f)) == 0);
            if (lane == 0) fl[cur * 8 + wave] = wdone ? 1u : 0u;
            __syncthreads();
            unsigned alld = 1u;
#pragma unroll
            for (int w = 0; w < 8; ++w) alld &= fl[cur * 8 + w];
            if (alld) break;
        } else {
            __syncthreads();
        }
    }
    if (SKEW && !skew) __syncthreads();
    }
#undef ATT_TILE
#undef ATT_LOAD
#undef ATT_WRITE
    LAS unsigned short* stg = (LAS unsigned short*)(L + wave * 4096);
    LAS int* wsi = (LAS int*)wsf;
    lsum += __shfl_xor(lsum, 32);
    float inv[16];
    if constexpr (MODE == AM_MOBAC || MODE == AM_MOBAO) {
        const int di = (MODE == AM_MOBAO) ? ((mb.bhbase + qpos) * 4 + 3) : (mb.valid ? ((mb.bhbase + mb.q) * 4 + mb.slot) : -1);
        if (hi == 0) { wsi[ql] = (MODE == AM_MOBAO) ? 0 : (mb.valid ? ((mb.bhbase + mb.q) * 3 + mb.slot) : -1); if (di >= 0) mb.PARTML[di] = (f32x2){mref, lsum}; }
#pragma unroll
        for (int r = 0; r < 16; ++r) inv[r] = 1.0f;
    } else if constexpr (MODE != AM_SB) {
        if constexpr (MODE == AM_SWA) lsum += __builtin_amdgcn_exp2f(sinkl2 - mref);
        if (hi == 0) wsf[32 + ql] = lsum;
#pragma unroll
        for (int g4 = 0; g4 < 4; ++g4) { const f32x4 lv = *(const LAS f32x4*)(wsf + 32 + 8 * g4 + 4 * hi);
            inv[4 * g4 + 0] = 1.0f / lv.x; inv[4 * g4 + 1] = 1.0f / lv.y; inv[4 * g4 + 2] = 1.0f / lv.z; inv[4 * g4 + 3] = 1.0f / lv.w; }
    } else {
#pragma unroll
        for (int r = 0; r < 16; ++r) inv[r] = 1.0f;
    }
#pragma unroll
    for (int r = 0; r < 16; ++r) { const int row = crow(r, hi);
        stg[row * 64 + ql] = (unsigned short)f2bf(o[0][r] * inv[r]); stg[row * 64 + 32 + ql] = (unsigned short)f2bf(o[1][r] * inv[r]); }
#pragma unroll
    for (int i = 0; i < 4; ++i) { const int c = lane + 64 * i, row = c >> 3, part = c & 7;
        const v4u v = *(const LAS v4u*)(stg + row * 64 + part * 8);
        if constexpr (MODE == AM_MOBAC) { const int d = wsi[row]; if (d >= 0) *(v4u*)(mb.PARTO + (size_t)d * 64 + part * 8) = v; }
        else *(v4u*)(a.O + (size_t)row * 1024 + part * 8) = v; }
}

constexpr int RK_OFF = 0, RK_TILE = 9216;
constexpr int RV_OFF = 36864, RV_TILE = 8192;
constexpr int RW_OFF = 69632;
constexpr int RB_OFF = 86016;
static_assert(RB_OFF + 256 + 32768 <= RING_BYTES, "resident MoBA LDS");

__device__ __forceinline__ void moba_resident_load(LAS unsigned char* L, const bf16* Kblk, const bf16* Vblk, int tid) {
    const int skey = tid >> 3, sc = tid & 7;
    v4u rk[4], rv[4];
#pragma unroll
    for (int t = 0; t < 4; ++t) { rk[t] = *(const v4u*)(Kblk + (size_t)(t * 64 + skey) * 3072 + sc * 8); rv[t] = *(const v4u*)(Vblk + (size_t)(t * 64 + skey) * 3072 + sc * 8); }
#pragma unroll
    for (int t = 0; t < 4; ++t) { *(LAS v4u*)(L + RK_OFF + t * RK_TILE + skey * 144 + sc * 16) = rk[t]; *(LAS v4u*)(L + RV_OFF + t * RV_TILE + (sc >> 2) * 4096 + skey * 64 + (sc & 3) * 16) = rv[t]; }
}
__device__ __forceinline__ void moba_resident_wave(LAS unsigned char* L, const bf16* Qb  , int n, int q, int slot, bool valid, int bhbase,
                                                   bf16* PARTO, f32x2* PARTML, int lane, int wave) {
    const int ql = lane & 31, hi = lane >> 5;
    LAS float* wsf = (LAS float*)(L + RW_OFF + wave * 2048);
    LAS int* wsi = (LAS int*)(L + RW_OFF + wave * 2048 + 1024);
    const LAS float* btab = (const LAS float*)(L + RB_OFF);
    bf16x8 qf[4];
#pragma unroll
    for (int d0 = 0; d0 < 4; ++d0) qf[d0] = *(const bf16x8*)(Qb + (size_t)q * 3072 + d0 * 16 + hi * 8);
    f32x16 o[2]; o[0] = f32x16{}; o[1] = f32x16{};
    float mref = NEGBIG, lsum = 0.f, carry = 0.f; f32x16 negm = f32x16{}; bool first = true;
    const int krd = ql * 144 + hi * 16;
    const int vrd = ((lane >> 4) & 1) * 32 + (lane & 3) * 8 + (4 * hi + ((lane & 15) >> 2)) * 64;
    f32x16 p0, p1;
#pragma unroll 1
    for (int t = 0; t < 4; ++t) {
        att_qk<4, 144>(L + RK_OFF + t * RK_TILE, krd, qf, p0, p1, negm);
        att_smpv<AM_MOBAC>(p0, p1, o, mref, lsum, carry, L + RV_OFF + t * RV_TILE, vrd, wsf, btab, q, 0, 4 * n + t, hi, ql, 0.125f * LOG2E, negm, first);
    }
    lsum += __shfl_xor(lsum, 32);
    const int di = valid ? ((bhbase + q) * 4 + slot) : -1;
    if (hi == 0) { wsi[ql] = valid ? ((bhbase + q) * 3 + slot) : -1; if (di >= 0) PARTML[di] = (f32x2){mref, lsum}; }
    LAS unsigned short* stg = (LAS unsigned short*)wsf;
#pragma unroll
    for (int g4 = 0; g4 < 4; ++g4) {
#pragma unroll
        for (int k = 0; k < 4; ++k) { const int r = 4 * g4 + k, lrow = 4 * hi + k;
            stg[lrow * 64 + ql] = (unsigned short)f2bf(o[0][r]); stg[lrow * 64 + 32 + ql] = (unsigned short)f2bf(o[1][r]); }
        const int lrow = lane >> 3, part = lane & 7, d = wsi[8 * g4 + lrow];
        const v4u v = *(const LAS v4u*)(stg + lrow * 64 + part * 8);
        if (d >= 0) *(v4u*)(PARTO + (size_t)d * 64 + part * 8) = v;
    }
}

namespace mla3 {
typedef __attribute__((address_space(3))) const char* lds_cptr;
constexpr int KSLOT = 12288, VSLOT = 8192;
constexpr int LDS_K = 0, LDS_V = 4 * KSLOT, LDS_WS = LDS_V + 3 * VSLOT, LDS_OST = LDS_WS + 8 * 64 * 4, LDS_BYTES = LDS_OST + 8 * 4096;
static_assert(LDS_BYTES <= RING_BYTES, "MLA LDS");
#define M3_SBAR() __builtin_amdgcn_sched_barrier(0)
#define M3_WAIT_BAR(N) asm volatile("s_waitcnt vmcnt(" #N ") lgkmcnt(0)\n\ts_barrier":::"memory")
#define M3_WB(NLO, NHI) do { if (wid < 4) { M3_WAIT_BAR(NHI); } else { M3_WAIT_BAR(NLO); } } while (0)
__device__ __forceinline__ void cmask(f32x16& p0, f32x16& p1, int jb, int qrel, int hi) {
    const float NEG = -INFINITY; const int kb = 64 * jb + 4 * hi;
#pragma unroll
    for (int r = 0; r < 16; ++r) { const int kv = kb + (r & 3) + 8 * (r >> 2); if (kv > qrel) p0[r] = NEG; if (kv + 32 > qrel) p1[r] = NEG; }
}
__device__ __forceinline__ void glds16(const void* sbase, unsigned voff, unsigned lds_dst) { unsigned keep;
    asm volatile("s_mov_b32 %0, m0\n\ts_mov_b32 m0, %3\n\ts_nop 0\n\tglobal_load_lds_dwordx4 %1, %2\n\ts_mov_b32 m0, %0" : "=&s"(keep) : "v"(voff), "s"(sbase), "s"(lds_dst) : "memory"); }
__device__ __forceinline__ float fsub_s(float a, float b) { float r; asm("v_sub_f32_e32 %0, %1, %2" : "=v"(r) : "v"(a), "v"(b)); return r; }
__device__ __forceinline__ float swapmax(float m) { float a = m, b = m; asm volatile("s_nop 1\n\tv_permlane32_swap_b32 %0, %1" : "+v"(a), "+v"(b)); return __builtin_fmaxf(a, b); }
__device__ __forceinline__ float swapadd(float m) { float a = m, b = m; asm volatile("s_nop 1\n\tv_permlane32_swap_b32 %0, %1" : "+v"(a), "+v"(b)); return a + b; }
__device__ __forceinline__ unsigned cvtpk_s(float lo, float hi) { return pg8::cvt_pk_bf16(lo, hi); }
__device__ __forceinline__ bf16x8 kld(lds_cptr p) { return *(const __attribute__((address_space(3))) bf16x8*)p; }
__device__ __forceinline__ s16x4 vtr3(lds_cptr p) { return __builtin_bit_cast(s16x4, __builtin_amdgcn_ds_read_tr16_b64_v4i16((__attribute__((address_space(3))) v4i16_t*)p)); }
__device__ __forceinline__ float rowmax(const f32x16& p0, const f32x16& p1) {
    float a = __builtin_fmaxf(__builtin_fmaxf(p0[0], p0[1]), p1[0]), b = __builtin_fmaxf(__builtin_fmaxf(p0[2], p0[3]), p1[1]); a = __builtin_fmaxf(__builtin_fmaxf(a, p1[2]), p1[3]);
#pragma unroll
    for (int r = 4; r < 16; r += 4) { a = __builtin_fmaxf(__builtin_fmaxf(a, p0[r]), p0[r + 1]); b = __builtin_fmaxf(__builtin_fmaxf(b, p0[r + 2]), p0[r + 3]);
        a = __builtin_fmaxf(__builtin_fmaxf(a, p1[r]), p1[r + 1]); b = __builtin_fmaxf(__builtin_fmaxf(b, p1[r + 2]), p1[r + 3]); }
    return swapmax(__builtin_fmaxf(a, b));
}
__device__ __forceinline__ void unit(int b, int h, int qb, const bf16* Q, const bf16* KVB, const bf16* KR, const f32x2* rope, bf16* O, char* shm, float cscale) {
    constexpr int THRL = 8;
    const int tid = otid(), lane = tid & 63, r32 = lane & 31, hi = lane >> 5; const int wid = __builtin_amdgcn_readfirstlane(tid >> 6);
    const long rowbase = (long)b * T_; const int q0 = qb * 256;
    const bf16* Qw = Q + (rowbase + q0 + wid * 32) * 768 + h * 96;
    const bf16* Kh = KVB + rowbase * 1024 + h * 128; const bf16* Vh = Kh + 64; const bf16* KRb = KR + rowbase * 32;
    const unsigned lds0 = (unsigned)(uintptr_t)shm;
    float* wsf = (float*)(shm + LDS_WS) + wid * 64;
    const unsigned koff = (unsigned)lane * 2048u + (unsigned)wid * 16u;
    const unsigned roff = (unsigned)lane * 64u + (unsigned)(wid & 3) * 16u;
    const unsigned voff = (unsigned)(16 * (wid & 3) + (lane >> 2)) * 2048u + (unsigned)(wid >> 2) * 64u + (unsigned)(lane & 3) * 16u;
    const unsigned kdst = lds0 + LDS_K + wid * 1024, rdst = lds0 + LDS_K + (8 + (wid & 3)) * 1024, vdst = lds0 + LDS_V + wid * 1024;
#define M3_DMA_K(t, si) do { glds16(Kh + (long)(t) * 64 * 1024, koff, (unsigned)__builtin_amdgcn_readfirstlane(kdst + (si) * KSLOT)); if (wid < 4) glds16(KRb + (long)(t) * 64 * 32, roff, (unsigned)__builtin_amdgcn_readfirstlane(rdst + (si) * KSLOT)); } while (0)
#define M3_DMA_V(t, si) glds16(Vh + (long)(t) * 64 * 1024, voff, (unsigned)__builtin_amdgcn_readfirstlane(vdst + (si) * VSLOT))
    const lds_cptr shm3 = (lds_cptr)shm; const lds_cptr kp0 = shm3 + LDS_K + hi * 1024 + r32 * 16;
    const lds_cptr vp0 = shm3 + LDS_V + ((lane >> 4) & 1) * 32 + (lane & 3) * 8 + (4 * hi + ((lane & 15) >> 2)) * 64;
    const int NT = (q0 + 256) / 64;
    M3_DMA_K(0, 0); M3_DMA_V(0, 0); M3_DMA_K(1, 1);
    bf16x8 qr[6];
#pragma unroll
    for (int d0 = 0; d0 < 6; ++d0) qr[d0] = *reinterpret_cast<const bf16x8*>(&Qw[(long)r32 * 768 + d0 * 16 + hi * 8]);
    {   const int qpos = q0 + wid * 32 + r32;
        const f32x4* rp = (const f32x4*)(rope + (size_t)qpos * 16 + 8 * hi);
        const v4u w1 = __builtin_bit_cast(v4u, qr[4]), w2 = __builtin_bit_cast(v4u, qr[5]);
        float x1[8], x2[8], cs[16];
        x1[0] = bflo(w1.x); x1[1] = bfhi(w1.x); x1[2] = bflo(w1.y); x1[3] = bfhi(w1.y); x1[4] = bflo(w1.z); x1[5] = bfhi(w1.z); x1[6] = bflo(w1.w); x1[7] = bfhi(w1.w);
        x2[0] = bflo(w2.x); x2[1] = bfhi(w2.x); x2[2] = bflo(w2.y); x2[3] = bfhi(w2.y); x2[4] = bflo(w2.z); x2[5] = bfhi(w2.z); x2[6] = bflo(w2.w); x2[7] = bfhi(w2.w);
#pragma unroll
        for (int k = 0; k < 4; ++k) { const f32x4 v = rp[k]; cs[4 * k] = v.x; cs[4 * k + 1] = v.y; cs[4 * k + 2] = v.z; cs[4 * k + 3] = v.w; }
        float y1[8], y2[8];
#pragma unroll
        for (int j = 0; j < 8; ++j) { const float c = cs[2 * j] * cscale, sn = cs[2 * j + 1] * cscale; y1[j] = x1[j] * c - x2[j] * sn; y2[j] = x2[j] * c + x1[j] * sn; }
#pragma unroll
        for (int d0 = 0; d0 < 4; ++d0) { const v4u w = __builtin_bit_cast(v4u, qr[d0]);
            qr[d0] = __builtin_bit_cast(bf16x8, (v4u){pk2(bflo(w.x) * cscale, bfhi(w.x) * cscale), pk2(bflo(w.y) * cscale, bfhi(w.y) * cscale), pk2(bflo(w.z) * cscale, bfhi(w.z) * cscale), pk2(bflo(w.w) * cscale, bfhi(w.w) * cscale)}); }
        qr[4] = __builtin_bit_cast(bf16x8, (v4u){pk2(y1[0], y1[1]), pk2(y1[2], y1[3]), pk2(y1[4], y1[5]), pk2(y1[6], y1[7])});
        qr[5] = __builtin_bit_cast(bf16x8, (v4u){pk2(y2[0], y2[1]), pk2(y2[2], y2[3]), pk2(y2[4], y2[5]), pk2(y2[6], y2[7])});
    }
    float mhat = 0.f, l_reg = 0.f; f32x16 o[2]; o[0] = f32x16{}; o[1] = f32x16{}; f32x16 negm = f32x16{}; asm volatile("" : "+v"(negm));
    const int qrel = wid * 32 + r32;
#define M3_CMASK(P0, P1, t) do { const int jb_ = (t) - (NT - 4); if (jb_ >= 0) cmask(P0, P1, jb_, qrel, hi); } while (0)
    bool resc = false;
#define M3_RESC() do { if (resc) { asm volatile("s_waitcnt lgkmcnt(0)" ::: "memory"); \
        _Pragma("unroll") for (int d_ = 0; d_ < 2; ++d_) _Pragma("unroll") for (int r = 0; r < 16; ++r) o[d_][r] *= wsf[crow(r, hi)]; } } while (0)
    f32x16 pA0, pA1, pB0, pB1;
    int i_prev = 0, i_cur = 0, i_next = 1, kc = 0;
#define M3_ROT() do { i_prev = i_cur; i_cur = i_next; i_next = (i_next == 2) ? 0 : i_next + 1; kc = (kc + 1) & 3; } while (0)
    M3_DMA_K(2, 2);
    M3_WB(1, 2);
    {   const lds_cptr kb = kp0;
        pA0 = negm; pA1 = negm;
#pragma unroll
        for (int d0 = 0; d0 < 6; ++d0) { const bf16x8 b0 = kld(kb + d0 * 2048), b1 = kld(kb + d0 * 2048 + 512);
            pA0 = __builtin_amdgcn_mfma_f32_32x32x16_bf16(b0, qr[d0], pA0, 0, 0, 0); pA1 = __builtin_amdgcn_mfma_f32_32x32x16_bf16(b1, qr[d0], pA1, 0, 0, 0); }
    }
    asm volatile("s_nop 15\n\ts_nop 7" : "+v"(pA0), "+v"(pA1)); M3_CMASK(pA0, pA1, 0);
    {   const float rm = rowmax(pA0, pA1); resc = false;
        mhat = rm;
#pragma unroll
        for (int r = 0; r < 16; ++r) negm[r] = -mhat;
        asm volatile("" : "+v"(negm));
#pragma unroll
        for (int r = 0; r < 16; ++r) { pA0[r] = __builtin_amdgcn_exp2f(fsub_s(pA0[r], rm)); pA1[r] = __builtin_amdgcn_exp2f(fsub_s(pA1[r], rm)); }
    }
    M3_WAIT_BAR(0);
    M3_DMA_K(3, 3); M3_DMA_V(1, 1);
    M3_ROT();
    bf16x8 kf[8];
#pragma unroll
    for (int j = 0; j < 4; ++j) { kf[2 * j] = kld(kp0 + kc * KSLOT + j * 2048); kf[2 * j + 1] = kld(kp0 + kc * KSLOT + j * 2048 + 512); }
    M3_WB(2, 3);
    s16x4 vlo[8], vhi[8]; v4u pw0, pw1, pw2, pw3;
#define M3_PKW(P, B) cvtpk_s(P[B], P[B + 1])
#define M3_PAF(k) __builtin_bit_cast(bf16x8, pw##k)
#define M3_VFR(i) (bf16x8){vlo[i][0], vlo[i][1], vlo[i][2], vlo[i][3], vhi[i][0], vhi[i][1], vhi[i][2], vhi[i][3]}
#define M3_PIN(x) asm volatile("" : "+v"(x))
#define M3_MX3(a, b, c) __builtin_fmaxf(__builtin_fmaxf((a), (b)), (c))
#define M3_MF(A, B, C) __builtin_amdgcn_mfma_f32_32x32x16_bf16(A, B, C, 0, 0, 0)
#define M3_GAPA(MF, A0, A1, A2, A3, W0, W1, PW) do { MF; sacc += A0; sacc += A1; sacc += A2; sacc += A3; M3_PIN(sacc); W0; W1; M3_PIN(PW); M3_SBAR(); } while (0)
#define M3_GAPR(MF) do { MF; M3_SBAR(); } while (0)
#define M3_EX(v) __builtin_amdgcn_exp2f(v)
#define M3_GAPB(MF, X, B) do { MF; X[B] = M3_EX(X[B]); X[B + 1] = M3_EX(X[B + 1]); X[B + 2] = M3_EX(X[B + 2]); X[B + 3] = M3_EX(X[B + 3]); M3_PIN(X); M3_SBAR(); } while (0)
#define M3_VRD(i) do { vlo[i] = vtr3(vp_ + (((i) >> 2) * 4096 + ((i) & 3) * 1024)); vhi[i] = vtr3(vp_ + (((i) >> 2) * 4096 + ((i) & 3) * 1024 + 512)); } while (0)
#define M3_KRR(j) do { kr[2 * (j)] = kld(kr_ + (4 + (j)) * 2048); kr[2 * (j) + 1] = kld(kr_ + (4 + (j)) * 2048 + 512); } while (0)
#define M3_KRD(G_, j) do { if (G_) { kf[2 * (j)] = kld(kn_ + (j) * 2048); kf[2 * (j) + 1] = kld(kn_ + (j) * 2048 + 512); M3_SBAR(); } } while (0)
#define M3_STEP(C0, C1, P0, P1, t, GK, GV, GL) do { M3_SBAR(); \
        const lds_cptr vp_ = vp0 + i_prev * VSLOT; const lds_cptr kr_ = kp0 + kc * KSLOT; const lds_cptr kn_ = kp0 + ((kc + 1) & 3) * KSLOT; bf16x8 kr[4]; \
        M3_VRD(0); M3_KRR(0); M3_SBAR(); float sacc = (P0[0] + P0[1]); \
        M3_GAPA(C0 = M3_MF(kf[0], qr[0], negm), P0[2], P0[3], P0[4], P0[5],     pw0[0] = M3_PKW(P0, 0), pw0[1] = M3_PKW(P0, 2), pw0); \
        M3_VRD(4); M3_KRR(1); M3_SBAR(); M3_GAPA(C1 = M3_MF(kf[1], qr[0], negm), P0[6], P0[7], P0[8], P0[9],     pw0[2] = M3_PKW(P0, 4), pw0[3] = M3_PKW(P0, 6), pw0); \
        M3_VRD(1); M3_SBAR(); M3_GAPA(C0 = M3_MF(kf[2], qr[1], C0),   P0[10], P0[11], P0[12], P0[13], pw1[0] = M3_PKW(P0, 8), pw1[1] = M3_PKW(P0, 10), pw1); \
        M3_VRD(5); M3_SBAR(); M3_GAPA(C1 = M3_MF(kf[3], qr[1], C1),   P0[14], P0[15], P1[0], P1[1],   pw1[2] = M3_PKW(P0, 12), pw1[3] = M3_PKW(P0, 14), pw1); \
        M3_GAPA(C0 = M3_MF(kf[4], qr[2], C0),   P1[2], P1[3], P1[4], P1[5],     pw2[0] = M3_PKW(P1, 0), pw2[1] = M3_PKW(P1, 2), pw2); \
        M3_GAPA(C1 = M3_MF(kf[5], qr[2], C1),   P1[6], P1[7], P1[8], P1[9],     pw2[2] = M3_PKW(P1, 4), pw2[3] = M3_PKW(P1, 6), pw2); \
        M3_GAPA(C0 = M3_MF(kf[6], qr[3], C0),   P1[10], P1[11], P1[12], P1[13], pw3[0] = M3_PKW(P1, 8), pw3[1] = M3_PKW(P1, 10), pw3); \
        M3_GAPA(C1 = M3_MF(kf[7], qr[3], C1),   P1[14], P1[15], 0.f, 0.f,       pw3[2] = M3_PKW(P1, 12), pw3[3] = M3_PKW(P1, 14), pw3); \
        M3_GAPR(C0 = M3_MF(kr[0], qr[4], C0)); M3_GAPR(C1 = M3_MF(kr[1], qr[4], C1)); M3_GAPR(C0 = M3_MF(kr[2], qr[5], C0)); M3_GAPR(C1 = M3_MF(kr[3], qr[5], C1)); \
        l_reg += sacc; \
        if (GK) { M3_DMA_K((t) + 3, (kc + 3) & 3); } if (GV) { M3_DMA_V((t) + 1, i_next); } \
        M3_CMASK(C0, C1, t); \
        { float a = M3_MX3(C0[0], C0[1], C1[0]), b_ = M3_MX3(C0[2], C0[3], C1[1]); a = M3_MX3(a, C1[2], C1[3]); \
          _Pragma("unroll") for (int r = 4; r < 16; r += 4) { a = M3_MX3(a, C0[r], C0[r + 1]); b_ = M3_MX3(b_, C0[r + 2], C0[r + 3]); a = M3_MX3(a, C1[r], C1[r + 1]); b_ = M3_MX3(b_, C1[r + 2], C1[r + 3]); } \
          const float rm = swapmax(__builtin_fmaxf(a, b_)); \
          resc = false; \
          if (__builtin_expect(__any(rm > (float)THRL), 0)) { const float dl = __builtin_fmaxf(rm, 0.f); mhat += dl; \
            _Pragma("unroll") for (int r = 0; r < 16; ++r) { C0[r] -= dl; C1[r] -= dl; } \
            _Pragma("unroll") for (int r = 0; r < 16; ++r) negm[r] = -mhat; asm volatile("" : "+v"(negm)); \
            const float f = __builtin_amdgcn_exp2f(-dl); l_reg *= f; if (hi == 0) wsf[r32] = f; resc = true; } } \
        M3_SBAR(); \
        M3_VRD(2); M3_SBAR(); M3_GAPB(o[0] = M3_MF(M3_PAF(0), M3_VFR(0), o[0]), C0, 0); \
        M3_VRD(6); M3_SBAR(); M3_GAPB(o[1] = M3_MF(M3_PAF(0), M3_VFR(4), o[1]), C0, 4); \
        M3_VRD(3); M3_KRD(GL, 0); M3_GAPB(o[0] = M3_MF(M3_PAF(1), M3_VFR(1), o[0]), C0, 8); \
        M3_VRD(7); M3_KRD(GL, 1); M3_GAPB(o[1] = M3_MF(M3_PAF(1), M3_VFR(5), o[1]), C0, 12); \
        M3_KRD(GL, 2); M3_GAPB(o[0] = M3_MF(M3_PAF(2), M3_VFR(2), o[0]), C1, 0); \
        M3_KRD(GL, 3); M3_GAPB(o[1] = M3_MF(M3_PAF(2), M3_VFR(6), o[1]), C1, 4); \
        M3_GAPB(o[0] = M3_MF(M3_PAF(3), M3_VFR(3), o[0]), C1, 8); \
        M3_GAPB(o[1] = M3_MF(M3_PAF(3), M3_VFR(7), o[1]), C1, 12); \
    } while (0)
    int t = 1;
#undef M3_CMASK
#define M3_CMASK(P0, P1, t) do {} while (0)
    for (; t + 5 < NT; t += 2) {
        M3_STEP(pB0, pB1, pA0, pA1, t, true, true, true);       M3_WB(2, 3); M3_RESC(); M3_ROT();
        M3_STEP(pA0, pA1, pB0, pB1, t + 1, true, true, true);   M3_WB(2, 3); M3_RESC(); M3_ROT();
    }
#undef M3_CMASK
#define M3_CMASK(P0, P1, t) do { const int jb_ = (t) - (NT - 4); if (jb_ >= 0) cmask(P0, P1, jb_, qrel, hi); } while (0)
#define M3_ENDW(tt) do { if ((tt) + 3 < NT) { M3_WB(2, 3); } else if ((tt) + 2 < NT) { M3_WAIT_BAR(1); } else { M3_WAIT_BAR(0); } } while (0)
    for (; t + 1 < NT; t += 2) {
        M3_STEP(pB0, pB1, pA0, pA1, t, (t + 3 < NT), (t + 1 < NT), (t + 1 < NT));       M3_ENDW(t);     M3_RESC(); M3_ROT();
        M3_STEP(pA0, pA1, pB0, pB1, t + 1, (t + 4 < NT), (t + 2 < NT), (t + 2 < NT));   M3_ENDW(t + 1); M3_RESC(); M3_ROT();
    }
    M3_STEP(pB0, pB1, pA0, pA1, NT - 1, false, false, false); M3_RESC();
    {   float sacc = pB0[0] + pB0[1];
#pragma unroll
        for (int r = 2; r < 16; ++r) sacc += pB0[r];
#pragma unroll
        for (int r = 0; r < 16; ++r) sacc += pB1[r];
        l_reg += sacc;
        pw0 = (v4u){M3_PKW(pB0, 0), M3_PKW(pB0, 2), M3_PKW(pB0, 4), M3_PKW(pB0, 6)}; pw1 = (v4u){M3_PKW(pB0, 8), M3_PKW(pB0, 10), M3_PKW(pB0, 12), M3_PKW(pB0, 14)};
        pw2 = (v4u){M3_PKW(pB1, 0), M3_PKW(pB1, 2), M3_PKW(pB1, 4), M3_PKW(pB1, 6)}; pw3 = (v4u){M3_PKW(pB1, 8), M3_PKW(pB1, 10), M3_PKW(pB1, 12), M3_PKW(pB1, 14)};
        M3_SBAR();
        const lds_cptr vp_ = vp0 + i_cur * VSLOT;
        M3_VRD(0); M3_VRD(1); M3_VRD(2); M3_VRD(3);
        o[0] = M3_MF(M3_PAF(0), M3_VFR(0), o[0]); o[0] = M3_MF(M3_PAF(1), M3_VFR(1), o[0]); o[0] = M3_MF(M3_PAF(2), M3_VFR(2), o[0]); o[0] = M3_MF(M3_PAF(3), M3_VFR(3), o[0]);
        M3_SBAR();
        M3_VRD(4); M3_VRD(5); M3_VRD(6); M3_VRD(7);
        o[1] = M3_MF(M3_PAF(0), M3_VFR(4), o[1]); o[1] = M3_MF(M3_PAF(1), M3_VFR(5), o[1]); o[1] = M3_MF(M3_PAF(2), M3_VFR(6), o[1]); o[1] = M3_MF(M3_PAF(3), M3_VFR(7), o[1]);
    }
    l_reg = swapadd(l_reg);
    if (hi == 0) wsf[32 + r32] = l_reg; asm volatile("s_waitcnt lgkmcnt(0)" ::: "memory");
    float rli[16];
#pragma unroll
    for (int r = 0; r < 16; ++r) rli[r] = __builtin_amdgcn_rcpf(wsf[32 + crow(r, hi)]);
    bf16* Ow = O + (rowbase + q0 + wid * 32) * 1024 + h * 64;
    {   bf16* stg = (bf16*)(shm + LDS_OST) + wid * 2048;
#pragma unroll
        for (int r = 0; r < 16; ++r) { const int orow = crow(r, hi);
#pragma unroll
            for (int d0 = 0; d0 < 2; ++d0) stg[orow * 64 + d0 * 32 + r32] = (bf16)f2bf(o[d0][r] * rli[r]); }
        asm volatile("s_waitcnt lgkmcnt(0)" ::: "memory");
#pragma unroll
        for (int i = 0; i < 4; ++i) { const int row = i * 8 + (lane >> 3), ch = lane & 7; const v4u v = *(const v4u*)(stg + row * 64 + ch * 8); *(v4u*)(Ow + (long)row * 1024 + ch * 8) = v; } }
    asm volatile("s_waitcnt lgkmcnt(0)\n\ts_barrier" ::: "memory");
#undef M3_DMA_K
#undef M3_DMA_V
#undef M3_CMASK
#undef M3_RESC
#undef M3_ROT
#undef M3_PKW
#undef M3_PAF
#undef M3_VFR
#undef M3_PIN
#undef M3_MX3
#undef M3_MF
#undef M3_GAPA
#undef M3_GAPR
#undef M3_EX
#undef M3_GAPB
#undef M3_VRD
#undef M3_KRR
#undef M3_KRD
#undef M3_STEP
#undef M3_ENDW
}
#undef M3_SBAR
#undef M3_WAIT_BAR
}
#ifndef REP_CH
#define REP_CH 1
#endif
#ifndef REPS_INIT
#define REPS_INIT {1,1,1,1,1,1,1,1,1,1,1,1,1,1,1,1,1,1,1,1,1,1}
#endif
__device__ constexpr int REPS[22] = REPS_INIT;
__device__ __forceinline__ void p0_prologue(const Params& p, LAS unsigned char* L, int gw, int NGW, int lane, int wave, int gtid, int NGT) {
    LAS float* scr = (LAS float*)(L + wave * 16384);
    unsigned char* ws = p.ws;
    constexpr int I0 = 592, I1 = 96, I2 = 64, I3 = 512, I4 = 1536, I5 = 512, IM = 24576;
    constexpr int NIT = I0 + I1 + I2 + I3 + I4 + I5; (void)IM;
    for (int it = gw; it < NIT; it += NGW) {
        int r = it;
        if (r < I0) { const int kb = r / 37, nb = r % 37; transpose_item(p.in[5], 1184, 64 * kb, 32 * nb, (bf16*)(ws + WS_WINE) + (size_t)(32 * nb) * 1024, 1024, scr, lane); continue; } r -= I0;
        if (r < I1) { const int kb = r / 24, nb = r % 24; transpose_item(p.in[8], 768, 64 * kb, 32 * nb, (bf16*)(ws + WS_WQB) + (size_t)(32 * nb) * 256, 256, scr, lane); continue; } r -= I1;
        if (r < I2) { const int kb = r / 32, nb = r % 32; transpose_item(p.in[9], 1024, 64 * kb, 32 * nb, (bf16*)(ws + WS_WKVB) + (size_t)(32 * nb) * 128, 128, scr, lane); continue; } r -= I2;
        if (r < I3) { const int kb = r / 32, nb = r % 32; transpose_item(p.in[11], 1024, 64 * kb, 32 * nb, (bf16*)(ws + WS_WOE) + (size_t)(32 * nb) * 1024, 1024, scr, lane); continue; } r -= I3;
        if (r < I4) { const int kb = r / 96, nb = r % 96; transpose_item(p.in[12], 3072, 64 * kb, 32 * nb, (bf16*)(ws + WS_WINO) + (size_t)(32 * nb) * 1024, 1024, scr, lane); continue; } r -= I4;
        { const int kb = r / 32, nb = r % 32; transpose_item(p.in[13], 1024, 64 * kb, 32 * nb, (bf16*)(ws + WS_WOO) + (size_t)(32 * nb) * 1024, 1024, scr, lane); }
    }
    { v4u* z = (v4u*)((bf16*)(ws + WS_WINE) + (size_t)1184 * 1024); for (int i = gtid; i < 96 * 1024 / 8; i += NGT) z[i] = (v4u){0u, 0u, 0u, 0u}; }
    for (int m = gw; m < NTOK / 2; m += NGW) rms_rows2_to_bf16(p.in[0] + (size_t)m * 1024, p.in[0] + (size_t)(m + NTOK / 2) * 1024, p.in[1], (bf16*)(ws + WS_U) + (size_t)m * 1024, (bf16*)(ws + WS_U) + (size_t)(m + NTOK / 2) * 1024, lane);
    { float* bt = (float*)(ws + WS_BIAS); const float* rel = p.in[4];
      for (int i = gtid; i < 8 * 8192; i += NGT) { const int h = i >> 13, n = i & 8191; int b;
          if (n < 16) b = n; else { b = 16 + (int)(log((double)n / 16.0) / log(128.0) * 16.0); if (b > 31) b = 31; }
          bt[i] = rel[b * 8 + h] * LOG2E; } }
    { float* wrt = (float*)(ws + WS_WRT);
      for (int i = gtid; i < 2 * 48 * 1024; i += NGT) { const int d = i & 1023, j = (i >> 10) % 48, l = i / (48 * 1024);
          const float g = p.in[2][l * 1024 + d];
          const float w = (j < 32) ? g * p.in[16][((size_t)l * 1024 + d) * 32 + j] : (j < 36) ? g * p.in[14][((size_t)l * 1024 + d) * 4 + (j - 32)] : 0.f;
          wrt[i] = w; const unsigned hb = f2bf(w);
          const int cch = d >> 5, kq_ = (d >> 3) & 3, e_ = d & 7, jt = j >> 4, col_ = j & 15;
          const size_t fi = ((((size_t)l * 32 + cch) * 3 + jt) * 64 + (kq_ * 16 + col_)) * 8 + e_;
          ((bf16*)(ws + WS_WRT + 512 * 1024))[fi] = (bf16)hb; ((bf16*)(ws + WS_WRT + 768 * 1024))[fi] = (bf16)f2bf(w - bf2f((unsigned short)hb)); } }
    { f32x2* rt = (f32x2*)(ws + WS_ROPE);
      for (int i = gtid; i < 8192 * 16; i += NGT) { const int t = i >> 4, ii = i & 15;
          const float freq = (float)pow(10000.0, -(double)(2 * ii) / 32.0); const float ang = (float)t * freq;
          f32x2 cs; cs.x = (float)cos((double)ang); cs.y = (float)sin((double)ang); rt[i] = cs; } }
}


__device__ __forceinline__ void moe_item(const Params& p, int layer, int it, const float*& W, int& ldw, int& k0, int& n0, bf16*& dst, int& ldk) {
    const int r = layer * 32 * 384 + it, le = r / 384, rr = r % 384, which = rr >> 7, item = rr & 127, e = le & 31;
    unsigned char* lbase = p.ws + WS_MOEW + (size_t)(le >> 5) * 48 * MiB;
    if (which < 2) { W = p.in[18 + which] + (size_t)le * 1024 * 256; ldw = 256; const int kb = item / 8, nb = item % 8; k0 = 64 * kb; n0 = 32 * nb;
        dst = (bf16*)lbase + ((size_t)e * 512 + (n0 >> 7) * 256 + which * 128 + (n0 & 127)) * 1024; ldk = 1024; }
    else { W = p.in[20] + (size_t)le * 256 * 1024; ldw = 1024; const int kb = item / 32, nb = item % 32; k0 = 64 * kb; n0 = 32 * nb;
        dst = (bf16*)(lbase + 32 * MiB) + ((size_t)e * 1024 + 32 * nb) * 256; ldk = 256; }
}
__device__ __forceinline__ void moe_convert(const Params& p, LAS unsigned char* L, int layer, int widx, int nworkers, int lane, int wave) {
    LAS float* scr = (LAS float*)(L + wave * 16384);
    int it = widx;
    if (it >= 32 * 384) return;
    const float* W; int ldw, k0, n0, ldk; bf16* dst;
    moe_item(p, layer, it, W, ldw, k0, n0, dst, ldk);
    float tv[32];
#pragma unroll
    for (int i = 0; i < 32; ++i) tv[i] = W[(size_t)(k0 + 2 * i + (lane >> 5)) * ldw + n0 + (lane & 31)];
    for (;;) {
        const int itn = it + nworkers; const bool more = itn < 32 * 384;
        const float* Wn = W; int ldwn = ldw, k0n = k0, n0n = n0, ldkn = ldk; bf16* dstn = dst;
        if (more) moe_item(p, layer, itn, Wn, ldwn, k0n, n0n, dstn, ldkn);
#pragma unroll
        for (int i = 0; i < 32; ++i) scr[(2 * i + (lane >> 5)) * 33 + (lane & 31)] = tv[i];
        if (more) {
#pragma unroll
            for (int i = 0; i < 32; ++i) tv[i] = Wn[(size_t)(k0n + 2 * i + (lane >> 5)) * ldwn + n0n + (lane & 31)];
        }
        LDS_WAIT(); asm volatile("" ::: "memory");
        const int c = lane & 7;
        f32x4 g0 = {1.f, 1.f, 1.f, 1.f}, g1 = g0;
        if (ldk == 1024) { const f32x4* gp = (const f32x4*)(p.in[2] + layer * 1024 + k0 + 8 * c); g0 = gp[0]; g1 = gp[1]; }
#pragma unroll
        for (int j = 0; j < 4; ++j) { const int n = (lane >> 3) + 8 * j; const LAS float* s = scr + (8 * c) * 33 + n;
            v4u o; o.x = pk2(s[0 * 33] * g0.x, s[1 * 33] * g0.y); o.y = pk2(s[2 * 33] * g0.z, s[3 * 33] * g0.w); o.z = pk2(s[4 * 33] * g1.x, s[5 * 33] * g1.y); o.w = pk2(s[6 * 33] * g1.z, s[7 * 33] * g1.w);
            *(v4u*)(dst + (size_t)n * ldk + k0 + 8 * c) = o; }
        LDS_WAIT(); asm volatile("" ::: "memory");
        if (!more) break;
        it = itn; W = Wn; ldw = ldwn; k0 = k0n; n0 = n0n; dst = dstn; ldk = ldkn;
    }
}
constexpr int MOE_T2E_OFF = RING_BYTES + 1024;
template <bool ORD>
__device__ __forceinline__ void moe_tables(const Params& p, LAS unsigned char* L, int layer, int tid, int G, int& ntiles, int& nfull) {
    LAS int* seg = (LAS int*)(L + MOE_T2E_OFF + 256); LAS unsigned char* t2e = L + MOE_T2E_OFF; LAS int* cntL = (LAS int*)(L + MOE_T2E_OFF + 512);
    LAS unsigned char* ord = L + MOE_T2E_OFF + 640; LAS int* nf = (LAS int*)(L + MOE_T2E_OFF + 800);
    const unsigned* cnt = (const unsigned*)(p.ws + WS_CTL) + CW_ECNT + layer * 32 * 64;
    __syncthreads();
    if (tid < 64) {
        const int c = (tid < 32) ? (int)__hip_atomic_load(cnt + tid * 64, __ATOMIC_RELAXED, __HIP_MEMORY_SCOPE_AGENT) : 0;
        const int nt = (c + 255) >> 8; const int r = c - (nt - 1) * 256; const int part = (nt > 0 && r < 256) ? 1 : 0;
        int tl_ = 0;
        if constexpr (ORD) {
            int ncomp = nt - part;
#pragma unroll
            for (int o = 1; o < 64; o <<= 1) ncomp += __shfl_xor(ncomp, o);
            const int slots = ((ncomp * 2 + G - 1) / G) * G / 2 - ncomp;
            int rank = 0;
            const int key = part ? r : -1;
#pragma unroll
            for (int e2 = 0; e2 < 32; ++e2) { const int k2 = __builtin_amdgcn_readlane(key, e2); rank += (k2 > key || (k2 == key && e2 < tid)) ? 1 : 0; }
            tl_ = (part && rank >= slots) ? 1 : 0;
        }
        const int tl = tl_; const int nfe = nt - tl;
        int inc = nt, incf = nfe, inct = tl;
#pragma unroll
        for (int o = 1; o < 32; o <<= 1) { const int v = __shfl_up(inc, o), vf = __shfl_up(incf, o), vt = __shfl_up(inct, o); if ((tid & 63) >= o) { inc += v; incf += vf; inct += vt; } }
        const int nfa = __shfl(incf, 31);
        if (tid < 32) { cntL[tid] = c; seg[tid] = (inc - nt) * 256; for (int t = inc - nt; t < inc; ++t) t2e[t] = (unsigned char)tid;
            for (int t = 0; t < nfe; ++t) ord[incf - nfe + t] = (unsigned char)(inc - nt + t);
            if (tl) ord[nfa + inct - 1] = (unsigned char)(inc - 1); }
        if (tid == 31) { seg[32] = inc * 256; nf[0] = nfa; }
    }
    __syncthreads();
    ntiles = seg[32] >> 8; nfull = nf[0];
}
__device__ __forceinline__ void moe_tail_units(const Params& p, LAS unsigned char* L, const bf16* GU, unsigned* hcnt, int nfull, int ntiles, int q, int G, int tid, int lane, int wave) {
    unsigned char* ws = p.ws;
    const LAS int* seg = (const LAS int*)(L + MOE_T2E_OFF + 256); const LAS unsigned char* t2e = L + MOE_T2E_OFF; const LAS int* cntL = (const LAS int*)(L + MOE_T2E_OFF + 512);
    const LAS unsigned char* ord = L + MOE_T2E_OFF + 640;
    const bf16* UB = (const bf16*)p.out; const int* EL = (const int*)(ws + WS_EL); const f32x2* EW = (const f32x2*)(ws + WS_EW); bf16* HH = (bf16*)(ws + WS_HH);
    constexpr int RS = 528;
    const int mb = wave & 3, cg = wave >> 2, fm = lane & 15, kq = lane >> 4;
    int base = 0;
    for (int ti = nfull; ti < ntiles; ++ti) {
        const int pm = (int)ord[ti], e = (int)t2e[pm], cn = cntL[e], off = pm * 256 - seg[e], rows = cn - off, nun = ((rows + 63) >> 6) * 8;
        const unsigned pub = 96u / (unsigned)nun;
        for (int un = (q - base + G) % G; un < nun; un += G) {
            const int rg = un >> 3, s = un & 7, f0 = s * 32, ro = off + rg * 64;
            const bf16* src[8];
#pragma unroll
            for (int i = 0; i < 8; ++i) { const int r = (wave & 3) * 16 + 2 * i + (lane >> 5);
                if (wave < 4) { int li = ro + r; li = li < cn ? li : cn - 1; src[i] = UB + hro((size_t)EL[(size_t)e * 16384 + li]) + (lane & 31) * 8; }
                else { const int f = f0 + (r & 31); src[i] = GU + ((size_t)e * 512 + (f >> 7) * 256 + (f & 127) + (r >> 5) * 128) * 1024 + (lane & 31) * 8; } }
            pg8::f32x4 accg = (pg8::f32x4){0.f, 0.f, 0.f, 0.f}, accu = (pg8::f32x4){0.f, 0.f, 0.f, 0.f};
            const bool active = (ro + mb * 16 < cn);
            v4u rr[8];
#pragma unroll
            for (int i = 0; i < 8; ++i) rr[i] = *(const v4u*)(src[i]);
#pragma unroll 1
            for (int ch = 0; ch < 4; ++ch) {
                __syncthreads();
#pragma unroll
                for (int i = 0; i < 8; ++i) *(LAS v4u*)(L + (wave * 16 + 2 * i + (lane >> 5)) * RS + (lane & 31) * 16) = rr[i];
                __syncthreads();
                if (ch < 3) {
#pragma unroll
                    for (int i = 0; i < 8; ++i) rr[i] = *(const v4u*)(src[i] + (ch + 1) * 256);
                }
                if (active) {
#pragma unroll
                    for (int kk = 0; kk < 8; ++kk) {
                        const pg8::bf16x8 af = *(const LAS pg8::bf16x8*)(L + (mb * 16 + fm) * RS + kk * 64 + kq * 16);
                        const pg8::bf16x8 bg = *(const LAS pg8::bf16x8*)(L + (64 + cg * 16 + fm) * RS + kk * 64 + kq * 16);
                        const pg8::bf16x8 bu = *(const LAS pg8::bf16x8*)(L + (96 + cg * 16 + fm) * RS + kk * 64 + kq * 16);
                        accg = __builtin_amdgcn_mfma_f32_16x16x32_bf16(af, bg, accg, 0, 0, 0);
                        accu = __builtin_amdgcn_mfma_f32_16x16x32_bf16(af, bu, accu, 0, 0, 0);
                    }
                }
            }
            if (active) {
#pragma unroll
                for (int i = 0; i < 4; ++i) { const int lr = rg * 64 + mb * 16 + 4 * kq + i, li = off + lr;
                    if (li < cn) { const f32x2 w2 = EW[(size_t)e * 16384 + li]; const float g = accg[i] * w2.y, up = accu[i] * w2.y;
                        const float hv = g * __builtin_amdgcn_rcpf(1.0f + __builtin_amdgcn_exp2f(-g * LOG2E)) * up * w2.x;
                        const unsigned hb = (unsigned)f2bf(hv); bf16* hp = HH + (size_t)(pm * 256 + lr) * 256 + f0 + cg * 16 + fm;
                        asm volatile("global_store_short %0, %1, off sc1" :: "v"(hp), "v"(hb) : "memory"); } }
            }
            asm volatile("s_waitcnt vmcnt(0)" ::: "memory");
            __syncthreads();
            if (tid == 0) (void)__hip_atomic_fetch_add(hcnt + pm * 16, pub, __ATOMIC_RELAXED, __HIP_MEMORY_SCOPE_AGENT);
        }
        base = (base + nun) % G;
    }
}
__device__ __forceinline__ void moe_route(const Params& p, LAS unsigned char* L, int layer, const float* H, int gw, int NGW, int lane, int wave) {
    unsigned char* ws = p.ws;
    const float* b_group = p.in[15] + layer * 4; const float* b_router = p.in[17] + layer * 32; const float* gain = p.in[2] + layer * 1024;
    unsigned* cnt = (unsigned*)(ws + WS_CTL) + CW_ECNT + layer * 32 * 64;
    const int g4 = wave & 3, half = wave >> 2;
    LAS float* lg = (LAS float*)(L + g4 * 4096);
    LAS float* pl = (LAS float*)(L + 16384 + g4 * 4096);
    LAS unsigned* lc = (LAS unsigned*)(L + 32768);
    const int tok = lane & 15, kq = lane >> 4, tid = wave * 64 + lane;
    const int G_ = NGW / NWAVES, vcu_ = gw / NWAVES;
    for (int base = 0; base < NTOK / 16; base += 4 * G_) {
        const int grp = base + g4 * G_ + vcu_;
        const bool active = (grp < NTOK / 16);
        if (tid < 32) lc[tid] = 0u;
        int e0 = 0, e1 = 0; unsigned r0 = 0u, r1 = 0u; float wA = 0.f, wB = 0.f, rtok = 0.f; const int m0 = grp * 16;
        pg8::f32x4 acc0 = {0.f, 0.f, 0.f, 0.f}, acc1 = acc0, acc2 = acc0; float ss = 0.f;
        if (active) {
            const int kb = 512 * half + 8 * kq;
            const bf16* hrow = (const bf16*)H + hro((size_t)(m0 + tok)) + kb;
            const bf16* wh = (const bf16*)(ws + WS_WRT + 512 * 1024) + ((size_t)layer * 32 + 16 * half) * 1536 + lane * 8;
            const bf16* wl = (const bf16*)(ws + WS_WRT + 768 * 1024) + ((size_t)layer * 32 + 16 * half) * 1536 + lane * 8;
            v4u rhb[2]; bf16x8 rbh0[2], rbl0[2], rbh1[2], rbl1[2], rbh2[2], rbl2[2];
#define RT_LD(S, C) do { rhb[S] = *(const v4u*)(hrow + 32 * (C)); \
                rbh0[S] = *(const bf16x8*)(wh + 1536 * (C)); rbl0[S] = *(const bf16x8*)(wl + 1536 * (C)); rbh1[S] = *(const bf16x8*)(wh + 1536 * (C) + 512); rbl1[S] = *(const bf16x8*)(wl + 1536 * (C) + 512); \
                rbh2[S] = *(const bf16x8*)(wh + 1536 * (C) + 1024); rbl2[S] = *(const bf16x8*)(wl + 1536 * (C) + 1024); } while (0)
#define RT_DO(S, C) do { const v4u hb_ = rhb[S]; const f32x4 a0 = {bflo(hb_.x), bfhi(hb_.x), bflo(hb_.y), bfhi(hb_.y)}, a1 = {bflo(hb_.z), bfhi(hb_.z), bflo(hb_.w), bfhi(hb_.w)}; \
                ss += ((a0.x * a0.x + a0.y * a0.y) + (a0.z * a0.z + a0.w * a0.w)) + ((a1.x * a1.x + a1.y * a1.y) + (a1.z * a1.z + a1.w * a1.w)); \
                const bf16x8 ah = __builtin_bit_cast(bf16x8, hb_);     \
                acc0 = __builtin_amdgcn_mfma_f32_16x16x32_bf16(ah, rbh0[S], acc0, 0, 0, 0); acc1 = __builtin_amdgcn_mfma_f32_16x16x32_bf16(ah, rbh1[S], acc1, 0, 0, 0); acc2 = __builtin_amdgcn_mfma_f32_16x16x32_bf16(ah, rbh2[S], acc2, 0, 0, 0); \
                acc0 = __builtin_amdgcn_mfma_f32_16x16x32_bf16(ah, rbl0[S], acc0, 0, 0, 0); acc1 = __builtin_amdgcn_mfma_f32_16x16x32_bf16(ah, rbl1[S], acc1, 0, 0, 0); acc2 = __builtin_amdgcn_mfma_f32_16x16x32_bf16(ah, rbl2[S], acc2, 0, 0, 0); } while (0)
            RT_LD(0, 0);
#pragma unroll 1
            for (int c = 0; c < 16; c += 2) {
                RT_LD(1, c + 1);
                RT_DO(0, c);
                if (c + 2 < 16) RT_LD(0, c + 2);
                RT_DO(1, c + 1);
            }
#undef RT_LD
#undef RT_DO
            ss += __shfl_xor(ss, 16); ss += __shfl_xor(ss, 32);
            if (half == 1) {
#pragma unroll
                for (int i = 0; i < 4; ++i) { const int tk = 4 * kq + i; pl[tk * 48 + tok] = acc0[i]; pl[tk * 48 + 16 + tok] = acc1[i]; pl[tk * 48 + 32 + tok] = acc2[i]; }
                if (lane < 16) pl[768 + lane] = ss;
            }
        }
        __syncthreads();
        if (active && half == 0) {
            ss += pl[768 + tok];
            const float r = 1.0f / sqrtf(ss * (1.f / 1024.f) + RMS_EPS);
            rtok = r;
            const int col = lane & 15;
            const float bia0 = b_router[col], bia1 = b_router[16 + col], bia2 = (col < 4) ? b_group[col] : 0.f;
#pragma unroll
            for (int i = 0; i < 4; ++i) { const int tk = 4 * kq + i; const float rt = __shfl(r, tk);
                lg[tk * 48 + col] = (acc0[i] + pl[tk * 48 + col]) * rt + bia0; lg[tk * 48 + 16 + col] = (acc1[i] + pl[tk * 48 + 16 + col]) * rt + bia1; lg[tk * 48 + 32 + col] = (acc2[i] + pl[tk * 48 + 32 + col]) * rt + bia2; }
            LDS_WAIT(); asm volatile("" ::: "memory");
            if (lane < 16) {
                const LAS float* l = lg + lane * 48;
                int gs = 0; float gm = l[32];
#pragma unroll
                for (int j = 1; j < 4; ++j) { const float v = l[32 + j]; if (v > gm) { gm = v; gs = j; } }
                float gsum = 0.f;
#pragma unroll
                for (int j = 0; j < 4; ++j) gsum += expf(l[32 + j] - gm);
                const float ggate = 1.0f / gsum;
                const LAS float* el = l + gs * 8;
                float v0 = el[0]; int a0 = 0;
#pragma unroll
                for (int j = 1; j < 8; ++j) { const float v = el[j]; if (v > v0) { v0 = v; a0 = j; } }
                float v1 = -INFINITY; int a1 = 0;
#pragma unroll
                for (int j = 0; j < 8; ++j) { const float v = el[j]; if (j != a0 && v > v1) { v1 = v; a1 = j; } }
                const float p1 = expf(v1 - v0), ps = 1.0f + p1;
                e0 = gs * 8 + a0; e1 = gs * 8 + a1; wA = ggate / ps; wB = ggate * p1 / ps;
                r0 = __hip_atomic_fetch_add(lc + e0, 1u, __ATOMIC_RELAXED, __HIP_MEMORY_SCOPE_WORKGROUP);
                r1 = __hip_atomic_fetch_add(lc + e1, 1u, __ATOMIC_RELAXED, __HIP_MEMORY_SCOPE_WORKGROUP);
            }
        }
        __syncthreads();
        if (tid < 32) { const unsigned c = lc[tid]; lc[32 + tid] = c ? __hip_atomic_fetch_add(cnt + tid * 64, c, __ATOMIC_RELAXED, __HIP_MEMORY_SCOPE_AGENT) : 0u; }
        __syncthreads();
        if (active && half == 0 && lane < 16) {
            const unsigned pos0 = lc[32 + e0] + r0, pos1 = lc[32 + e1] + r1;
            v4u ti; ti.x = ((unsigned)e0 << 16) | pos0; ti.y = ((unsigned)e1 << 16) | pos1; ti.z = __builtin_bit_cast(unsigned, wA); ti.w = __builtin_bit_cast(unsigned, wB);
            *((v4u*)(ws + WS_TOKINFO) + m0 + lane) = ti;
            { int* EL = (int*)(ws + WS_EL); f32x2* EW = (f32x2*)(ws + WS_EW); EL[e0 * 16384 + pos0] = m0 + lane; EL[e1 * 16384 + pos1] = m0 + lane; EW[e0 * 16384 + pos0] = (f32x2){wA, rtok}; EW[e1 * 16384 + pos1] = (f32x2){wB, rtok}; }
        }
        __syncthreads();
    }
}
template <bool FINAL>
__device__ __forceinline__ void moe_combine(const Params& p, LAS unsigned char* L, float* H, const float* gain, int gw, int NGW, int lane) {
    unsigned char* ws = p.ws; const LAS int* seg = (const LAS int*)(L + MOE_T2E_OFF + 256);
    const bf16* YE = (const bf16*)(ws + WS_XG); bf16* U = (bf16*)(ws + WS_U);
    const f32x4* gr = (const f32x4*)gain + lane;
    for (int m0 = gw; m0 < NTOK / 2; m0 += NGW) {
        const int mA = m0, mB = m0 + NTOK / 2;
        const v2u tA = *((const v2u*)(ws + WS_TOKINFO) + 2 * mA), tB = *((const v2u*)(ws + WS_TOKINFO) + 2 * mB);
        const int rA0 = seg[tA.x >> 16] + (int)(tA.x & 0xffffu), rA1 = seg[tA.y >> 16] + (int)(tA.y & 0xffffu);
        const int rB0 = seg[tB.x >> 16] + (int)(tB.x & 0xffffu), rB1 = seg[tB.y >> 16] + (int)(tB.y & 0xffffu);
        f32x4* hA = (f32x4*)(H + (size_t)mA * 1024) + lane; f32x4* hB = (f32x4*)(H + (size_t)mB * 1024) + lane;
        v2u* gA = (v2u*)((bf16*)H + hro((size_t)mA)) + lane; v2u* gB = (v2u*)((bf16*)H + hro((size_t)mB)) + lane;
        const v2u* yA0 = (const v2u*)(YE + (size_t)rA0 * 1024) + lane; const v2u* yA1 = (const v2u*)(YE + (size_t)rA1 * 1024) + lane;
        const v2u* yB0 = (const v2u*)(YE + (size_t)rB0 * 1024) + lane; const v2u* yB1 = (const v2u*)(YE + (size_t)rB1 * 1024) + lane;
        f32x4 va[4], vb[4]; v2u a0[4], a1[4], b0[4], b1[4];
#pragma unroll
        for (int j = 0; j < 4; ++j) { const v2u ha_ = gA[64 * j], hb_ = gB[64 * j]; va[j] = (f32x4){bflo(ha_.x), bfhi(ha_.x), bflo(ha_.y), bfhi(ha_.y)}; vb[j] = (f32x4){bflo(hb_.x), bfhi(hb_.x), bflo(hb_.y), bfhi(hb_.y)}; a0[j] = yA0[64 * j]; a1[j] = yA1[64 * j]; b0[j] = yB0[64 * j]; b1[j] = yB1[64 * j]; }
        float sa = 0.f, sb = 0.f;
#pragma unroll
        for (int j = 0; j < 4; ++j) {
            va[j].x += bflo(a0[j].x) + bflo(a1[j].x); va[j].y += bfhi(a0[j].x) + bfhi(a1[j].x); va[j].z += bflo(a0[j].y) + bflo(a1[j].y); va[j].w += bfhi(a0[j].y) + bfhi(a1[j].y);
            vb[j].x += bflo(b0[j].x) + bflo(b1[j].x); vb[j].y += bfhi(b0[j].x) + bfhi(b1[j].x); vb[j].z += bflo(b0[j].y) + bflo(b1[j].y); vb[j].w += bfhi(b0[j].y) + bfhi(b1[j].y);
            sa += (va[j].x * va[j].x + va[j].y * va[j].y) + (va[j].z * va[j].z + va[j].w * va[j].w);
            sb += (vb[j].x * vb[j].x + vb[j].y * vb[j].y) + (vb[j].z * vb[j].z + vb[j].w * vb[j].w); }
#pragma unroll
        for (int o = 1; o < 64; o <<= 1) { sa += __shfl_xor(sa, o); sb += __shfl_xor(sb, o); }
        const float ra = 1.0f / sqrtf(sa * (1.f / 1024.f) + RMS_EPS), rb = 1.0f / sqrtf(sb * (1.f / 1024.f) + RMS_EPS);
        if (FINAL) {
#pragma unroll
            for (int j = 0; j < 4; ++j) { const f32x4 g = gr[64 * j];
                hA[64 * j] = (f32x4){va[j].x * ra * g.x, va[j].y * ra * g.y, va[j].z * ra * g.z, va[j].w * ra * g.w};
                hB[64 * j] = (f32x4){vb[j].x * rb * g.x, vb[j].y * rb * g.y, vb[j].z * rb * g.z, vb[j].w * rb * g.w}; }
        } else {
            unsigned long long* oA = (unsigned long long*)(U + (size_t)mA * 1024) + lane; unsigned long long* oB = (unsigned long long*)(U + (size_t)mB * 1024) + lane;
#pragma unroll
            for (int j = 0; j < 4; ++j) { const f32x4 g = gr[64 * j]; gA[64 * j] = (v2u){pk2(va[j].x, va[j].y), pk2(va[j].z, va[j].w)}; gB[64 * j] = (v2u){pk2(vb[j].x, vb[j].y), pk2(vb[j].z, vb[j].w)};
                oA[64 * j] = (unsigned long long)pk2(va[j].x * ra * g.x, va[j].y * ra * g.y) | ((unsigned long long)pk2(va[j].z * ra * g.z, va[j].w * ra * g.w) << 32);
                oB[64 * j] = (unsigned long long)pk2(vb[j].x * rb * g.x, vb[j].y * rb * g.y) | ((unsigned long long)pk2(vb[j].z * rb * g.z, vb[j].w * rb * g.w) << 32); }
        }
    }
}
__device__ __forceinline__ int mbl_off(int n) { return 256 * (31 * n - (n * (n - 1)) / 2); }
constexpr int MBL_PER_BH = 256 * 496;
#define P3_SUM16(v) do { v += __builtin_bit_cast(float, __builtin_amdgcn_update_dpp(0, __builtin_bit_cast(int, v), 0xB1, 0xf, 0xf, true)); \
        v += __builtin_bit_cast(float, __builtin_amdgcn_update_dpp(0, __builtin_bit_cast(int, v), 0x4E, 0xf, 0xf, true)); \
        v += __builtin_bit_cast(float, __builtin_amdgcn_update_dpp(0, __builtin_bit_cast(int, v), 0x141, 0xf, 0xf, true)); \
        v += __builtin_bit_cast(float, __builtin_amdgcn_update_dpp(0, __builtin_bit_cast(int, v), 0x140, 0xf, 0xf, true)); } while (0)
template <int WHAT>
__device__ __forceinline__ void p3_norm_tile(const Params& p, int pm, bool dokr, int lane, int wave) {
    unsigned char* ws = p.ws;
    const bf16* P0 = (const bf16*)(ws + WS_PROJ0); bf16* CQN = (bf16*)(ws + WS_CQN); bf16* CKVN = (bf16*)(ws + WS_CKVN); bf16* KR = (bf16*)(ws + WS_KR);
    const f32x2* rope = (const f32x2*)(ws + WS_ROPE);
    const int rsub = lane >> 4, c16 = lane & 15, row0 = pm * 256 + wave * 4 + rsub;
    if constexpr (WHAT == 0) {
        f32x4 g4[4];
#pragma unroll
        for (int j = 0; j < 4; ++j) g4[j] = *((const f32x4*)p.in[6] + c16 * 4 + j);
        const float g[16] = {g4[0].x, g4[0].y, g4[0].z, g4[0].w, g4[1].x, g4[1].y, g4[1].z, g4[1].w, g4[2].x, g4[2].y, g4[2].z, g4[2].w, g4[3].x, g4[3].y, g4[3].z, g4[3].w};
#pragma unroll 1
        for (int jh = 0; jh < 8; jh += 4) {
        v4u w[4][2];
#pragma unroll
        for (int j = 0; j < 4; ++j) { const bf16* pr = P0 + (size_t)(row0 + 32 * (jh + j)) * 1280 + c16 * 16; w[j][0] = *(const v4u*)pr; w[j][1] = *(const v4u*)(pr + 8); }
#pragma unroll
        for (int j = 0; j < 4; ++j) { const int m = row0 + 32 * (jh + j); float cq[16];
#pragma unroll
            for (int h2 = 0; h2 < 2; ++h2) { const v4u x = w[j][h2]; cq[8 * h2 + 0] = bflo(x.x); cq[8 * h2 + 1] = bfhi(x.x); cq[8 * h2 + 2] = bflo(x.y); cq[8 * h2 + 3] = bfhi(x.y);
                cq[8 * h2 + 4] = bflo(x.z); cq[8 * h2 + 5] = bfhi(x.z); cq[8 * h2 + 6] = bflo(x.w); cq[8 * h2 + 7] = bfhi(x.w); }
            float sq = 0.f;
#pragma unroll
            for (int e = 0; e < 16; ++e) sq += cq[e] * cq[e];
            P3_SUM16(sq);
            const float r = 1.0f / sqrtf(sq * (1.f / 256.f) + RMS_EPS);
            v4u o0, o1;
            o0.x = pk2(cq[0] * r * g[0], cq[1] * r * g[1]); o0.y = pk2(cq[2] * r * g[2], cq[3] * r * g[3]); o0.z = pk2(cq[4] * r * g[4], cq[5] * r * g[5]); o0.w = pk2(cq[6] * r * g[6], cq[7] * r * g[7]);
            o1.x = pk2(cq[8] * r * g[8], cq[9] * r * g[9]); o1.y = pk2(cq[10] * r * g[10], cq[11] * r * g[11]); o1.z = pk2(cq[12] * r * g[12], cq[13] * r * g[13]); o1.w = pk2(cq[14] * r * g[14], cq[15] * r * g[15]);
            *(v4u*)(CQN + (size_t)m * 256 + c16 * 16) = o0; *(v4u*)(CQN + (size_t)m * 256 + c16 * 16 + 8) = o1; }
        }
    } else {
        f32x4 g4[2];
#pragma unroll
        for (int j = 0; j < 2; ++j) g4[j] = *((const f32x4*)p.in[7] + c16 * 2 + j);
        v4u w[8]; float x1[8], x2[8]; f32x2 cs[8];
#pragma unroll
        for (int j = 0; j < 8; ++j) { const int m = row0 + 32 * j; const bf16* pr = P0 + (size_t)m * 1280; w[j] = *(const v4u*)(pr + 256 + c16 * 8);
            x1[j] = 0.f; x2[j] = 0.f; cs[j] = (f32x2){0.f, 0.f};
            if (dokr) { x1[j] = bf2f(pr[384 + c16]); x2[j] = bf2f(pr[400 + c16]); cs[j] = rope[(size_t)(m & 8191) * 16 + c16]; } }
        const float gk[8] = {g4[0].x, g4[0].y, g4[0].z, g4[0].w, g4[1].x, g4[1].y, g4[1].z, g4[1].w};
#pragma unroll
        for (int j = 0; j < 8; ++j) { const int m = row0 + 32 * j; float ck[8]; const v4u x = w[j];
            ck[0] = bflo(x.x); ck[1] = bfhi(x.x); ck[2] = bflo(x.y); ck[3] = bfhi(x.y); ck[4] = bflo(x.z); ck[5] = bfhi(x.z); ck[6] = bflo(x.w); ck[7] = bfhi(x.w);
            float sk = 0.f;
#pragma unroll
            for (int e = 0; e < 8; ++e) sk += ck[e] * ck[e];
            P3_SUM16(sk);
            const float r2 = 1.0f / sqrtf(sk * (1.f / 128.f) + RMS_EPS);
            v4u ok; ok.x = pk2(ck[0] * r2 * gk[0], ck[1] * r2 * gk[1]); ok.y = pk2(ck[2] * r2 * gk[2], ck[3] * r2 * gk[3]); ok.z = pk2(ck[4] * r2 * gk[4], ck[5] * r2 * gk[5]); ok.w = pk2(ck[6] * r2 * gk[6], ck[7] * r2 * gk[7]);
            *(v4u*)(CKVN + (size_t)m * 128 + c16 * 8) = ok;
            if (dokr) { KR[(size_t)m * 32 + c16] = (bf16)f2bf(x1[j] * cs[j].x - x2[j] * cs[j].y); KR[(size_t)m * 32 + 16 + c16] = (bf16)f2bf(x2[j] * cs[j].x + x1[j] * cs[j].y); } }
    }
}
#undef P3_SUM16
__global__ void __launch_bounds__(NWAVES * 64, 2) mega(Params p) {
    extern __shared__ __attribute__((aligned(16))) unsigned char lds[];
    LAS unsigned char* L = (LAS unsigned char*)lds;
    int tid = threadIdx.x, lane = tid & 63; const int wave = __builtin_amdgcn_readfirstlane(tid >> 6);
#define PH_OPQ() asm volatile("" : "+v"(tid), "+v"(lane))
    const int G = gridDim.x, bx = blockIdx.x;
    const int vcu = (G % 8 == 0) ? (bx % 8) * (G / 8) + bx / 8 : bx;
    unsigned char* ws = p.ws;
    volatile LAS unsigned* MISC = (volatile LAS unsigned*)(L + MISC_OFF);
    if (tid < 32) MISC[tid] = 0u;
    __syncthreads();
    XcdBarrier bar = xcd_barrier_post((unsigned*)(ws + WS_CTL) + CW_BAR + p.li * XCD_BAR_WORDS, MISC + 8);
    const int lo = p.ph_lo, hi = p.ph_hi;
#define IN(k) (lo <= (k) && (k) < hi)
#define BOTH(k) (IN(k) && IN((k) + 1))
    const int gw = vcu * NWAVES + wave, NGW = G * NWAVES, gtid = vcu * (NWAVES * 64) + tid, NGT = G * NWAVES * 64;

    PH_OPQ();
    if (IN(0)) for (int rep = 0; rep < REPS[0]; ++rep) { p0_prologue(p, L, gw, NGW, lane, wave, gtid, NGT); if (BOTH(0) && rep == REPS[0] - 1) xcd_barrier(bar); }

    PH_OPQ();
    if (IN(1)) for (int rep = 0; rep < REPS[1]; ++rep) {
        pg8::Gemm g{(const pg8::bf16_t*)(ws + WS_U), (const pg8::bf16_t*)(ws + WS_WINE), NTOK, 1280, 1024};
        pg8::StaticOrder S; S.init(NTOK, 1280, G, bx);
        EpiStore E{(bf16*)(ws + WS_PROJ0), 1280, -1};
        pg8::gemm_phase<EpiStore, pg8::StaticOrder, true, true>(L + RING_OFF, g, S, E);
        { const int total = (NTOK / 256) * 5, rem = total % G, nidle = rem ? G - rem : G;
          if (rep == 0 && bx >= (rem ? rem : 0)) { __syncthreads(); moe_convert(p, L, 0, (bx - rem) * NWAVES + wave, nidle * NWAVES, lane, wave); } }
        if (BOTH(1) && rep == REPS[1] - 1) xcd_barrier(bar);
    }

    PH_OPQ();

    PH_OPQ();
    if (IN(3)) for (int rep = 0; rep < REPS[3]; ++rep) {
        { pg8::StaticOrder Sq; Sq.init(NTOK, 768, G, bx); pg8::Unit uq; const bool hq = Sq.next(0, uq);
          pg8::StaticOrder Sk; Sk.init(NTOK, 1024, G, bx); pg8::Unit uk; const bool hk = Sk.next(0, uk);
          if (hq) p3_norm_tile<0>(p, uq.pm, false, lane, wave);
          if (hk) p3_norm_tile<1>(p, uk.pm, uk.pn == 0, lane, wave);
          asm volatile("s_waitcnt vmcnt(0)" ::: "memory"); __syncthreads(); }
        PH_OPQ();
        { pg8::Gemm g{(const pg8::bf16_t*)(ws + WS_CQN), (const pg8::bf16_t*)(ws + WS_WQB), NTOK, 768, 256};
          pg8::StaticOrder S; S.init(NTOK, 768, G, bx);
          EpiStore E{(bf16*)(ws + WS_Q), 768, -1};
          pg8::gemm_phase<EpiStore, pg8::StaticOrder, true, true>(L + RING_OFF, g, S, E); }
        { pg8::Gemm g{(const pg8::bf16_t*)(ws + WS_CKVN), (const pg8::bf16_t*)(ws + WS_WKVB), NTOK, 1024, 128};
          pg8::StaticOrder S; S.init(NTOK, 1024, G, bx);
          EpiStore E{(bf16*)(ws + WS_KVB), 1024, -1};
          pg8::gemm_phase<EpiStore, pg8::StaticOrder, true, true>(L + RING_OFF, g, S, E); }
        if (BOTH(3) && rep == REPS[3] - 1) xcd_barrier(bar);
    }

    PH_OPQ();
    if (IN(4)) for (int rep = 0; rep < REPS[4]; ++rep) {
        const bf16* Qb = (const bf16*)(ws + WS_Q); const bf16* KVB = (const bf16*)(ws + WS_KVB); const bf16* KR = (const bf16*)(ws + WS_KR); const bf16* P0 = (const bf16*)(ws + WS_PROJ0);
        bf16* MIX = (bf16*)(ws + WS_U); const MobaArgs mb0{};
        for (int pi = vcu; pi < 256; pi += G) {
            const int bh = pi >> 4, s = pi & 15, b = bh >> 3, h = bh & 7;
#pragma unroll 1
            for (int ui = 0; ui < 2; ++ui)
                mla3::unit(b, h, ui ? s : 31 - s, Qb, KVB, KR, (const f32x2*)(ws + WS_ROPE), MIX, (char*)L, 0.10206207261596575f * LOG2E);
        }
        __syncthreads();
        PH_OPQ();
        { const float* BT = (const float*)(ws + WS_BIAS); LAS float* tb = (LAS float*)(L + ABIAS_OFF);
          for (int i = tid; i < 8 * 320; i += NWAVES * 64) { const int h = i / 320, d = (i % 320) - 64; tb[i] = (d >= 0 && d < 128) ? BT[h * 8192 + d] : 0.f; } }
        __syncthreads();
        for (int id = vcu; id < 512; id += G) {
            const int b = id >> 8, hkv = (id >> 7) & 1, qt = id & 127, q0u = qt * 64, hq = 4 * hkv + (wave >> 1), q0w = q0u + 32 * (wave & 1); const size_t r0 = (size_t)b * T_;
            AttnPtrs a; a.Q = P0 + (r0 + q0w) * 1280 + 416 + hq * 64; a.qs = 1280; a.K = P0 + r0 * 1280 + 928 + hkv * 64; a.ks = 1280; a.K2 = nullptr;
            a.V = P0 + r0 * 1280 + 1056 + hkv * 64; a.vs = 1280; a.O = MIX + (r0 + q0w) * 1024 + 512 + hq * 64;
            attn_unit<AM_SWA>(L, a, q0u, q0w, qt >= 2 ? qt - 2 : 0, qt, 0.125f * LOG2E, p.in[10][hq] * LOG2E, mb0, hq * 320, nullptr, tid, lane, wave);
        }
        __syncthreads();
        if (BOTH(4) && rep == REPS[4] - 1) xcd_barrier(bar);
    }

    PH_OPQ();
    if (IN(5)) for (int rep = 0; rep < REPS[5]; ++rep) {
        pg8::Gemm g{(const pg8::bf16_t*)(ws + WS_U), (const pg8::bf16_t*)(ws + WS_WOE), NTOK, 1024, 1024};
        pg8::StaticOrder S; S.init(NTOK, 1024, G, bx);
        EpiResid<false> E{p.in[0], (bf16*)p.out};
        pg8::gemm_phase<EpiResid<false>, pg8::StaticOrder, true, true>(L + RING_OFF, g, S, E);
        if (BOTH(5) && rep == REPS[5] - 1) xcd_barrier(bar);
    }

    PH_OPQ();
    if (IN(6)) { moe_route(p, L, 0, p.out, gw, NGW, lane, wave); if (BOTH(6)) xcd_barrier(bar); }
    PH_OPQ();
    if (IN(8)) {
        int nt, nfull; moe_tables<true>(p, L, 0, tid, G, nt, nfull);
        unsigned* hcnt = (unsigned*)(ws + WS_CTL) + CW_HCNT + 0 * 160 * 16;
        const int total1 = nfull * 2, rem = total1 % G, q = (vcu + G - rem) % G;
        { pg8::Gemm g{(const pg8::bf16_t*)p.out, (const pg8::bf16_t*)(ws + WS_MOEW), nt * 256, 32 * 512, 1024};
          MoeOrderG<2> S{total1, G, vcu, L + MOE_T2E_OFF, (const LAS int*)(L + MOE_T2E_OFF + 256), (const LAS int*)(L + MOE_T2E_OFF + 512), (const int*)(ws + WS_EL), hcnt, L + MOE_T2E_OFF + 640};
          EpiSwiGLU E{(bf16*)(ws + WS_HH), (const f32x2*)(ws + WS_EW), L + MOE_T2E_OFF, (const LAS int*)(L + MOE_T2E_OFF + 256)};
          pg8::gemm_phase_g<EpiSwiGLU, MoeOrderG<2>, true, true>(L + RING_OFF, g, S, E); }
        __syncthreads();
        moe_tail_units(p, L, (const bf16*)(ws + WS_MOEW), hcnt, nfull, nt, q, G, tid, lane, wave);
        { const int ntu = (nt - nfull) * 16, nw = (ntu <= G - 64) ? G - ntu : G, r = (ntu <= G - 64) ? q - ntu : q;
          if (r >= 0) { __syncthreads(); moe_convert(p, L, 1, r * NWAVES + wave, nw * NWAVES, lane, wave); __syncthreads(); } }
        { pg8::Gemm g{(const pg8::bf16_t*)(ws + WS_HH), (const pg8::bf16_t*)(ws + WS_MOEW + 32 * MiB), nt * 256, 32 * 1024, 256};
          MoeOrderD<4> S{nt * 4, L + MOE_T2E_OFF, L + MOE_T2E_OFF + 640, hcnt, (unsigned*)(ws + WS_CTL) + CW_TICK + 0 * 64, (LAS unsigned*)(L + MOE_T2E_OFF + 804)};
          EpiStore E{(bf16*)(ws + WS_XG), 1024, 3};
          pg8::gemm_phase<EpiStore, MoeOrderD<4>, false, true>(L + RING_OFF, g, S, E); }
        if (BOTH(8)) xcd_barrier(bar);
    }
    PH_OPQ();
    if (IN(10)) { int nt, nfl; moe_tables<false>(p, L, 0, tid, G, nt, nfl); moe_combine<false>(p, L, p.out, p.in[1] + 1024, gw, NGW, lane); __syncthreads(); if (BOTH(10)) xcd_barrier(bar); }

    PH_OPQ();
    if (IN(11)) for (int rep = 0; rep < REPS[11]; ++rep) {
        pg8::Gemm g{(const pg8::bf16_t*)(ws + WS_U), (const pg8::bf16_t*)(ws + WS_WINO), NTOK, 3072, 1024};
        pg8::StaticOrder S; S.init(NTOK, 3072, G, bx);
        EpiStore E{(bf16*)(ws + WS_PROJ1), 3072, -1};
        pg8::gemm_phase<EpiStore, pg8::StaticOrder, true, true>(L + RING_OFF, g, S, E);
        if (BOTH(11) && rep == REPS[11] - 1) xcd_barrier(bar);
    }
    PH_OPQ();
    if (IN(12)) for (int rep = 0; rep < REPS[12]; ++rep) {
        const bf16* P1 = (const bf16*)(ws + WS_PROJ1); float* KM = (float*)(ws + WS_KMEAN);
        LAS float* part = (LAS float*)L;
        for (int id = vcu; id < 64; id += G) { const int b = id >> 5, n = id & 31;
            const bf16* kp = P1 + ((size_t)b * T_ + n * 256 + wave * 32) * 3072 + 512 + lane * 8;
            float acc[8] = {0.f, 0.f, 0.f, 0.f, 0.f, 0.f, 0.f, 0.f};
#pragma unroll 8
            for (int j = 0; j < 32; ++j) { const v4u w = *(const v4u*)(kp + (size_t)j * 3072);
                acc[0] += bflo(w.x); acc[1] += bfhi(w.x); acc[2] += bflo(w.y); acc[3] += bfhi(w.y); acc[4] += bflo(w.z); acc[5] += bfhi(w.z); acc[6] += bflo(w.w); acc[7] += bfhi(w.w); }
            __syncthreads();
#pragma unroll
            for (int j = 0; j < 8; ++j) part[wave * 512 + lane * 8 + j] = acc[j];
            __syncthreads();
            { const int c = tid;
              float s = 0.f;
#pragma unroll
              for (int w = 0; w < 8; ++w) s += part[w * 512 + c];
              KM[((size_t)(b * 8 + (c >> 6)) * 32 + n) * 64 + (c & 63)] = s * (1.0f / 256.f); }
        }
        __syncthreads();
        if (BOTH(12) && rep == REPS[12] - 1) xcd_barrier(bar);
    }
    PH_OPQ();
    if (IN(13)) {
        const bf16* P1 = (const bf16*)(ws + WS_PROJ1); const float* KM = (const float*)(ws + WS_KMEAN);
        unsigned* mcnt = (unsigned*)(ws + WS_CTL) + CW_MBCNT; unsigned* LIST = (unsigned*)(ws + WS_MBLIST);
        LAS float* kml = (LAS float*)L;
        LAS unsigned char* qst = L + 16384 + wave * 9216;
        int bhc = -1;
        for (int id = gw; id < 2048; id += NGW) {
            const int bh = id >> 7, qc = id & 127, b = bh >> 3, h = bh & 7, q = qc * 64 + lane, own = (qc * 64) >> 8;
            if (bh != bhc) { __syncthreads(); *(LAS f32x4*)(kml + (tid >> 4) * 68 + (tid & 15) * 4) = *(const f32x4*)(KM + (size_t)bh * 2048 + tid * 4); bhc = bh; __syncthreads(); }
            { const bf16* qb = P1 + ((size_t)b * T_ + qc * 64) * 3072 + h * 64; v4u t[8];
#pragma unroll
              for (int j = 0; j < 8; ++j) t[j] = *(const v4u*)(qb + (size_t)(8 * j + (lane >> 3)) * 3072 + (lane & 7) * 8);
#pragma unroll
              for (int j = 0; j < 8; ++j) *(LAS v4u*)(qst + (8 * j + (lane >> 3)) * 144 + (lane & 7) * 16) = t[j]; }
            const int ql = lane & 31, hf = lane >> 5;
            f32x16 sc[2]; sc[0] = f32x16{}; sc[1] = f32x16{};
#pragma unroll
            for (int ks = 0; ks < 4; ++ks) {
                const f32x4 x0 = *(const LAS f32x4*)(kml + ql * 68 + ks * 16 + hf * 8), x1 = *(const LAS f32x4*)(kml + ql * 68 + ks * 16 + hf * 8 + 4);
                const float xv[8] = {x0.x, x0.y, x0.z, x0.w, x1.x, x1.y, x1.z, x1.w};
                unsigned hb[8], lb[8];
#pragma unroll
                for (int j = 0; j < 8; ++j) { hb[j] = f2bf(xv[j]); lb[j] = f2bf(xv[j] - bf2f((unsigned short)hb[j])); }
                const bf16x8 ahi = __builtin_bit_cast(bf16x8, (v4u){hb[0] | (hb[1] << 16), hb[2] | (hb[3] << 16), hb[4] | (hb[5] << 16), hb[6] | (hb[7] << 16)});
                const bf16x8 alo = __builtin_bit_cast(bf16x8, (v4u){lb[0] | (lb[1] << 16), lb[2] | (lb[3] << 16), lb[4] | (lb[5] << 16), lb[6] | (lb[7] << 16)});
#pragma unroll
                for (int t = 0; t < 2; ++t) { const bf16x8 bq = *(const LAS bf16x8*)(qst + (t * 32 + ql) * 144 + ks * 32 + hf * 16);
                    sc[t] = __builtin_amdgcn_mfma_f32_32x32x16_bf16(ahi, bq, sc[t], 0, 0, 0);
                    sc[t] = __builtin_amdgcn_mfma_f32_32x32x16_bf16(alo, bq, sc[t], 0, 0, 0); }
            }
            float b0 = -INFINITY, b1 = -INFINITY, b2 = -INFINITY; int i0 = -1, i1 = -1, i2 = -1;
#pragma unroll
            for (int t = 0; t < 2; ++t) {
                float c0 = -INFINITY, c1 = -INFINITY, c2 = -INFINITY; int j0 = -1, j1 = -1, j2 = -1;
#pragma unroll
                for (int r = 0; r < 16; ++r) { const int n = crow(r, hf); const float g = sc[t][r];
                    if (n < own) {
                        if (g > c0) { c2 = c1; j2 = j1; c1 = c0; j1 = j0; c0 = g; j0 = n; }
                        else if (g > c1) { c2 = c1; j2 = j1; c1 = g; j1 = n; }
                        else if (g > c2) { c2 = g; j2 = n; } } }
                const float o0 = __shfl_xor(c0, 32), o1 = __shfl_xor(c1, 32), o2 = __shfl_xor(c2, 32); const int p0 = __shfl_xor(j0, 32), p1 = __shfl_xor(j1, 32), p2 = __shfl_xor(j2, 32);
#define MB_INS(G_, N_) do { const float g_ = (G_); const int n_ = (N_); \
                    if (n_ >= 0) { \
                        if (g_ > c0 || (g_ == c0 && n_ < j0)) { c2 = c1; j2 = j1; c1 = c0; j1 = j0; c0 = g_; j0 = n_; } \
                        else if (g_ > c1 || (g_ == c1 && n_ < j1)) { c2 = c1; j2 = j1; c1 = g_; j1 = n_; } \
                        else if (g_ > c2 || (g_ == c2 && n_ < j2)) { c2 = g_; j2 = n_; } } } while (0)
                MB_INS(o0, p0); MB_INS(o1, p1); MB_INS(o2, p2);
#undef MB_INS
                if (hf == t) { b0 = c0; b1 = c1; b2 = c2; i0 = j0; i1 = j1; i2 = j2; }
            }
            (void)b0; (void)b1; (void)b2;
            int mycnt = 0;
            for (int n = 0; n < own; ++n) { const unsigned long long mask = __ballot((i0 == n) || (i1 == n) || (i2 == n)); if (lane == n) mycnt = __builtin_popcountll(mask); }
            unsigned mybase = 0u;
            if (mycnt > 0) mybase = __hip_atomic_fetch_add(mcnt + (bh * 32 + lane) * 16, (unsigned)mycnt, __ATOMIC_RELAXED, __HIP_MEMORY_SCOPE_AGENT);
            for (int n = 0; n < own; ++n) {
                const int sl = (i0 == n) ? 0 : (i1 == n) ? 1 : (i2 == n) ? 2 : -1;
                const unsigned long long mask = __ballot(sl >= 0);
                const unsigned base = __shfl(mybase, n);
                if (sl >= 0) LIST[(size_t)bh * MBL_PER_BH + mbl_off(n) + base + (unsigned)__builtin_popcountll(mask & ((1ull << lane) - 1ull))] = (unsigned)q | ((unsigned)sl << 13);
            }
        }
        if (BOTH(13)) xcd_barrier(bar);
    }
    PH_OPQ();
    if (IN(14)) for (int rep = 0; rep < REPS[14]; ++rep) {
        const bf16* P1 = (const bf16*)(ws + WS_PROJ1); bf16* MIX = (bf16*)(ws + WS_U);
        const float* BT = (const float*)(ws + WS_BIAS);
        const unsigned* mcnt = (const unsigned*)(ws + WS_CTL) + CW_MBCNT; const unsigned* LIST = (const unsigned*)(ws + WS_MBLIST);
        LAS int* pre = (LAS int*)(L + UT_OFF); LAS int* cntL = pre + 513;
        __syncthreads();
        { const int c = (int)__hip_atomic_load(mcnt + tid * 16, __ATOMIC_RELAXED, __HIP_MEMORY_SCOPE_AGENT); cntL[tid] = c; pre[tid + 1] = (c + 255) >> 8; if (tid == 0) pre[0] = 0; }
        __syncthreads();
        if (tid < 64) {
            int v[8], sum = 0;
#pragma unroll
            for (int j = 0; j < 8; ++j) { v[j] = pre[1 + tid * 8 + j]; sum += v[j]; }
            int inc = sum;
#pragma unroll
            for (int o = 1; o < 64; o <<= 1) { const int x = __shfl_up(inc, o); if (tid >= o) inc += x; }
            int run = inc - sum;
#pragma unroll
            for (int j = 0; j < 8; ++j) { run += v[j]; pre[1 + tid * 8 + j] = run; }
        }
        __syncthreads();
        const int nchunks = pre[512], per_lo = nchunks / G, per_ex = nchunks - per_lo * G;
        const int u_beg = vcu * per_lo + (vcu < per_ex ? vcu : per_ex), u_end = u_beg + per_lo + (vcu < per_ex ? 1 : 0);
        int hcur = -1;
        MobaArgs mb; mb.PARTO = (bf16*)(ws + WS_PARTO); mb.PARTML = (f32x2*)(ws + WS_PARTML);
        int icur = -1;
        int li_ = 0, ln_ = 0;
        if (u_beg < u_end) { int lo = 0, hi_ = 512; while (hi_ - lo > 1) { const int mid = (lo + hi_) >> 1; if (pre[mid] <= u_beg) lo = mid; else hi_ = mid; }
            li_ = __builtin_amdgcn_readfirstlane(lo); ln_ = __builtin_amdgcn_readfirstlane(pre[lo + 1]); }
        for (int u = u_beg; u < u_end; ++u) {
            while (u >= ln_) { ++li_; ln_ = __builtin_amdgcn_readfirstlane(pre[li_ + 1]); }
            const int i = li_, c = u - __builtin_amdgcn_readfirstlane(pre[li_]), bh = i >> 5, n = i & 31, b = bh >> 3, h = bh & 7, cn = __builtin_amdgcn_readfirstlane(cntL[i]);
            const size_t r0 = (size_t)b * T_;
            if (i != icur) {
                __syncthreads();
                moba_resident_load(L, P1 + (r0 + (size_t)n * 256) * 3072 + 512 + h * 64, P1 + (r0 + (size_t)n * 256) * 3072 + 1024 + h * 64, tid);
                if (h != hcur) { LAS float* tb = (LAS float*)(L + RB_OFF); for (int j = tid; j < 64 + 8192; j += NWAVES * 64) tb[j] = (j >= 64) ? BT[h * 8192 + (j - 64)] : 0.f; hcur = h; }
                icur = i;
                __syncthreads();
            }
            if ((c * 256 + 32 * wave) < cn) {
                const int e = c * 256 + 32 * wave + (lane & 31); const bool valid = e < cn; const unsigned ent = LIST[(size_t)bh * MBL_PER_BH + mbl_off(n) + (valid ? e : cn - 1)];
                moba_resident_wave(L, P1 + r0 * 3072 + h * 64, n, (int)(ent & 8191u), (int)(ent >> 13), valid, bh * 8192, mb.PARTO, mb.PARTML, lane, wave);
            }
        }
        hcur = -1;
        { unsigned* tick = (unsigned*)(ws + WS_CTL) + CW_TICK + 128; LAS unsigned* slot = (LAS unsigned*)(L + UT_OFF + 4224);
          unsigned nxt = 0u; if (tid == 0) nxt = __hip_atomic_fetch_add(tick, 1u, __ATOMIC_RELAXED, __HIP_MEMORY_SCOPE_AGENT);
          for (;;) {
            __syncthreads();
            if (tid == 0) *slot = nxt;
            __syncthreads();
            const int tk = __builtin_amdgcn_readfirstlane((int)*slot);
            if (tk >= 1024) break;
            if (tid == 0) nxt = __hip_atomic_fetch_add(tick, 1u, __ATOMIC_RELAXED, __HIP_MEMORY_SCOPE_AGENT);
            const int id = tk & 511, bh = id >> 5, qb = 31 - (id & 31), b = bh >> 3, h = bh & 7, q0u = qb * 256, q0w = q0u + 32 * wave; const size_t r0 = (size_t)b * T_;
            if (tk < 512) {
                AttnPtrs a; a.Q = P1 + (r0 + q0w) * 3072 + 1536 + h * 64; a.qs = 3072; a.K = P1 + r0 * 3072 + 2048 + h * 64; a.ks = 3072; a.K2 = nullptr;
                a.V = P1 + r0 * 3072 + 2560 + h * 64; a.vs = 3072; a.O = MIX + (r0 + q0w) * 1024 + 512 + h * 64;
                attn_unit<AM_SB>(L, a, q0u, q0w, 0, (q0u + 255) >> 6, 0.125f * LOG2E, 0.f, mb, 0, nullptr, tid, lane, wave);
            } else {
                if (h != hcur) {
                    __syncthreads();
                    LAS float* tb = (LAS float*)(L + ABIAS_OFF);
                    for (int j = tid; j < 64 + 512; j += NWAVES * 64) tb[j] = (j >= 64) ? BT[h * 8192 + (j - 64)] : 0.f;
                    hcur = h;
                    __syncthreads();
                }
                mb.q = 0; mb.slot = 3; mb.valid = true; mb.wvalid = true; mb.bhbase = bh * 8192;
                AttnPtrs a; a.Q = P1 + (r0 + q0w) * 3072 + h * 64; a.qs = 3072; a.K = P1 + r0 * 3072 + 512 + h * 64; a.ks = 3072; a.K2 = nullptr;
                a.V = P1 + r0 * 3072 + 1024 + h * 64; a.vs = 3072; a.O = MIX + (r0 + q0w) * 1024 + h * 64;
                attn_unit<AM_MOBAO>(L, a, q0u, q0w, 4 * qb, 4 * qb + 3, 0.125f * LOG2E, 0.f, mb, 0, nullptr, tid, lane, wave);
            }
          }
        }
        __syncthreads();
        if (BOTH(14) && rep == REPS[14] - 1) xcd_barrier(bar);
    }
    PH_OPQ();
    if (IN(15)) for (int rep = 0; rep < REPS[15]; ++rep) {
        bf16* MIX = (bf16*)(ws + WS_U); const bf16* PARTO = (const bf16*)(ws + WS_PARTO); const f32x4* PML = (const f32x4*)(ws + WS_PARTML);
        const int h = lane >> 3, d8 = (lane & 7) * 8;
        if (rep == 0) for (int m0_ = gw; m0_ < NTOK; m0_ += 2 * NGW) {
            f32x4 ml01[2], ml23[2]; v4u vo[2], v0[2], v1[2], v2[2]; int bq[2];
#pragma unroll
            for (int u = 0; u < 2; ++u) { const int m = m0_ + u * NGW < NTOK ? m0_ + u * NGW : m0_; const int b = m >> 13, q = m & 8191; bq[u] = ((b * 8 + h) * 8192 + q);
                ml01[u] = PML[(size_t)bq[u] * 2]; ml23[u] = PML[(size_t)bq[u] * 2 + 1];
                vo[u] = *(const v4u*)(MIX + (size_t)m * 1024 + h * 64 + d8);
                const v4u* pp = (const v4u*)(PARTO + (size_t)bq[u] * 3 * 64 + d8); v0[u] = pp[0]; v1[u] = pp[8]; v2[u] = pp[16]; }
#pragma unroll
            for (int u = 0; u < 2; ++u) { const int m = m0_ + u * NGW; if (m < NTOK) {
                const int q = m & 8191, nsel = (q >> 8) < 3 ? (q >> 8) : 3;
                const float m0 = nsel > 0 ? ml01[u].x : NEGBIG, m1 = nsel > 1 ? ml01[u].z : NEGBIG, m2 = nsel > 2 ? ml23[u].x : NEGBIG, mo = ml23[u].z;
                const float M = fmaxf(fmaxf(m0, m1), fmaxf(m2, mo));
                const float w0 = __builtin_amdgcn_exp2f(m0 - M), w1 = __builtin_amdgcn_exp2f(m1 - M), w2 = __builtin_amdgcn_exp2f(m2 - M), wo = __builtin_amdgcn_exp2f(mo - M);
                const float invL = 1.0f / (wo * ml23[u].w + (nsel > 0 ? w0 * ml01[u].y : 0.f) + (nsel > 1 ? w1 * ml01[u].w : 0.f) + (nsel > 2 ? w2 * ml23[u].y : 0.f));
                float acc[8]; const float co = wo * invL;
                { const v4u v = vo[u]; acc[0] = bflo(v.x) * co; acc[1] = bfhi(v.x) * co; acc[2] = bflo(v.y) * co; acc[3] = bfhi(v.y) * co; acc[4] = bflo(v.z) * co; acc[5] = bfhi(v.z) * co; acc[6] = bflo(v.w) * co; acc[7] = bfhi(v.w) * co; }
                if (nsel > 0) { const v4u v = v0[u]; const float c = w0 * invL; acc[0] += bflo(v.x) * c; acc[1] += bfhi(v.x) * c; acc[2] += bflo(v.y) * c; acc[3] += bfhi(v.y) * c; acc[4] += bflo(v.z) * c; acc[5] += bfhi(v.z) * c; acc[6] += bflo(v.w) * c; acc[7] += bfhi(v.w) * c; }
                if (nsel > 1) { const v4u v = v1[u]; const float c = w1 * invL; acc[0] += bflo(v.x) * c; acc[1] += bfhi(v.x) * c; acc[2] += bflo(v.y) * c; acc[3] += bfhi(v.y) * c; acc[4] += bflo(v.z) * c; acc[5] += bfhi(v.z) * c; acc[6] += bflo(v.w) * c; acc[7] += bfhi(v.w) * c; }
                if (nsel > 2) { const v4u v = v2[u]; const float c = w2 * invL; acc[0] += bflo(v.x) * c; acc[1] += bfhi(v.x) * c; acc[2] += bflo(v.y) * c; acc[3] += bfhi(v.y) * c; acc[4] += bflo(v.z) * c; acc[5] += bfhi(v.z) * c; acc[6] += bflo(v.w) * c; acc[7] += bfhi(v.w) * c; }
                *(v4u*)(MIX + (size_t)m * 1024 + h * 64 + d8) = (v4u){pk2(acc[0], acc[1]), pk2(acc[2], acc[3]), pk2(acc[4], acc[5]), pk2(acc[6], acc[7])}; } }
        }
        if (BOTH(15) && rep == REPS[15] - 1) xcd_barrier(bar);
    }
    PH_OPQ();
    if (IN(16)) {
        pg8::Gemm g{(const pg8::bf16_t*)(ws + WS_U), (const pg8::bf16_t*)(ws + WS_WOO), NTOK, 1024, 1024};
        pg8::StaticOrder S; S.init(NTOK, 1024, G, bx);
        EpiResid<true> E{p.out, (bf16*)p.out};
        pg8::gemm_phase<EpiResid<true>, pg8::StaticOrder, true, true>(L + RING_OFF, g, S, E);
        if (BOTH(16)) xcd_barrier(bar);
    }
    PH_OPQ();
    if (IN(17)) { moe_route(p, L, 1, p.out, gw, NGW, lane, wave); if (BOTH(17)) xcd_barrier(bar); }
    PH_OPQ();
    if (IN(19)) {
        int nt, nfull; moe_tables<true>(p, L, 1, tid, G, nt, nfull);
        unsigned* hcnt = (unsigned*)(ws + WS_CTL) + CW_HCNT + 1 * 160 * 16;
        const int total1 = nfull * 2, rem = total1 % G, q = (vcu + G - rem) % G;
        { pg8::Gemm g{(const pg8::bf16_t*)p.out, (const pg8::bf16_t*)(ws + WS_MOEW + 48 * MiB), nt * 256, 32 * 512, 1024};
          MoeOrderG<2> S{total1, G, vcu, L + MOE_T2E_OFF, (const LAS int*)(L + MOE_T2E_OFF + 256), (const LAS int*)(L + MOE_T2E_OFF + 512), (const int*)(ws + WS_EL), hcnt, L + MOE_T2E_OFF + 640};
          EpiSwiGLU E{(bf16*)(ws + WS_HH), (const f32x2*)(ws + WS_EW), L + MOE_T2E_OFF, (const LAS int*)(L + MOE_T2E_OFF + 256)};
          pg8::gemm_phase_g<EpiSwiGLU, MoeOrderG<2>, true, true>(L + RING_OFF, g, S, E); }
        __syncthreads();
        moe_tail_units(p, L, (const bf16*)(ws + WS_MOEW + 48 * MiB), hcnt, nfull, nt, q, G, tid, lane, wave);
        { pg8::Gemm g{(const pg8::bf16_t*)(ws + WS_HH), (const pg8::bf16_t*)(ws + WS_MOEW + 80 * MiB), nt * 256, 32 * 1024, 256};
          MoeOrderD<4> S{nt * 4, L + MOE_T2E_OFF, L + MOE_T2E_OFF + 640, hcnt, (unsigned*)(ws + WS_CTL) + CW_TICK + 1 * 64, (LAS unsigned*)(L + MOE_T2E_OFF + 804)};
          EpiStore E{(bf16*)(ws + WS_XG), 1024, 3};
          pg8::gemm_phase<EpiStore, MoeOrderD<4>, false, true>(L + RING_OFF, g, S, E); }
        if (BOTH(19)) xcd_barrier(bar);
    }
    PH_OPQ();
    if (IN(21)) { int nt, nfl; moe_tables<false>(p, L, 1, tid, G, nt, nfl); moe_combine<true>(p, L, p.out, p.in[3], gw, NGW, lane); }
#undef IN
#undef BOTH
}
extern "C" void kernel_launch(void* const* d_in, const int* in_sizes, int n_in, void* d_out, int out_size, void* d_ws, size_t ws_size, hipStream_t stream) {
    static int grid = 0;
    if (grid == 0) {
        int dev = 0, cus = 0;
        if (n_in != 21 || in_sizes[0] != NTOK * DM || out_size != NTOK * DM || ws_size < 282 * MiB) { fprintf(stderr, "kernel_launch: unexpected n_in %d / sizes / ws_size %zu; nothing launched\n", n_in, ws_size); grid = -1; return; }
        if (hipGetDevice(&dev) != hipSuccess || hipDeviceGetAttribute(&cus, hipDeviceAttributeMultiprocessorCount, dev) != hipSuccess) { grid = -1; return; }
        if (hipFuncSetAttribute((const void*)mega, hipFuncAttributeMaxDynamicSharedMemorySize, LDS_BYTES) != hipSuccess) { fprintf(stderr, "kernel_launch: hipFuncSetAttribute failed\n"); grid = -1; return; }
        (void)hipGetLastError();
        grid = cus;
    }
    if (grid < 0) return;
    (void)hipMemsetAsync((char*)d_ws + WS_CTL, 0, CTL_ZERO_BYTES, stream);
    Params p{};
    for (int i = 0; i < 21; ++i) p.in[i] = (const float*)d_in[i];
    p.out = (float*)d_out; p.ws = (unsigned char*)d_ws; p.ph_lo = 0; p.ph_hi = 22; p.li = 0;
    hipLaunchKernelGGL(mega, dim3(grid), dim3(NWAVES * 64), LDS_BYTES, stream, p);
}
```
